# Optimizing an MI355X kernel written in HIP

```python
import math
import jax
import jax.numpy as jnp
from jax import lax
import numpy as np

D_MODEL = 1024
BATCH = 4
SEQ = 8192
DEPTH = 2

GRID_W = 64
CTX_LEN = 256
EPS = 1e-6
D_HYENA = D_MODEL // 2
HYENA_ORDER = 2
SHORT_CONV = 3
FILTER_EMB = 33
FILTER_WIDTH = 64
FILTER_OUT_STD = 0.005
DECAY_FAST = 0.3
DECAY_SLOW = 1.5
DECAY_TARGET = 1e-2
DECAY_SHIFT = 0.05
DA_HEADS = 4
DA_HEAD_DIM = 64
D_DIFF = DA_HEADS * 2 * DA_HEAD_DIM
ROPE_BASE = 10000.0
Q_BLOCK = 128
N_HQ = 3 * D_HYENA + D_DIFF
D_SGU = D_MODEL
SGU_GROUPS = 8
CHUNK = 128
D_FF = 2816
FFN_CONV = 3

kernel_name = "hybrid_hyena_diffattn_sgu_dit"


def rmsnorm(x, g):
    xf = x.astype(jnp.float32)
    y = xf * lax.rsqrt(jnp.mean(xf * xf, axis=-1, keepdims=True) + EPS)
    return (y * g.astype(jnp.float32)).astype(x.dtype)


def layernorm(x, g, b):
    xf = x.astype(jnp.float32)
    mu = jnp.mean(xf, axis=-1, keepdims=True)
    xc = xf - mu
    y = xc * lax.rsqrt(jnp.mean(xc * xc, axis=-1, keepdims=True) + EPS)
    return (y * g.astype(jnp.float32) + b.astype(jnp.float32)).astype(x.dtype)


def modulate(h, shift, scale):
    return h * (1 + scale) + shift


def dwconv3(u, w, b):
    up = jnp.pad(u, ((0, 0), (1, 1), (0, 0)))
    return up[:, :-2] * w[0] + up[:, 1:-1] * w[1] + up[:, 2:] * w[2] + b


def hyena_filters(L, w1, b1, freq, w2, b2, w3):
    f32 = jnp.float32
    bands = (FILTER_EMB - 1) // 2
    pos = jnp.arange(L, dtype=f32)
    t = jnp.linspace(0.0, 1.0, L, dtype=f32)[:, None]
    ang = (2.0 * math.pi / L) * pos[:, None] * jnp.linspace(1e-4, bands - 1, bands, dtype=f32)[None, :]
    z = jnp.concatenate([t, jnp.cos(ang), -jnp.sin(ang)], axis=-1)
    h = jnp.sin(freq[0].astype(f32) * (z @ w1.astype(f32) + b1.astype(f32)))
    h = jnp.sin(freq[1].astype(f32) * (h @ w2.astype(f32) + b2.astype(f32)))
    h = h @ w3.astype(f32)
    deltas = jnp.abs(jnp.linspace(math.log(DECAY_TARGET) / DECAY_SLOW, math.log(DECAY_TARGET) / DECAY_FAST, D_HYENA, dtype=f32))
    window = jnp.exp(-t * deltas[None, :]) + DECAY_SHIFT
    h = h.reshape(L, HYENA_ORDER, 2, D_HYENA) * window[:, None, None, :]
    fwd, bwd = h[:, :, 0], h[:, :, 1]
    return jnp.concatenate([fwd, jnp.zeros_like(fwd[:1]), bwd[:0:-1]], axis=0)


def fftconv_bidir(u, h_full, d_skip):
    L = u.shape[1]
    uf32 = u.astype(jnp.float32)
    uf = jnp.fft.rfft(uf32, n=2 * L, axis=1)
    hf = jnp.fft.rfft(h_full, n=2 * L, axis=0)
    y = jnp.fft.irfft(uf * hf[None], n=2 * L, axis=1)[:, :L]
    return (y + uf32 * d_skip.astype(jnp.float32)).astype(u.dtype)


def hyena_mix(proj, conv_w, conv_b, w1, b1, freq, w2, b2, w3, d_skip):
    L = proj.shape[1]
    proj = dwconv3(proj, conv_w, conv_b)
    v, x1, x2 = jnp.split(proj, 3, axis=-1)
    filt = hyena_filters(L, w1, b1, freq, w2, b2, w3)
    z = v
    for o, gate in enumerate((x1, x2)):
        z = gate * fftconv_bidir(z, filt[:, o], d_skip[o])
    return z


def rope_1d(x, pos):
    m = x.shape[-1] // 2
    inv = ROPE_BASE ** (-jnp.arange(m, dtype=jnp.float32) / m)
    ang = pos.astype(jnp.float32)[:, None] * inv[None, :]
    cos, sin = jnp.cos(ang).astype(x.dtype), jnp.sin(ang).astype(x.dtype)
    x1, x2 = x[..., :m], x[..., m:]
    return jnp.concatenate([x1 * cos - x2 * sin, x1 * sin + x2 * cos], axis=-1)


def rope_2d(x, row, col):
    half = x.shape[-1] // 2
    return jnp.concatenate([rope_1d(x[..., :half], row), rope_1d(x[..., half:], col)], axis=-1)


def to_qk_heads(t):
    B, L, _ = t.shape
    return t.reshape(B, L, DA_HEADS, 2, DA_HEAD_DIM).transpose(0, 2, 3, 1, 4)


def to_v_heads(t):
    B, L, _ = t.shape
    return t.reshape(B, L, DA_HEADS, 2 * DA_HEAD_DIM).transpose(0, 2, 1, 3)


def diff_attention(q, k, v, lam):
    B, H, _, Lq, dh = q.shape
    nb = Lq // Q_BLOCK
    qb = q.reshape(B, H, 2, nb, Q_BLOCK, dh).transpose(3, 0, 1, 2, 4, 5)
    scale = dh ** -0.5

    def block(qi):
        s = jnp.einsum('bhmqd,bhmkd->bhmqk', qi, k).astype(jnp.float32) * scale
        p = jax.nn.softmax(s, axis=-1)
        a = (p[:, :, 0] - lam * p[:, :, 1]).astype(v.dtype)
        return jnp.einsum('bhqk,bhkd->bhqd', a, v)

    o = lax.map(block, qb)
    return o.transpose(1, 2, 0, 3, 4).reshape(B, H, Lq, 2 * dh)


def ab_mixer(h, w_in, w_out, hy, lam, lam_init, subln_g, kc, vc, pos):
    B, L, _ = h.shape
    if pos is None:
        proj = h @ w_in[:, :N_HQ]
        k, v = kc, vc
    else:
        proj = h @ w_in
        kv = proj[..., N_HQ:]
        k = jnp.concatenate([kc, rope_2d(to_qk_heads(kv[..., :D_DIFF]), *pos)], axis=3)
        v = jnp.concatenate([vc, to_v_heads(kv[..., D_DIFF:])], axis=2)
    y_a = hyena_mix(proj[..., :3 * D_HYENA], *hy)
    q = to_qk_heads(proj[..., 3 * D_HYENA:N_HQ])
    if pos is not None:
        q = rope_2d(q, *pos)
    o = diff_attention(q, k, v, lam)
    o = rmsnorm(o, subln_g) * (1.0 - lam_init)
    y_b = o.transpose(0, 2, 1, 3).reshape(B, L, D_DIFF)
    return jnp.concatenate([y_a, y_b], axis=-1) @ w_out


def sgu_mixer(h, w_in, b_in, ln_g, ln_b, w_s, b_s, w_out):
    B, L, _ = h.shape
    u, v = jnp.split(jax.nn.gelu(h @ w_in + b_in, approximate=False), 2, axis=-1)
    v = layernorm(v, ln_g, ln_b)
    n = L // CHUNK
    vb = v.reshape(B, n, CHUNK, SGU_GROUPS, D_SGU // SGU_GROUPS)
    s = jnp.einsum('gts,bnsgc->bntgc', w_s, vb) + b_s.T[:, :, None]
    return (u * s.reshape(B, L, D_SGU)) @ w_out


def conv_ffn(h, w_up, conv_w, conv_b, w_down):
    a = dwconv3(h @ w_up, conv_w, conv_b)
    g, u = jnp.split(a, 2, axis=-1)
    return (jax.nn.silu(g) * u) @ w_down


def setup_inputs(seed: int = 0) -> dict:
    key = jax.random.key(seed)
    ks = iter(jax.random.split(key, 40))
    D = D_MODEL
    n_even = (DEPTH + 1) // 2
    n_odd = DEPTH // 2

    def nrm(shape, scale):
        return jax.random.normal(next(ks), shape, jnp.float32) * scale

    def gain(shape):
        return 1.0 + nrm(shape, 0.02)

    return {
        "x": nrm((BATCH, SEQ, D), 1.0),
        "c": nrm((BATCH, D), 1.0),
        "ctx": nrm((BATCH, CTX_LEN, D), 1.0),
        "c_ctx": nrm((D,), 1.0),
        "mod_w": nrm((DEPTH, D, 6 * D), D ** -0.5),
        "mod_b": nrm((DEPTH, 6 * D), 0.02),
        "norm_mix_g": gain((DEPTH, D)),
        "norm_ffn_g": gain((DEPTH, D)),
        "ffn_w_up": nrm((DEPTH, D, 2 * D_FF), D ** -0.5),
        "ffn_conv_w": nrm((DEPTH, FFN_CONV, 2 * D_FF), FFN_CONV ** -0.5),
        "ffn_conv_b": nrm((DEPTH, 2 * D_FF), 0.02),
        "ffn_w_down": nrm((DEPTH, D_FF, D), D_FF ** -0.5),
        "ab_w_in": nrm((n_even, D, 3 * D_HYENA + 3 * D_DIFF), D ** -0.5),
        "hy_conv_w": nrm((n_even, SHORT_CONV, 3 * D_HYENA), SHORT_CONV ** -0.5),
        "hy_conv_b": nrm((n_even, 3 * D_HYENA), 0.02),
        "hy_w1": nrm((n_even, FILTER_EMB, FILTER_WIDTH), FILTER_EMB ** -0.5),
        "hy_b1": nrm((n_even, FILTER_WIDTH), 0.1),
        "hy_freq": gain((n_even, 2, FILTER_WIDTH)),
        "hy_w2": nrm((n_even, FILTER_WIDTH, FILTER_WIDTH), FILTER_WIDTH ** -0.5),
        "hy_b2": nrm((n_even, FILTER_WIDTH), 0.1),
        "hy_w3": nrm((n_even, FILTER_WIDTH, HYENA_ORDER * 2 * D_HYENA), FILTER_OUT_STD),
        "hy_bias": nrm((n_even, HYENA_ORDER, D_HYENA), 1.0),
        "da_lambda": nrm((n_even, 4, DA_HEAD_DIM), 0.1),
        "da_subln_g": gain((n_even, 2 * DA_HEAD_DIM)),
        "ab_w_out": nrm((n_even, D_HYENA + D_DIFF, D), (D_HYENA + D_DIFF) ** -0.5),
        "sgu_w_in": nrm((n_odd, D, 2 * D_SGU), D ** -0.5),
        "sgu_b_in": nrm((n_odd, 2 * D_SGU), 0.02),
        "sgu_ln_g": gain((n_odd, D_SGU)),
        "sgu_ln_b": nrm((n_odd, D_SGU), 0.02),
        "sgu_w_s": nrm((n_odd, SGU_GROUPS, CHUNK, CHUNK), CHUNK ** -0.5),
        "sgu_b_s": gain((n_odd, SGU_GROUPS, CHUNK)),
        "sgu_w_out": nrm((n_odd, D_SGU, D), D_SGU ** -0.5),
        "final_norm_g": gain((D,)),
    }


def reference(x, c, ctx, c_ctx, mod_w, mod_b, norm_mix_g, norm_ffn_g, ffn_w_up, ffn_conv_w, ffn_conv_b,
              ffn_w_down, ab_w_in, hy_conv_w, hy_conv_b, hy_w1, hy_b1, hy_freq, hy_w2, hy_b2, hy_w3, hy_bias,
              da_lambda, da_subln_g, ab_w_out, sgu_w_in, sgu_b_in, sgu_ln_g, sgu_ln_b, sgu_w_s, sgu_b_s,
              sgu_w_out, final_norm_g):
    D = D_MODEL
    S = x.shape[1]
    rows = S // GRID_W
    row = jnp.repeat(jnp.arange(rows, dtype=jnp.int32), GRID_W)
    col = jnp.tile(jnp.arange(GRID_W, dtype=jnp.int32), rows)
    for i in range(DEPTH):
        ctx_live = any(j % 2 == 0 for j in range(i + 1, DEPTH))
        need_ctx = (i % 2 == 0) or ctx_live
        sh1, sc1, g1, sh2, sc2, g2 = (m[:, None, :] for m in jnp.split(jax.nn.silu(c) @ mod_w[i] + mod_b[i], 6, axis=-1))
        hx = modulate(rmsnorm(x, norm_mix_g[i]), sh1, sc1)
        if need_ctx:
            n_mod = 6 if ctx_live else 2
            cmod = jnp.split(jax.nn.silu(c_ctx) @ mod_w[i][:, :n_mod * D] + mod_b[i][:n_mod * D], n_mod)
            hc = modulate(rmsnorm(ctx, norm_mix_g[i]), cmod[0], cmod[1])
        if i % 2 == 0:
            e = i // 2
            lam_init = 0.8 - 0.6 * math.exp(-0.3 * i)
            lq1, lk1, lq2, lk2 = da_lambda[e].astype(jnp.float32)
            lam = jnp.exp(jnp.sum(lq1 * lk1)) - jnp.exp(jnp.sum(lq2 * lk2)) + lam_init
            hy = (hy_conv_w[e], hy_conv_b[e], hy_w1[e], hy_b1[e], hy_freq[e], hy_w2[e], hy_b2[e], hy_w3[e], hy_bias[e])
            kvc = hc @ ab_w_in[e][:, N_HQ:]
            kc, vc = to_qk_heads(kvc[..., :D_DIFF]), to_v_heads(kvc[..., D_DIFF:])
            mix_x = ab_mixer(hx, ab_w_in[e], ab_w_out[e], hy, lam, lam_init, da_subln_g[e], kc, vc, (row, col))
            if ctx_live:
                mix_c = ab_mixer(hc, ab_w_in[e], ab_w_out[e], hy, lam, lam_init, da_subln_g[e], kc, vc, None)
        else:
            o = i // 2
            sgu = (sgu_w_in[o], sgu_b_in[o], sgu_ln_g[o], sgu_ln_b[o], sgu_w_s[o], sgu_b_s[o], sgu_w_out[o])
            mix_x = sgu_mixer(hx, *sgu)
            if ctx_live:
                mix_c = sgu_mixer(hc, *sgu)
        ffn = (ffn_w_up[i], ffn_conv_w[i], ffn_conv_b[i], ffn_w_down[i])
        x = x + g1 * mix_x
        x = x + g2 * conv_ffn(modulate(rmsnorm(x, norm_ffn_g[i]), sh2, sc2), *ffn)
        if ctx_live:
            ctx = ctx + cmod[2] * mix_c
            ctx = ctx + cmod[5] * conv_ffn(modulate(rmsnorm(ctx, norm_ffn_g[i]), cmod[3], cmod[4]), *ffn)
    return rmsnorm(x, final_norm_g)
```

```cpp
#include <hip/hip_runtime.h>
#include <hip/hip_cooperative_groups.h>
#include <hip/hip_bf16.h>
#include <cstdio>
#include <cstdint>
#include <cmath>
namespace cg = cooperative_groups;
namespace pg8 {
#define PG8_LAS __attribute__((address_space(3)))
typedef unsigned short bf16_t;
typedef short bf16x8 __attribute__((ext_vector_type(8)));
typedef float f32x4 __attribute__((ext_vector_type(4)));
typedef unsigned u32x4 __attribute__((ext_vector_type(4)));
constexpr int BM = 256, BK = 64, HALF = 128, HTB = HALF * BK * 2  , STAGE_BYTES = 8 * HTB, NXCD = 8, WGM = 8;

__host__ __device__ __forceinline__ int lds_byte(int r, int c) { const int st = (r >> 4) * 2 + (c >> 5), rr = r & 15, cc = c & 31, ob = rr * 64 + cc * 2; return st * 1024 + (ob ^ (((ob >> 9) & 1) << 5)); }
__host__ __device__ __forceinline__ void stage_rc(int b, int& R, int& C) { const int st = b / 1024, sb = b % 1024, swz = sb ^ (((sb >> 9) & 1) << 5); R = (st >> 1) * 16 + swz / 64; C = (st & 1) * 32 + (swz % 64) / 2; }
__host__ __device__ __forceinline__ int perm32(int rho) { const int n = rho >> 4, i = rho & 15; return 8 * (i >> 2) + 4 * n + (i & 3); }

struct Unit { int pm, pn; };
struct Gemm { const bf16_t* A; const bf16_t* Bt; int M, N, K; int slab; };

struct StaticOrder {
    int nM, nN, nwg, G, c;
    __host__ __device__ void init(int M, int N, int G_, int c_) { nM = M / BM; nN = N / BM; nwg = nM * nN; G = G_; c = c_; }
    __host__ __device__ bool next(int i, Unit& u) const {
        const long L = (long)i * G + c; if (L >= nwg) return false;
        int wgid = (int)L; { const int q = nwg / NXCD, r = nwg % NXCD, xcd = wgid % NXCD, off = wgid / NXCD; wgid = (xcd < r ? xcd * (q + 1) : r * (q + 1) + (xcd - r) * q) + off; }
        const int nig = WGM * nN, gid = wgid / nig, fm = gid * WGM, gsz = (nM - fm) < WGM ? (nM - fm) : WGM;
        u.pm = fm + ((wgid % nig) % gsz); u.pn = (wgid % nig) / gsz; return true;
    }
    __device__ __forceinline__ void a_ready(const Unit&) const {}
    __device__ __forceinline__ void done(const Unit&) const {}
};

__device__ __forceinline__ unsigned cvt_pk_bf16(float lo, float hi) { unsigned r; asm volatile("v_cvt_pk_bf16_f32 %0, %1, %2" : "=v"(r) : "v"(lo), "v"(hi)); return r; }
typedef float f32x2 __attribute__((ext_vector_type(2)));
__device__ __forceinline__ f32x2 gelu_pk(f32x2 v) {
    const f32x2 av = __builtin_elementwise_abs(v), d = av * 0.2316418882f + 1.0f;
    f32x2 t; t.x = __builtin_amdgcn_rcpf(d.x); t.y = __builtin_amdgcn_rcpf(d.y);
    f32x2 q = t * 0.5307027145f + (-0.7265760135f); q = q * t + 0.7107068705f; q = q * t + (-0.142248368f); q = q * t + 0.127414796f; q = q * t;
    const f32x2 s = (v * v) * (-0.72134752044f);
    f32x2 e; e.x = __builtin_amdgcn_exp2f(s.x); e.y = __builtin_amdgcn_exp2f(s.y);
    const f32x2 m = v * (q * e), r = v - m;
    f32x2 o; o.x = v.x < 0.f ? m.x : r.x; o.y = v.y < 0.f ? m.y : r.y; return o;
}

template <class Epi, class Sched, bool ALIGN_EPI = false, bool SP2 = false>
__device__ __forceinline__ void gemm_phase(PG8_LAS unsigned char* lds, const Gemm g, const Sched& S, const Epi& E) {
    int tid_ = threadIdx.x; asm volatile("" : "+v"(tid_));
    const int tid = tid_, wid = __builtin_amdgcn_readfirstlane(tid >> 6), lane = tid & 63, wr = wid >> 2, wc = wid & 3, fr = lane & 15, fq = lane >> 4;
    const int K = g.K, nt = K / BK;
    unsigned voffA[2], voffB[2];
#pragma unroll
    for (int i = 0; i < 2; ++i) { int R, C; stage_rc(tid * 16 + i * 8192, R, C); const int Rb = Epi::PERM ? ((R & ~31) + perm32(R & 31)) : R;
        const int Ra = g.slab ? ((R >> 6) * 62 + (R & 63)) : R; voffA[i] = (unsigned)(Ra * K + C) * 2u; voffB[i] = (unsigned)(Rb * K + C) * 2u; }
    const size_t kstep = (size_t)(BK * 2);
    const size_t hstep = (size_t)HALF * K * 2;
    const size_t tstep = 2 * hstep;
    const size_t hstepA = g.slab ? (size_t)124 * K * 2 : hstep, tstepA = g.slab ? (size_t)248 * K * 2 : tstep;
    const unsigned ldsw = (unsigned)wid * 1024u;
    const int aoff = lds_byte(wr * 64 + fr, fq * 8), boff = lds_byte(wc * 32 + fr, fq * 8);
#define PG8_SA(b, h) (((b) * 2 + (h)) * HTB)
#define PG8_SB(b, h) ((4 + (b) * 2 + (h)) * HTB)
#define PG8_STAGE(bufoff, gbase, voff) do { _Pragma("unroll") for (int _i = 0; _i < 2; ++_i) \
        __builtin_amdgcn_global_load_lds((const unsigned*)((const char*)(gbase) + (voff)[_i]), (PG8_LAS unsigned*)(lds + (bufoff) + ldsw + _i * 8192), 16, 0, 0); } while (0)
#define PG8_LDA(dst, b, h) do { _Pragma("unroll") for (int m = 0; m < 4; ++m) _Pragma("unroll") for (int k = 0; k < 2; ++k) dst[m][k] = *(const PG8_LAS bf16x8*)(lds + PG8_SA(b, h) + aoff + m * 2048 + k * 1024); } while (0)
#define PG8_LDB(dst, b, h) do { _Pragma("unroll") for (int n = 0; n < 2; ++n) _Pragma("unroll") for (int k = 0; k < 2; ++k) dst[n][k] = *(const PG8_LAS bf16x8*)(lds + PG8_SB(b, h) + boff + n * 2048 + k * 1024); } while (0)
#define PG8_MMA(ai, bj, At, Bt) do { __builtin_amdgcn_s_setprio(1); _Pragma("unroll") for (int m = 0; m < 4; ++m) _Pragma("unroll") for (int n = 0; n < 2; ++n) _Pragma("unroll") for (int k = 0; k < 2; ++k) \
        acc[ai][bj][m][n] = __builtin_amdgcn_mfma_f32_16x16x32_bf16(Bt[n][k], At[m][k], acc[ai][bj][m][n], 0, 0, 0); __builtin_amdgcn_s_setprio(0); } while (0)
#define PG8_WAIT_V(n) asm volatile("s_waitcnt vmcnt(" #n ")" ::: "memory")
#define PG8_WAIT_L(n) asm volatile("s_waitcnt lgkmcnt(" #n ")" ::: "memory")
#define PG8_BAR __builtin_amdgcn_s_barrier()
#define PG8_SCHED __builtin_amdgcn_sched_barrier(0)
    Unit cur, nxt; int ui = 0;
    if (!S.next(0, cur)) return;
    f32x4 acc[2][2][4][2];
#pragma unroll
    for (int a = 0; a < 2; ++a)
#pragma unroll
        for (int b = 0; b < 2; ++b)
#pragma unroll
            for (int m = 0; m < 4; ++m)
#pragma unroll
                for (int n = 0; n < 2; ++n) acc[a][b][m][n] = (f32x4){0.f, 0.f, 0.f, 0.f};
    bf16x8 At[4][2], B0[2][2], B1[2][2];
    const char* cA = (const char*)g.A + (size_t)cur.pm * tstepA; const char* cB = (const char*)g.Bt + (size_t)cur.pn * tstep;
    S.a_ready(cur);
    if constexpr (SP2) {
        PG8_STAGE(PG8_SB(0, 0), cB, voffB); PG8_STAGE(PG8_SB(0, 1), cB + hstep, voffB); PG8_STAGE(PG8_SA(0, 0), cA, voffA); PG8_STAGE(PG8_SA(0, 1), cA + hstepA, voffA);
        if (wr == 1) PG8_BAR;
        PG8_WAIT_V(2); PG8_BAR;
        PG8_STAGE(PG8_SB(1, 0), cB + kstep, voffB); PG8_STAGE(PG8_SA(1, 0), cA + kstep, voffA); PG8_STAGE(PG8_SB(1, 1), cB + hstep + kstep, voffB);
        PG8_WAIT_V(6); PG8_BAR;
    } else {
        PG8_STAGE(PG8_SB(0, 0), cB, voffB); PG8_STAGE(PG8_SA(0, 0), cA, voffA); PG8_STAGE(PG8_SB(0, 1), cB + hstep, voffB); PG8_STAGE(PG8_SA(0, 1), cA + hstepA, voffA);
        if (wr == 1) PG8_BAR;
        PG8_WAIT_V(4); PG8_BAR;
        PG8_STAGE(PG8_SB(1, 0), cB + kstep, voffB); PG8_STAGE(PG8_SA(1, 0), cA + kstep, voffA); PG8_STAGE(PG8_SB(1, 1), cB + hstep + kstep, voffB);
        PG8_WAIT_V(6); PG8_BAR;
    }
    for (;;) {
        const bool has_next = S.next(ui + 1, nxt);
        const char* nA = has_next ? (const char*)g.A + (size_t)nxt.pm * tstepA : cA; const char* nB = has_next ? (const char*)g.Bt + (size_t)nxt.pn * tstep : cB;
        for (int t = 0; t < nt; t += 2) {
            const bool last = (t == nt - 2);
            const char* a1 = cA + (size_t)(t + 1) * kstep;
            const char* a2 = last ? nA : cA + (size_t)(t + 2) * kstep; const char* b2 = last ? nB : cB + (size_t)(t + 2) * kstep;
            const char* a3 = a2 + kstep; const char* b3 = b2 + kstep;
            if (last && has_next) S.a_ready(nxt);
            if constexpr (SP2) {
            PG8_LDB(B0, 0, 0); PG8_LDB(B1, 0, 1); PG8_SCHED; PG8_LDA(At, 0, 0); PG8_STAGE(PG8_SA(1, 1), a1 + hstepA, voffA);
            PG8_WAIT_V(8); PG8_WAIT_L(0); PG8_BAR; PG8_MMA(0, 0, At, B0); PG8_MMA(0, 1, At, B1); PG8_BAR; PG8_SCHED;
            PG8_LDA(At, 0, 1); PG8_STAGE(PG8_SB(0, 0), b2, voffB); PG8_STAGE(PG8_SB(0, 1), b2 + hstep, voffB); PG8_STAGE(PG8_SA(0, 0), a2, voffA);
            PG8_WAIT_V(8); PG8_WAIT_L(0); PG8_BAR; PG8_MMA(1, 0, At, B0); PG8_MMA(1, 1, At, B1); PG8_BAR; PG8_SCHED;
            PG8_LDB(B0, 1, 0); PG8_LDB(B1, 1, 1); PG8_SCHED; PG8_LDA(At, 1, 0); PG8_STAGE(PG8_SA(0, 1), a2 + hstepA, voffA);
            PG8_WAIT_V(8); PG8_WAIT_L(0); PG8_BAR; PG8_MMA(0, 0, At, B0); PG8_MMA(0, 1, At, B1); PG8_BAR; PG8_SCHED;
            PG8_LDA(At, 1, 1); PG8_STAGE(PG8_SB(1, 0), b3, voffB); PG8_STAGE(PG8_SB(1, 1), b3 + hstep, voffB); PG8_STAGE(PG8_SA(1, 0), a3, voffA);
            PG8_WAIT_V(8); PG8_WAIT_L(0); PG8_BAR; PG8_MMA(1, 0, At, B0); PG8_MMA(1, 1, At, B1); PG8_BAR; PG8_SCHED;
            } else {
            PG8_LDB(B0, 0, 0); PG8_SCHED; PG8_LDA(At, 0, 0); PG8_STAGE(PG8_SA(1, 1), a1 + hstepA, voffA);
            PG8_WAIT_L(8); PG8_BAR; PG8_WAIT_L(0); PG8_MMA(0, 0, At, B0); PG8_BAR; PG8_SCHED;
            PG8_LDB(B1, 0, 1); PG8_STAGE(PG8_SB(0, 0), b2, voffB);
            PG8_BAR; PG8_WAIT_L(0); PG8_MMA(0, 1, At, B1); PG8_BAR;
            PG8_LDA(At, 0, 1); PG8_STAGE(PG8_SA(0, 0), a2, voffA);
            PG8_BAR; PG8_WAIT_L(0); PG8_MMA(1, 0, At, B0); PG8_BAR; PG8_SCHED;
            PG8_STAGE(PG8_SB(0, 1), b2 + hstep, voffB);
            PG8_WAIT_V(6); PG8_BAR; PG8_MMA(1, 1, At, B1); PG8_BAR;
            PG8_LDB(B0, 1, 0); PG8_SCHED; PG8_LDA(At, 1, 0); PG8_STAGE(PG8_SA(0, 1), a2 + hstepA, voffA);
            PG8_WAIT_L(8); PG8_BAR; PG8_WAIT_L(0); PG8_MMA(0, 0, At, B0); PG8_BAR; PG8_SCHED;
            PG8_LDB(B1, 1, 1); PG8_STAGE(PG8_SB(1, 0), b3, voffB);
            PG8_BAR; PG8_WAIT_L(0); PG8_MMA(0, 1, At, B1); PG8_BAR;
            PG8_LDA(At, 1, 1); PG8_STAGE(PG8_SA(1, 0), a3, voffA);
            PG8_BAR; PG8_WAIT_L(0); PG8_MMA(1, 0, At, B0); PG8_BAR; PG8_SCHED;
            PG8_STAGE(PG8_SB(1, 1), b3 + hstep, voffB);
            PG8_WAIT_V(6); PG8_BAR; PG8_MMA(1, 1, At, B1); PG8_BAR;
            }
        }
        if constexpr (ALIGN_EPI) { if (wr == 0) PG8_BAR; }
        if constexpr (!Epi::AFTER_DRAIN) { E(acc, cur, wr, wc, fr, fq); S.done(cur); }
        if (!has_next) break;
#pragma unroll
        for (int a = 0; a < 2; ++a)
#pragma unroll
            for (int b = 0; b < 2; ++b)
#pragma unroll
                for (int m = 0; m < 4; ++m)
#pragma unroll
                    for (int n = 0; n < 2; ++n) acc[a][b][m][n] = (f32x4){0.f, 0.f, 0.f, 0.f};
        cur = nxt; cA = nA; cB = nB; ++ui;
        if constexpr (ALIGN_EPI) { if (wr == 1) PG8_BAR; }
    }
    PG8_WAIT_V(0);
    if constexpr (!ALIGN_EPI) { if (wr == 0) PG8_BAR; }
    PG8_BAR;
    if constexpr (Epi::AFTER_DRAIN) { E.fused(acc, cur, wr, wc, fr, fq, lds, wid, lane); S.done(cur); }
#undef PG8_SA
#undef PG8_SB
#undef PG8_STAGE
#undef PG8_LDA
#undef PG8_LDB
#undef PG8_MMA
#undef PG8_WAIT_V
#undef PG8_WAIT_L
#undef PG8_BAR
#undef PG8_SCHED
}
}

namespace attn_body {
using bf16=__hip_bfloat16;
using bf16x8=__attribute__((ext_vector_type(8)))short;
using s16x4=__attribute__((ext_vector_type(4)))short;
using f32x16=__attribute__((ext_vector_type(16)))float;
using u32x4=__attribute__((ext_vector_type(4)))unsigned;
constexpr int D=64,QP=512,KP=512,VP=512,OP=1024,NT_ALL=132;
constexpr int NW=8,QBLK=32,QB=QBLK*NW,KVBLK=64;
__device__ __forceinline__ int crow(int r,int hi){return (r&3)+8*(r>>2)+4*hi;}
#define SBAR() __builtin_amdgcn_sched_barrier(0)
__device__ __forceinline__ void cmask(f32x16&p0,f32x16&p1,int jb,int qrel,int hi){
  const float NEG=-INFINITY; int kb=64*jb+4*hi;
  #pragma unroll
  for(int r=0;r<16;++r){int kv=kb+(r&3)+8*(r>>2); if(kv>qrel)p0[r]=NEG; if(kv+32>qrel)p1[r]=NEG;}
}

constexpr int NSLOT=3, SLOTB=8192;
constexpr int LDS_K=0, LDS_V=NSLOT*SLOTB, LDS_WS=2*NSLOT*SLOTB, LDS_OST=LDS_WS+NW*64*4, LDS_BYTES=LDS_OST+NW*4096;
constexpr float C2=0.125f*1.4426950408889634f;
__device__ __forceinline__ void glds16(const void*gsrc,unsigned lds_dst){unsigned keep;
  asm volatile("s_mov_b32 %0, m0\n\ts_mov_b32 m0, %2\n\ts_nop 0\n\tglobal_load_lds_dwordx4 %1, off\n\ts_mov_b32 m0, %0":"=&s"(keep):"v"(gsrc),"s"(lds_dst):"memory");}
__device__ __forceinline__ float max3f(float a,float b,float c){float r;asm("v_max3_f32 %0, %1, %2, %3":"=v"(r):"v"(a),"v"(b),"v"(c));return r;}
__device__ __forceinline__ float max2f(float a,float b){float r;asm("v_max_f32_e32 %0, %1, %2":"=v"(r):"v"(a),"v"(b));return r;}
__device__ __forceinline__ float fadd_s(float a,float b){float r;asm("v_add_f32_e32 %0, %1, %2":"=v"(r):"v"(a),"v"(b));return r;}
__device__ __forceinline__ float fsub_s(float a,float b){float r;asm("v_sub_f32_e32 %0, %1, %2":"=v"(r):"v"(a),"v"(b));return r;}
typedef float f32x2_t __attribute__((ext_vector_type(2))); typedef __bf16 bf16x2_t __attribute__((ext_vector_type(2)));
__device__ __forceinline__ unsigned cvtpk_s(float lo,float hi){f32x2_t v={lo,hi};bf16x2_t b=__builtin_convertvector(v,bf16x2_t);return __builtin_bit_cast(unsigned,b);}
#define WAIT_BAR(N) asm volatile("s_waitcnt vmcnt(" #N ") lgkmcnt(0)\n\ts_barrier":::"memory")

__device__ __forceinline__ void qkt(f32x16&p0,f32x16&p1,const char*Kslot,const bf16x8*qr,const f32x16&negm,int r32,int hi){
  const char*kb=Kslot+hi*1024+r32*16;
  #pragma unroll
  for(int d0=0;d0<4;++d0){
    const bf16x8 b0=*reinterpret_cast<const bf16x8*>(kb+d0*2048);
    const bf16x8 b1=*reinterpret_cast<const bf16x8*>(kb+d0*2048+512);
    if(d0==0){p0=__builtin_amdgcn_mfma_f32_32x32x16_bf16(b0,qr[0],negm,0,0,0);p1=__builtin_amdgcn_mfma_f32_32x32x16_bf16(b1,qr[0],negm,0,0,0);}
    else{p0=__builtin_amdgcn_mfma_f32_32x32x16_bf16(b0,qr[d0],p0,0,0,0);p1=__builtin_amdgcn_mfma_f32_32x32x16_bf16(b1,qr[d0],p1,0,0,0);}}
}
typedef __attribute__((address_space(3))) const char* lds_cptr;
typedef short v4i16_t __attribute__((ext_vector_type(4)));
__device__ __forceinline__ void kload8(bf16x8*kf,lds_cptr kp){
  kf[0]=*(const __attribute__((address_space(3))) bf16x8*)(kp);      kf[1]=*(const __attribute__((address_space(3))) bf16x8*)(kp+512);
  kf[2]=*(const __attribute__((address_space(3))) bf16x8*)(kp+2048); kf[3]=*(const __attribute__((address_space(3))) bf16x8*)(kp+2560);
  kf[4]=*(const __attribute__((address_space(3))) bf16x8*)(kp+4096); kf[5]=*(const __attribute__((address_space(3))) bf16x8*)(kp+4608);
  kf[6]=*(const __attribute__((address_space(3))) bf16x8*)(kp+6144); kf[7]=*(const __attribute__((address_space(3))) bf16x8*)(kp+6656);
}
__device__ __forceinline__ void kload2(bf16x8*kf,lds_cptr kp,int j){ kf[2*j]=*(const __attribute__((address_space(3))) bf16x8*)(kp+j*2048); kf[2*j+1]=*(const __attribute__((address_space(3))) bf16x8*)(kp+j*2048+512); }
__device__ __forceinline__ s16x4 vtr(lds_cptr p){ return __builtin_bit_cast(s16x4,__builtin_amdgcn_ds_read_tr16_b64_v4i16((__attribute__((address_space(3))) v4i16_t*)p)); }
__device__ __forceinline__ float rowmax(const f32x16&p0,const f32x16&p1){
  float a=max3f(p0[0],p0[1],p1[0]),b=max3f(p0[2],p0[3],p1[1]);a=max3f(a,p1[2],p1[3]);
  #pragma unroll
  for(int r=4;r<16;r+=4){a=max3f(a,p0[r],p0[r+1]);b=max3f(b,p0[r+2],p0[r+3]);a=max3f(a,p1[r],p1[r+1]);b=max3f(b,p1[r+2],p1[r+3]);}
  const float m=max2f(a,b);
  auto rr=__builtin_amdgcn_permlane32_swap(__float_as_uint(m),__float_as_uint(m),false,false);
  return max2f(__uint_as_float(rr[0]),__uint_as_float(rr[1]));
}
__device__ __forceinline__ void pv(f32x16*o,int vb,bf16x8 pa0,bf16x8 pa1,bf16x8 pa2,bf16x8 pa3){
  #pragma unroll
  for(int d0=0;d0<2;++d0){s16x4 lo[4],hi[4];
    #pragma unroll
    for(int ks=0;ks<4;++ks){
      asm volatile("ds_read_b64_tr_b16 %0,%1 offset:%c2":"=&v"(lo[ks]):"v"(vb),"i"(d0*4096+ks*1024):"memory");
      asm volatile("ds_read_b64_tr_b16 %0,%1 offset:%c2":"=&v"(hi[ks]):"v"(vb),"i"(d0*4096+ks*1024+512):"memory");}
    asm volatile("s_waitcnt lgkmcnt(0)":::"memory");SBAR();
    #define PK(k) (bf16x8){lo[k][0],lo[k][1],lo[k][2],lo[k][3],hi[k][0],hi[k][1],hi[k][2],hi[k][3]}
    o[d0]=__builtin_amdgcn_mfma_f32_32x32x16_bf16(pa0,PK(0),o[d0],0,0,0);
    o[d0]=__builtin_amdgcn_mfma_f32_32x32x16_bf16(pa1,PK(1),o[d0],0,0,0);
    o[d0]=__builtin_amdgcn_mfma_f32_32x32x16_bf16(pa2,PK(2),o[d0],0,0,0);
    o[d0]=__builtin_amdgcn_mfma_f32_32x32x16_bf16(pa3,PK(3),o[d0],0,0,0);
    #undef PK
  }
}

#ifndef ATTN_STORE16
#define ATTN_STORE16(p,v) (*(u32x4*)(p)=(v))
#endif
template<int THRL> __device__ __forceinline__ void attn_unit(const bf16*Qblk,const bf16*__restrict__ Kh,const bf16*__restrict__ Vh,bf16*Oblk,char*shm){
  const int tid=threadIdx.x,lane=tid&63,r32=lane&31,hi=lane>>5; const int wid=__builtin_amdgcn_readfirstlane(tid>>6);
  const bf16*Qw=Qblk+(long)(wid*QBLK)*QP;
  const unsigned lds0=(unsigned)(uintptr_t)shm;
  float*wsf=(float*)(shm+LDS_WS)+wid*64;
  const bf16*ksrc=Kh+(long)lane*KP+wid*8;
  const bf16*vsrc=Vh+(long)(16*(wid&3)+(lane>>2))*VP+(wid>>2)*32+(lane&3)*8;
  const unsigned kdst=lds0+LDS_K+wid*1024, vdst=lds0+LDS_V+wid*1024;
  #define DMA_K(t,slot) glds16(ksrc+(long)(t)*KVBLK*KP,(unsigned)__builtin_amdgcn_readfirstlane(kdst+(slot)))
  #define DMA_V(t,slot) glds16(vsrc+(long)(t)*KVBLK*VP,(unsigned)__builtin_amdgcn_readfirstlane(vdst+(slot)))
  const int vb0=(int)(lds0+LDS_V)+((lane>>4)&1)*32+(lane&3)*8+(4*hi+((lane&15)>>2))*64;
  const char*Kbase=shm+LDS_K; bf16x8 kf[8];
  const lds_cptr shm3=(lds_cptr)shm; const lds_cptr kp0=shm3+LDS_K+hi*1024+r32*16; const lds_cptr vp0=shm3+LDS_V+((lane>>4)&1)*32+(lane&3)*8+(4*hi+((lane&15)>>2))*64;
  const int NT=NT_ALL;
  DMA_K(0,0);DMA_V(0,0);DMA_K(1,SLOTB);
  bf16x8 qr[4];
  #pragma unroll
  for(int d0=0;d0<4;++d0)qr[d0]=*reinterpret_cast<const bf16x8*>(&Qw[(long)r32*QP+d0*16+hi*8]);
  float mhat=0.f,l_reg=0.f;f32x16 o[2];o[0]=f32x16{};o[1]=f32x16{};f32x16 negm=f32x16{};asm volatile("":"+v"(negm));
  #define CMASK(P0,P1,t) do{}while(0)
  bool resc=false;
  #define START(P0,P1) do{ const float rm=rowmax(P0,P1); resc=false; \
    { const float dl=rm; mhat=fadd_s(mhat,dl); \
      _Pragma("unroll") for(int r=0;r<16;++r){P0[r]=fsub_s(P0[r],dl);P1[r]=fsub_s(P1[r],dl);} \
      _Pragma("unroll") for(int r=0;r<16;++r)negm[r]=-mhat; asm volatile("":"+v"(negm)); } \
    _Pragma("unroll") for(int r=0;r<16;++r)P0[r]=__builtin_amdgcn_exp2f(P0[r]); }while(0)
  #define RESC() do{ if(resc){ asm volatile("s_waitcnt lgkmcnt(0)":::"memory"); \
      _Pragma("unroll") for(int d_=0;d_<2;++d_) _Pragma("unroll") for(int r=0;r<16;++r)o[d_][r]*=wsf[crow(r,hi)]; } }while(0)
  f32x16 pA0,pA1,pB0,pB1;
  int sl_prev=0,sl_cur=0,sl_next=SLOTB;
  #define ROT() do{sl_prev=sl_cur;sl_cur=sl_next;sl_next=(sl_next==(NSLOT-1)*SLOTB)?0:sl_next+SLOTB;}while(0)
  DMA_K(2,2*SLOTB);
  WAIT_BAR(3);
  qkt(pA0,pA1,Kbase,qr,negm,r32,hi);asm volatile("s_nop 15\n\ts_nop 7":"+v"(pA0),"+v"(pA1));CMASK(pA0,pA1,0);
  START(pA0,pA1);
  _Pragma("unroll") for(int r=0;r<16;++r)pA1[r]=__builtin_amdgcn_exp2f(pA1[r]);
  WAIT_BAR(0);
  DMA_K(3,0);DMA_V(1,SLOTB);
  ROT();
  kload8(kf,kp0+sl_cur);
  WAIT_BAR(2);
  s16x4 vlo[8],vhi[8]; u32x4 pw0,pw1,pw2,pw3;
  #define PKW(P,B) cvtpk_s(P[B],P[B+1])
  #define PAF(k) __builtin_bit_cast(bf16x8,pw##k)
  #define VFR(i) (bf16x8){vlo[i][0],vlo[i][1],vlo[i][2],vlo[i][3],vhi[i][0],vhi[i][1],vhi[i][2],vhi[i][3]}
  #define PIN(x) asm volatile("":"+v"(x))
  #define MX3(a,b,c) __builtin_fmaxf(__builtin_fmaxf((a),(b)),(c))
  #define GAPA(MF,A0,A1,A2,A3,W0,W1,PW) do{ MF; sacc+=A0; sacc+=A1; sacc+=A2; sacc+=A3; PIN(sacc); W0; W1; PIN(PW); SBAR(); }while(0)
  #define EX(v) __builtin_amdgcn_exp2f(v)
  #define GAPB(MF,X,B) do{ MF; X[B]=EX(X[B]); X[B+1]=EX(X[B+1]); X[B+2]=EX(X[B+2]); X[B+3]=EX(X[B+3]); PIN(X); SBAR(); }while(0)
  #define VRD(i) do{ vlo[i]=vtr(vp_+(((i)>>2)*4096+((i)&3)*1024)); vhi[i]=vtr(vp_+(((i)>>2)*4096+((i)&3)*1024+512)); }while(0)
  #define KRD(G,j) do{ if(G){ kload2(kf,kp0+sl_next,j); SBAR(); } }while(0)
  #define STEP(C0,C1,P0,P1,t,GK,GV,GL) do{ SBAR(); \
    const lds_cptr vp_=vp0+sl_prev; \
    VRD(0); SBAR(); float sacc=(P0[0]+P0[1]); \
    GAPA(C0=__builtin_amdgcn_mfma_f32_32x32x16_bf16(kf[0],qr[0],negm,0,0,0), P0[2],P0[3],P0[4],P0[5],     pw0[0]=PKW(P0,0), pw0[1]=PKW(P0,2), pw0); \
    VRD(4); SBAR(); GAPA(C1=__builtin_amdgcn_mfma_f32_32x32x16_bf16(kf[1],qr[0],negm,0,0,0), P0[6],P0[7],P0[8],P0[9],     pw0[2]=PKW(P0,4), pw0[3]=PKW(P0,6), pw0); \
    VRD(1); SBAR(); GAPA(C0=__builtin_amdgcn_mfma_f32_32x32x16_bf16(kf[2],qr[1],C0,0,0,0),   P0[10],P0[11],P0[12],P0[13], pw1[0]=PKW(P0,8), pw1[1]=PKW(P0,10), pw1); \
    VRD(5); SBAR(); GAPA(C1=__builtin_amdgcn_mfma_f32_32x32x16_bf16(kf[3],qr[1],C1,0,0,0),   P0[14],P0[15],P1[0],P1[1],   pw1[2]=PKW(P0,12),pw1[3]=PKW(P0,14), pw1); \
    VRD(2); SBAR(); GAPA(C0=__builtin_amdgcn_mfma_f32_32x32x16_bf16(kf[4],qr[2],C0,0,0,0),   P1[2],P1[3],P1[4],P1[5],     pw2[0]=PKW(P1,0), pw2[1]=PKW(P1,2), pw2); \
    VRD(6); SBAR(); GAPA(C1=__builtin_amdgcn_mfma_f32_32x32x16_bf16(kf[5],qr[2],C1,0,0,0),   P1[6],P1[7],P1[8],P1[9],     pw2[2]=PKW(P1,4), pw2[3]=PKW(P1,6), pw2); \
    VRD(3); SBAR(); GAPA(C0=__builtin_amdgcn_mfma_f32_32x32x16_bf16(kf[6],qr[3],C0,0,0,0),   P1[10],P1[11],P1[12],P1[13], pw3[0]=PKW(P1,8), pw3[1]=PKW(P1,10), pw3); \
    VRD(7); SBAR(); GAPA(C1=__builtin_amdgcn_mfma_f32_32x32x16_bf16(kf[7],qr[3],C1,0,0,0),   P1[14],P1[15],0.f,0.f,       pw3[2]=PKW(P1,12),pw3[3]=PKW(P1,14), pw3); \
    l_reg+=sacc; \
    if(GK){DMA_K((t)+3,sl_cur);} if(GV){DMA_V((t)+1,sl_next);} \
    CMASK(C0,C1,t); \
    { float a=MX3(C0[0],C0[1],C1[0]),b=MX3(C0[2],C0[3],C1[1]); a=MX3(a,C1[2],C1[3]); \
      _Pragma("unroll") for(int r=4;r<16;r+=4){a=MX3(a,C0[r],C0[r+1]);b=MX3(b,C0[r+2],C0[r+3]);a=MX3(a,C1[r],C1[r+1]);b=MX3(b,C1[r+2],C1[r+3]);} \
      float rm=__builtin_fmaxf(a,b); { auto rr=__builtin_amdgcn_permlane32_swap(__float_as_uint(rm),__float_as_uint(rm),false,false); rm=__builtin_fmaxf(__uint_as_float(rr[0]),__uint_as_float(rr[1])); } \
      resc=false; \
      if(__builtin_expect(__any(rm>(float)THRL),0)){ const float dl=__builtin_fmaxf(rm,0.f); mhat+=dl; \
        _Pragma("unroll") for(int r=0;r<16;++r){C0[r]-=dl;C1[r]-=dl;} \
        _Pragma("unroll") for(int r=0;r<16;++r)negm[r]=-mhat; asm volatile("":"+v"(negm)); \
        const float f=__builtin_amdgcn_exp2f(-dl); l_reg*=f; if(hi==0)wsf[r32]=f; resc=true; } } \
    SBAR(); \
    GAPB(o[0]=__builtin_amdgcn_mfma_f32_32x32x16_bf16(PAF(0),VFR(0),o[0],0,0,0), C0,0); \
    GAPB(o[1]=__builtin_amdgcn_mfma_f32_32x32x16_bf16(PAF(0),VFR(4),o[1],0,0,0), C0,4); \
    KRD(GL,0); GAPB(o[0]=__builtin_amdgcn_mfma_f32_32x32x16_bf16(PAF(1),VFR(1),o[0],0,0,0), C0,8); \
    KRD(GL,1); GAPB(o[1]=__builtin_amdgcn_mfma_f32_32x32x16_bf16(PAF(1),VFR(5),o[1],0,0,0), C0,12); \
    KRD(GL,2); GAPB(o[0]=__builtin_amdgcn_mfma_f32_32x32x16_bf16(PAF(2),VFR(2),o[0],0,0,0), C1,0); \
    KRD(GL,3); GAPB(o[1]=__builtin_amdgcn_mfma_f32_32x32x16_bf16(PAF(2),VFR(6),o[1],0,0,0), C1,4); \
    GAPB(o[0]=__builtin_amdgcn_mfma_f32_32x32x16_bf16(PAF(3),VFR(3),o[0],0,0,0), C1,8); \
    GAPB(o[1]=__builtin_amdgcn_mfma_f32_32x32x16_bf16(PAF(3),VFR(7),o[1],0,0,0), C1,12); \
    }while(0)
  int t=1;
  #undef CMASK
  #define CMASK(P0,P1,t) do{}while(0)
  for(;t+5<NT;t+=2){
    STEP(pB0,pB1,pA0,pA1,t,true,true,true);     WAIT_BAR(2); RESC(); ROT();
    STEP(pA0,pA1,pB0,pB1,t+1,true,true,true);   WAIT_BAR(2); RESC(); ROT();
  }
  #undef CMASK
  #define CMASK(P0,P1,t) do{}while(0)
  #define ENDW(tt) do{ if((tt)+3<NT){WAIT_BAR(2);} else if((tt)+2<NT){WAIT_BAR(1);} else {WAIT_BAR(0);} }while(0)
  for(;t+1<NT;t+=2){
    STEP(pB0,pB1,pA0,pA1,t,(t+3<NT),(t+1<NT),(t+1<NT));       ENDW(t);   RESC(); ROT();
    STEP(pA0,pA1,pB0,pB1,t+1,(t+4<NT),(t+2<NT),(t+2<NT));     ENDW(t+1); RESC(); ROT();
  }
  STEP(pB0,pB1,pA0,pA1,NT-1,false,false,false); RESC();
  { float sacc=pB0[0]+pB0[1]; _Pragma("unroll") for(int r=2;r<16;++r)sacc+=pB0[r]; _Pragma("unroll") for(int r=0;r<16;++r)sacc+=pB1[r]; l_reg+=sacc;
    pw0=(u32x4){PKW(pB0,0),PKW(pB0,2),PKW(pB0,4),PKW(pB0,6)};pw1=(u32x4){PKW(pB0,8),PKW(pB0,10),PKW(pB0,12),PKW(pB0,14)};pw2=(u32x4){PKW(pB1,0),PKW(pB1,2),PKW(pB1,4),PKW(pB1,6)};pw3=(u32x4){PKW(pB1,8),PKW(pB1,10),PKW(pB1,12),PKW(pB1,14)};
    SBAR(); pv(o,vb0+sl_cur,PAF(0),PAF(1),PAF(2),PAF(3)); }
  #undef PKW
  #undef PAF
  #undef VFR
  #undef PIN
  #undef MX3
  #undef GAPA
  #undef GAPB
  #undef EX
  #undef VRD
  #undef KRD
  #undef STEP
  #undef ENDW
  {auto rr=__builtin_amdgcn_permlane32_swap(__float_as_uint(l_reg),__float_as_uint(l_reg),false,false);l_reg=__uint_as_float(rr[0])+__uint_as_float(rr[1]);}
  if(hi==0)wsf[32+r32]=l_reg;asm volatile("s_waitcnt lgkmcnt(0)":::"memory");
  float rli[16];
  #pragma unroll
  for(int r=0;r<16;++r)rli[r]=__builtin_amdgcn_rcpf(wsf[32+crow(r,hi)]);
  bf16*Ow=Oblk+(long)(wid*QBLK)*OP;
  { bf16*stg=(bf16*)(shm+LDS_OST)+wid*2048;
    #pragma unroll
    for(int r=0;r<16;++r){const int orow=crow(r,hi);
      #pragma unroll
      for(int d0=0;d0<2;++d0)stg[orow*64+d0*32+r32]=__float2bfloat16(o[d0][r]*rli[r]);}
    asm volatile("s_waitcnt lgkmcnt(0)":::"memory");
    #pragma unroll
    for(int i=0;i<4;++i){const int row=i*8+(lane>>3),ch=lane&7; const u32x4 v=*(const u32x4*)(stg+row*64+ch*8); ATTN_STORE16(Ow+(long)row*OP+ch*8,v);} }
  asm volatile("s_waitcnt lgkmcnt(0)\n\ts_barrier":::"memory");
  #undef DMA_K
  #undef DMA_V
  #undef CMASK
  #undef START
  #undef RESC
  #undef ROT
}
constexpr int ATTN_LDS_BYTES=LDS_BYTES;
#undef SBAR
#undef WAIT_BAR
}


#define GAS __attribute__((address_space(1)))
#define LAS __attribute__((address_space(3)))
typedef unsigned short bf16;
typedef unsigned v4u __attribute__((ext_vector_type(4)));
typedef unsigned v2u __attribute__((ext_vector_type(2)));
typedef float f32x4 __attribute__((ext_vector_type(4)));
typedef short bf16x8 __attribute__((ext_vector_type(8)));
typedef GAS unsigned gu32;

constexpr int NWAVES = 8, NTHR = 512;
constexpr int DM = 1024, NB = 4, SEQ = 8192, NTOK = NB * SEQ, CTX = 256, NCTX = NB * CTX, DFF = 2816, NKV = SEQ + CTX;
constexpr int DHY = 512, NIN = 3072, NUP = 2 * DFF;
constexpr float EPS = 1e-6f;
constexpr int SLAB_TILES = 133;
constexpr size_t MiB = 1u << 20;
constexpr size_t WS_CTL = 0, WS_STAT = 1 * MiB, WS_MOD = 2 * MiB, WS_CMOD = WS_MOD + 256 * 1024, WS_ROPE = WS_CMOD + 16 * 1024, WS_H2 = 3 * MiB;
constexpr size_t WS_WIN = 8 * MiB, WS_WOUT = 14 * MiB, WS_WUP0 = 16 * MiB, WS_WUP1 = 27 * MiB, WS_WDN0 = 38 * MiB, WS_WDN1 = 44 * MiB, WS_WSIN = 50 * MiB, WS_WSOUT = 54 * MiB, WS_W3 = 56 * MiB, WS_WS = 57 * MiB;
constexpr size_t WS_ACT = 58 * MiB, WS_HC = 124 * MiB, WS_R = 126 * MiB, WS_HY = 158 * MiB, WS_Q = 254 * MiB, WS_K = 286 * MiB, WS_V = 320 * MiB, WS_O = 354 * MiB, WS_YAT = 418 * MiB, WS_END = 450 * MiB;
constexpr size_t WS_HID = 158 * MiB, WS_SU = 158 * MiB, WS_SV = 222 * MiB;
static_assert(WS_ACT + (size_t)(NTOK + 301) * DM * 2 <= WS_HC && WS_HID + (size_t)NTOK * DFF * 2 <= WS_O, "ws map");
constexpr int LDS_BYTES = 147456, RING_BYTES = 131072, MISC_OFF = RING_BYTES;

#define RLX_AGENT __ATOMIC_RELAXED, __HIP_MEMORY_SCOPE_AGENT
#define LDS_WAIT() asm volatile("s_waitcnt lgkmcnt(0)" ::: "memory")
__device__ __forceinline__ unsigned f2bf(float f) { unsigned u = __builtin_bit_cast(unsigned, f); return (u + 0x7fffu + ((u >> 16) & 1u)) >> 16; }
__device__ __forceinline__ unsigned pk2(float lo, float hi) { return f2bf(lo) | (f2bf(hi) << 16); }
__device__ __forceinline__ float bf2f(unsigned h) { return __builtin_bit_cast(float, h << 16); }
__device__ __forceinline__ float bflo(unsigned w) { return __builtin_bit_cast(float, w << 16); }
__device__ __forceinline__ float bfhi(unsigned w) { return __builtin_bit_cast(float, w & 0xffff0000u); }
__device__ __forceinline__ float wave_sum(float v) {
#pragma unroll
    for (int o = 1; o < 64; o <<= 1) v += __shfl_xor(v, o);
    return v;
}
#ifndef USE_DPP
#define USE_DPP 0
#endif
__device__ __forceinline__ float rot_prev(float v) {
#if USE_DPP
    return __builtin_bit_cast(float, __builtin_amdgcn_update_dpp(0, __builtin_bit_cast(int, v), 0x121, 0xf, 0xf, false));
#else
    const int l = threadIdx.x & 63; return __shfl(v, (l & 48) | ((l - 1) & 15));
#endif
}
__device__ __forceinline__ float rot_next(float v) {
#if USE_DPP
    return __builtin_bit_cast(float, __builtin_amdgcn_update_dpp(0, __builtin_bit_cast(int, v), 0x12F, 0xf, 0xf, false));
#else
    const int l = threadIdx.x & 63; return __shfl(v, (l & 48) | ((l + 1) & 15));
#endif
}
__device__ __forceinline__ f32x4 rot_prev4(f32x4 v) { return (f32x4){rot_prev(v[0]), rot_prev(v[1]), rot_prev(v[2]), rot_prev(v[3])}; }
__device__ __forceinline__ f32x4 rot_next4(f32x4 v) { return (f32x4){rot_next(v[0]), rot_next(v[1]), rot_next(v[2]), rot_next(v[3])}; }

namespace epi {
using pg8::Unit; using pg8::bf16_t;
typedef float f32x4 __attribute__((ext_vector_type(4)));

struct EpiInProj {
    static constexpr bool PERM = false, AFTER_DRAIN = false;
    bf16_t* HY; bf16_t* Q; bf16_t* Kb; bf16_t* Vb; const float* cw; const float* cb; const float* rope;
    __device__ __forceinline__ void operator()(const f32x4 (&acc)[2][2][4][2], const Unit& u, int wr, int wc, int fr, int fq) const {
        if (u.pn < 6) {
#pragma unroll
            for (int ai = 0; ai < 2; ++ai) {
                const int gbase = 248 * u.pm + 62 * (2 * ai + wr) - 1;
#pragma unroll
                for (int bj = 0; bj < 2; ++bj)
#pragma unroll
                    for (int n = 0; n < 2; ++n) {
                        const int col = 256 * u.pn + 128 * bj + 32 * wc + 16 * n + 4 * fq;
                        const f32x4 w0 = *(const f32x4*)(cw + col), w1 = *(const f32x4*)(cw + 1536 + col), w2 = *(const f32x4*)(cw + 3072 + col), bb = *(const f32x4*)(cb + col);
                        f32x4 rp_prev = (f32x4){0.f, 0.f, 0.f, 0.f}, rn_cur = rot_next4(acc[ai][bj][0][n]);
#pragma unroll
                        for (int m = 0; m < 4; ++m) {
                            const int j = 16 * m + fr, g = gbase + j, t = g & (SEQ - 1), b = g >> 13;
                            const f32x4 rp_cur = rot_prev4(acc[ai][bj][m][n]);
                            const f32x4 rn_next = (m < 3) ? rot_next4(acc[ai][bj][m < 3 ? m + 1 : 3][n]) : rn_cur;
                            f32x4 p = (fr == 0) ? rp_prev : rp_cur;
                            f32x4 q = (fr == 15) ? rn_next : rn_cur;
                            rp_prev = rp_cur; rn_cur = rn_next;
                            if (t == 0) p = (f32x4){0.f, 0.f, 0.f, 0.f};
                            if (t == SEQ - 1) q = (f32x4){0.f, 0.f, 0.f, 0.f};
                            const f32x4 o = w0 * p + w1 * acc[ai][bj][m][n] + w2 * q + bb;
                            if (j >= 1 && j <= 62 && g < NTOK) {
                                bf16_t* dst = HY + ((size_t)(b * 1536 + col) * SEQ + t);
                                dst[0] = (bf16_t)f2bf(o[0]); dst[SEQ] = (bf16_t)f2bf(o[1]); dst[2 * SEQ] = (bf16_t)f2bf(o[2]); dst[3 * SEQ] = (bf16_t)f2bf(o[3]);
                            }
                        }
                        asm volatile("" ::: "memory");
                    }
            }
        } else if (u.pn < 10) {
            const bool isq = u.pn < 8;
            const float sc = isq ? attn_body::C2 : 1.0f;
#pragma unroll
            for (int ai = 0; ai < 2; ++ai) {
                const int gbase = 248 * u.pm + 62 * (2 * ai + wr) - 1;
#pragma unroll
                for (int m = 0; m < 4; ++m) {
                    const int j = 16 * m + fr, g = gbase + j, t = g & (SEQ - 1), b = g >> 13;
                    const bool ok = (j >= 1 && j <= 62 && g < NTOK);
                    const int pos = (wc & 1) ? (t & 63) : (t >> 6);
                    const float* rp = rope + (size_t)(pos * 16 + 4 * fq) * 2;
                    const f32x4 cs0 = *(const f32x4*)rp, cs1 = *(const f32x4*)(rp + 4);
                    const f32x4 cc = (f32x4){cs0[0], cs0[2], cs1[0], cs1[2]}, ss = (f32x4){cs0[1], cs0[3], cs1[1], cs1[3]};
#pragma unroll
                    for (int bj = 0; bj < 2; ++bj) {
                        const f32x4 x1 = acc[ai][bj][m][0], x2 = acc[ai][bj][m][1];
                        const f32x4 o1 = (x1 * cc - x2 * ss) * sc, o2 = (x1 * ss + x2 * cc) * sc;
                        const int col = 256 * (u.pn - (isq ? 6 : 8)) + 128 * bj + 32 * wc + 4 * fq;
                        if (ok) {
                            bf16_t* dst = isq ? (Q + (size_t)g * 512 + col) : (Kb + ((size_t)b * NKV + CTX + t) * 512 + col);
                            *(v2u*)dst = (v2u){pk2(o1[0], o1[1]), pk2(o1[2], o1[3])};
                            *(v2u*)(dst + 16) = (v2u){pk2(o2[0], o2[1]), pk2(o2[2], o2[3])};
                        }
                    }
                    asm volatile("" ::: "memory");
                }
            }
        } else {
#pragma unroll
            for (int ai = 0; ai < 2; ++ai) {
                const int gbase = 248 * u.pm + 62 * (2 * ai + wr) - 1;
#pragma unroll
                for (int m = 0; m < 4; ++m) {
                    const int j = 16 * m + fr, g = gbase + j, t = g & (SEQ - 1), b = g >> 13;
                    if (j >= 1 && j <= 62 && g < NTOK) {
#pragma unroll
                        for (int bj = 0; bj < 2; ++bj)
#pragma unroll
                            for (int n = 0; n < 2; ++n) {
                                const int col = 256 * (u.pn - 10) + 128 * bj + 32 * wc + 16 * n + 4 * fq;
                                const f32x4 v = acc[ai][bj][m][n];
                                *(v2u*)(Vb + ((size_t)b * NKV + CTX + t) * 512 + col) = (v2u){pk2(v[0], v[1]), pk2(v[2], v[3])};
                            }
                    }
                }
            }
        }
    }
};

struct EpiCtxKV {
    static constexpr bool PERM = false, AFTER_DRAIN = false;
    bf16_t* Kb; bf16_t* Vb;
    __device__ __forceinline__ void operator()(const f32x4 (&acc)[2][2][4][2], const Unit& u, int wr, int wc, int fr, int fq) const {
#pragma unroll
        for (int ai = 0; ai < 2; ++ai)
#pragma unroll
            for (int m = 0; m < 4; ++m) {
                const int row = 256 * u.pm + 128 * ai + 64 * wr + 16 * m + fr, b = row >> 8, tc = row & 255;
#pragma unroll
                for (int bj = 0; bj < 2; ++bj)
#pragma unroll
                    for (int n = 0; n < 2; ++n) {
                        const int col = 256 * u.pn + 128 * bj + 32 * wc + 16 * n + 4 * fq;
                        const f32x4 v = acc[ai][bj][m][n];
                        bf16_t* dst = (col < 512) ? (Kb + ((size_t)b * NKV + tc) * 512 + col) : (Vb + ((size_t)b * NKV + tc) * 512 + (col - 512));
                        *(v2u*)dst = (v2u){pk2(v[0], v[1]), pk2(v[2], v[3])};
                    }
            }
    }
};

struct EpiResid {
    static constexpr bool PERM = false, AFTER_DRAIN = false;
    const float* base; float* out; const float* gate;
    __device__ __forceinline__ void operator()(const f32x4 (&acc)[2][2][4][2], const Unit& u, int wr, int wc, int fr, int fq) const {
#pragma unroll
        for (int ai = 0; ai < 2; ++ai)
#pragma unroll
            for (int m = 0; m < 4; ++m) {
                const int row = 256 * u.pm + 128 * ai + 64 * wr + 16 * m + fr, b = row >> 13;
#pragma unroll
                for (int bj = 0; bj < 2; ++bj)
#pragma unroll
                    for (int n = 0; n < 2; ++n) {
                        const int col = 256 * u.pn + 128 * bj + 32 * wc + 16 * n + 4 * fq;
                        const f32x4 gt = *(const f32x4*)(gate + b * 6144 + col), bs = *(const f32x4*)(base + (size_t)row * DM + col);
                        *(f32x4*)(out + (size_t)row * DM + col) = bs + gt * acc[ai][bj][m][n];
                    }
            }
    }
};

struct EpiFfnUp {
    static constexpr bool PERM = true, AFTER_DRAIN = false;
    bf16_t* H; const float* cw; const float* cb;
    __device__ __forceinline__ void operator()(const f32x4 (&acc)[2][2][4][2], const Unit& u, int wr, int wc, int fr, int fq) const {
#pragma unroll
        for (int ai = 0; ai < 2; ++ai) {
            const int gbase = 248 * u.pm + 62 * (2 * ai + wr) - 1;
#pragma unroll
            for (int n = 0; n < 2; ++n) {
                const int ch = 128 * u.pn + 32 * wc + 8 * fq + 4 * n;
                const f32x4 g0 = *(const f32x4*)(cw + ch), g1 = *(const f32x4*)(cw + NUP + ch), g2 = *(const f32x4*)(cw + 2 * NUP + ch), gb = *(const f32x4*)(cb + ch);
                const f32x4 u0 = *(const f32x4*)(cw + DFF + ch), u1 = *(const f32x4*)(cw + NUP + DFF + ch), u2 = *(const f32x4*)(cw + 2 * NUP + DFF + ch), ub = *(const f32x4*)(cb + DFF + ch);
                const f32x4 z = (f32x4){0.f, 0.f, 0.f, 0.f};
                f32x4 gp_prev = z, up_prev = z, gn_cur = rot_next4(acc[ai][0][0][n]), un_cur = rot_next4(acc[ai][1][0][n]);
#pragma unroll
                for (int m = 0; m < 4; ++m) {
                    const int j = 16 * m + fr, g = gbase + j, t = g & (SEQ - 1);
                    const f32x4 gp_cur = rot_prev4(acc[ai][0][m][n]), up_cur = rot_prev4(acc[ai][1][m][n]);
                    const f32x4 gn_next = (m < 3) ? rot_next4(acc[ai][0][m < 3 ? m + 1 : 3][n]) : gn_cur, un_next = (m < 3) ? rot_next4(acc[ai][1][m < 3 ? m + 1 : 3][n]) : un_cur;
                    f32x4 pg = (fr == 0) ? gp_prev : gp_cur, ng = (fr == 15) ? gn_next : gn_cur;
                    f32x4 pu = (fr == 0) ? up_prev : up_cur, nu = (fr == 15) ? un_next : un_cur;
                    gp_prev = gp_cur; up_prev = up_cur; gn_cur = gn_next; un_cur = un_next;
                    if (t == 0) { pg = z; pu = z; }
                    if (t == SEQ - 1) { ng = z; nu = z; }
                    const f32x4 gc = g0 * pg + g1 * acc[ai][0][m][n] + g2 * ng + gb;
                    const f32x4 uc = u0 * pu + u1 * acc[ai][1][m][n] + u2 * nu + ub;
                    f32x4 h;
#pragma unroll
                    for (int e = 0; e < 4; ++e) h[e] = gc[e] / (1.0f + __expf(-gc[e])) * uc[e];
                    if (j >= 1 && j <= 62 && g < NTOK) *(v2u*)(H + (size_t)g * DFF + ch) = (v2u){pk2(h[0], h[1]), pk2(h[2], h[3])};
                }
                asm volatile("" ::: "memory");
            }
        }
    }
};

struct EpiSguIn {
    static constexpr bool PERM = true, AFTER_DRAIN = false;
    bf16_t* U; bf16_t* V; const float* bias; float* stat;
    __device__ __forceinline__ void operator()(const f32x4 (&acc)[2][2][4][2], const Unit& u, int wr, int wc, int fr, int fq) const {
        const bool isv = u.pn >= 4;
#pragma unroll
        for (int ai = 0; ai < 2; ++ai)
#pragma unroll
            for (int m = 0; m < 4; ++m) {
                const int row = 256 * u.pm + 128 * ai + 64 * wr + 16 * m + fr;
                float s = 0.f, s2 = 0.f;
#pragma unroll
                for (int bj = 0; bj < 2; ++bj) {
                    const int col = 256 * u.pn + 128 * bj + 32 * wc + 8 * fq;
                    const f32x4 b0 = *(const f32x4*)(bias + col), b1 = *(const f32x4*)(bias + col + 4);
                    const f32x4 v0 = acc[ai][bj][m][0] + b0, v1 = acc[ai][bj][m][1] + b1;
                    const pg8::f32x2 a = pg8::gelu_pk((pg8::f32x2){v0[0], v0[1]}), b = pg8::gelu_pk((pg8::f32x2){v0[2], v0[3]}), c = pg8::gelu_pk((pg8::f32x2){v1[0], v1[1]}), d = pg8::gelu_pk((pg8::f32x2){v1[2], v1[3]});
                    s += (a.x + a.y) + (b.x + b.y) + (c.x + c.y) + (d.x + d.y);
                    s2 += (a.x * a.x + a.y * a.y) + (b.x * b.x + b.y * b.y) + (c.x * c.x + c.y * c.y) + (d.x * d.x + d.y * d.y);
                    bf16_t* dst = (isv ? V : U) + (size_t)row * DM + (col & 1023);
                    *(v4u*)dst = (v4u){pk2(a.x, a.y), pk2(b.x, b.y), pk2(c.x, c.y), pk2(d.x, d.y)};
                }
                if (isv) {
                    s += __shfl_xor(s, 16); s += __shfl_xor(s, 32); s2 += __shfl_xor(s2, 16); s2 += __shfl_xor(s2, 32);
                    if (fq == 0) { atomicAdd(stat + 2 * row, s); atomicAdd(stat + 2 * row + 1, s2); }
                }
            }
    }
};
}

typedef const float* fptr_t;
typedef __attribute__((address_space(4))) const fptr_t* ktab;
struct Ctx {
    LAS unsigned char* lds; unsigned char* ldsg; int tid, lane, wave, G, bx;
    ktab kin; float* out; unsigned char* ws;
};
__device__ __forceinline__ const float* ld_in(ktab t, int k) { asm volatile("" : "+s"(t)); return t[k]; }
#define INP(k) ld_in(C.kin, (k))
#define WSP(T, off) ((T*)(C.ws + (off)))

__device__ __forceinline__ void p0_transpose_item(const float* W, int ldw, int k0, int n0, bf16* WT, int ldt, int drow0, LAS float* scr, int lane) {
#pragma unroll 8
    for (int i = 0; i < 32; ++i) { const int kk = 2 * i + (lane >> 5); scr[kk * 33 + (lane & 31)] = W[(size_t)(k0 + kk) * ldw + n0 + (lane & 31)]; }
    LDS_WAIT(); asm volatile("" ::: "memory");
    const int c = lane & 7;
#pragma unroll
    for (int j = 0; j < 4; ++j) { const int n = (lane >> 3) + 8 * j; const LAS float* s = scr + (8 * c) * 33 + n;
        v4u o; o.x = pk2(s[0 * 33], s[1 * 33]); o.y = pk2(s[2 * 33], s[3 * 33]); o.z = pk2(s[4 * 33], s[5 * 33]); o.w = pk2(s[6 * 33], s[7 * 33]);
        *(v4u*)(WT + (size_t)(drow0 + n) * ldt + k0 + 8 * c) = o; }
    LDS_WAIT(); asm volatile("" ::: "memory");
}
__device__ __forceinline__ void p0_mat(const float* W, int K, int N, bf16* WT, int ldt, int item, bool ffn_perm, LAS float* scr, int lane) {
    const int nblk = N / 32, kb = item / nblk, nb = item % nblk, n0 = 32 * nb;
    int drow0 = n0;
    if (ffn_perm) { const int s = n0 / DFF, ch = n0 % DFF; drow0 = 256 * (ch >> 7) + 128 * s + (ch & 127); }
    p0_transpose_item(W, N, 64 * kb, n0, WT, ldt, drow0, scr, lane);
}
__device__ __forceinline__ float silu_f(float v) { return v / (1.0f + __expf(-v)); }

__device__ __forceinline__ void phase_p0(Ctx& C) {
    LAS float* scr = (LAS float*)(C.lds + C.wave * 16384);
    const int gw = C.bx * NWAVES + C.wave, NGW = C.G * NWAVES, lane = C.lane;
    const int gt = C.bx * NTHR + C.tid, NGT = C.G * NTHR;
    constexpr int I_IN = 16 * 96, I_OUT = 16 * 32, I_UP = 16 * 176, I_DN = 44 * 32, I_SIN = 16 * 64, I_SOUT = 16 * 32;
    constexpr int NITEMS = I_IN + I_OUT + 2 * I_UP + 2 * I_DN + I_SIN + I_SOUT;
    for (int it = gw; it < NITEMS; it += NGW) {
        int r = it;
        if (r < I_IN) { p0_mat(INP(12), 1024, NIN, WSP(bf16, WS_WIN), 1024, r, false, scr, lane); continue; } r -= I_IN;
        if (r < I_OUT) { p0_mat(INP(24), 1024, 1024, WSP(bf16, WS_WOUT), 1024, r, false, scr, lane); continue; } r -= I_OUT;
        if (r < I_UP) { p0_mat(INP(8), 1024, NUP, WSP(bf16, WS_WUP0), 1024, r, true, scr, lane); continue; } r -= I_UP;
        if (r < I_UP) { p0_mat(INP(8) + (size_t)1024 * NUP, 1024, NUP, WSP(bf16, WS_WUP1), 1024, r, true, scr, lane); continue; } r -= I_UP;
        if (r < I_DN) { p0_mat(INP(11), DFF, 1024, WSP(bf16, WS_WDN0), DFF, r, false, scr, lane); continue; } r -= I_DN;
        if (r < I_DN) { p0_mat(INP(11) + (size_t)DFF * 1024, DFF, 1024, WSP(bf16, WS_WDN1), DFF, r, false, scr, lane); continue; } r -= I_DN;
        if (r < I_SIN) { p0_mat(INP(25), 1024, 2048, WSP(bf16, WS_WSIN), 1024, r, false, scr, lane); continue; } r -= I_SIN;
        p0_mat(INP(31), 1024, 1024, WSP(bf16, WS_WSOUT), 1024, r, false, scr, lane);
    }
    for (int i = gt; i < 8 * 128 * 128 / 8; i += NGT) { const float* s = INP(29) + (size_t)i * 8; const f32x4 a = *(const f32x4*)s, b = *(const f32x4*)(s + 4);
        *(v4u*)(WSP(bf16, WS_WS) + (size_t)i * 8) = (v4u){pk2(a[0], a[1]), pk2(a[2], a[3]), pk2(b[0], b[1]), pk2(b[2], b[3])}; }
    for (int i = gt; i < NTOK * 2 / 4; i += NGT) *(f32x4*)(WSP(float, WS_STAT) + (size_t)i * 4) = (f32x4){0.f, 0.f, 0.f, 0.f};
    for (int i = gt; i < 128 * 16; i += NGT) { const int pos = i >> 4, k = i & 15; const float inv = powf(10000.0f, -(float)k / 16.0f), ang = (float)pos * inv; float sn, cs; sincosf(ang, &sn, &cs);
        WSP(float, WS_ROPE)[2 * i] = cs; WSP(float, WS_ROPE)[2 * i + 1] = sn; }
    if (C.bx == 0 && C.tid < 8) WSP(unsigned, WS_CTL)[64 * C.tid] = 0u;
    {
        const float* w1 = INP(15); const float* b1 = INP(16); const float* fr = INP(17); const float* w2 = INP(18); const float* b2 = INP(19);
        const float f0 = fr[lane], f1 = fr[64 + lane], bb1 = b1[lane], bb2 = b2[lane];
        for (int t = gw; t < SEQ; t += NGW) {
            float z = 0.f;
            if (lane == 0) z = (float)t * (1.0f / 8191.0f);
            else if (lane <= 32) { const int k = (lane - 1) & 15; const float band = 1e-4f + (float)k * ((15.0f - 1e-4f) / 15.0f);
                const float ang = ((6.283185307179586f / 8192.0f) * (float)t) * band; z = (lane <= 16) ? cosf(ang) : -sinf(ang); }
            float a = bb1;
#pragma unroll
            for (int i = 0; i < 33; ++i) a += __shfl(z, i) * w1[i * 64 + lane];
            const float h1 = sinf(f0 * a);
            float a2 = bb2;
#pragma unroll 16
            for (int i = 0; i < 64; ++i) a2 += __shfl(h1, i) * w2[i * 64 + lane];
            const float h2 = sinf(f1 * a2);
            WSP(float, WS_H2)[(size_t)lane * SEQ + t] = h2;
        }
    }
    __syncthreads();
    {
        LAS float* red = (LAS float*)C.lds;
        for (int it = C.bx; it < 2 * 96; it += C.G) {
            const int l = it / 96, cb = it % 96, col = cb * 64 + lane;
            const float* W = INP(4) + (size_t)l * 1024 * 6144;
            float a0 = 0.f, a1 = 0.f, a2 = 0.f, a3 = 0.f, a4 = 0.f;
            const int kbeg = C.wave * 128;
#pragma unroll 4
            for (int k = kbeg; k < kbeg + 128; ++k) {
                const float w = W[(size_t)k * 6144 + col];
                a0 += silu_f(INP(1)[k]) * w; a1 += silu_f(INP(1)[1024 + k]) * w; a2 += silu_f(INP(1)[2048 + k]) * w; a3 += silu_f(INP(1)[3072 + k]) * w; a4 += silu_f(INP(3)[k]) * w;
            }
            red[(C.wave * 5 + 0) * 64 + lane] = a0; red[(C.wave * 5 + 1) * 64 + lane] = a1; red[(C.wave * 5 + 2) * 64 + lane] = a2; red[(C.wave * 5 + 3) * 64 + lane] = a3; red[(C.wave * 5 + 4) * 64 + lane] = a4;
            __syncthreads();
            if (C.tid < 320) { const int v = C.tid >> 6, cc = C.tid & 63; float s = 0.f;
#pragma unroll
                for (int w = 0; w < 8; ++w) s += red[(w * 5 + v) * 64 + cc];
                const int oc = cb * 64 + cc; s += INP(5)[l * 6144 + oc];
                if (v < 4) WSP(float, WS_MOD)[(size_t)(l * 4 + v) * 6144 + oc] = s;
                else if (l == 0 && oc < 2048) WSP(float, WS_CMOD)[oc] = s; }
            __syncthreads();
        }
    }
}

__device__ __forceinline__ void phase_norm_mod(Ctx& C, const float* src, int rows, int rows_per_batch, const float* g, const float* shift, const float* scale, int bstride, bf16* dst) {
    const int gw = C.bx * NWAVES + C.wave, NGW = C.G * NWAVES, lane = C.lane;
    for (int r = gw; r < rows; r += NGW) {
        const f32x4* xr = (const f32x4*)(src + (size_t)r * DM) + lane;
        const int b = r / rows_per_batch;
        f32x4 v[4]; float s = 0.f;
#pragma unroll
        for (int j = 0; j < 4; ++j) { v[j] = xr[64 * j]; s += (v[j][0] * v[j][0] + v[j][1] * v[j][1]) + (v[j][2] * v[j][2] + v[j][3] * v[j][3]); }
        const float rstd = 1.0f / sqrtf(wave_sum(s) * (1.0f / DM) + EPS);
        v2u* o = (v2u*)(dst + (size_t)r * DM) + lane;
#pragma unroll
        for (int j = 0; j < 4; ++j) {
            const int col = 4 * (lane + 64 * j);
            const f32x4 gg = *(const f32x4*)(g + col), sh = *(const f32x4*)(shift + (size_t)b * bstride + col), sc = *(const f32x4*)(scale + (size_t)b * bstride + col);
            const f32x4 y = (v[j] * rstd) * gg * (sc + 1.0f) + sh;
            o[64 * j] = (v2u){pk2(y[0], y[1]), pk2(y[2], y[3])};
        }
    }
}
__device__ __forceinline__ void phase_final_norm(Ctx& C, float* x, const float* g) {
    const int gw = C.bx * NWAVES + C.wave, NGW = C.G * NWAVES, lane = C.lane;
    for (int r = gw; r < NTOK; r += NGW) {
        f32x4* xr = (f32x4*)(x + (size_t)r * DM) + lane;
        f32x4 v[4]; float s = 0.f;
#pragma unroll
        for (int j = 0; j < 4; ++j) { v[j] = xr[64 * j]; s += (v[j][0] * v[j][0] + v[j][1] * v[j][1]) + (v[j][2] * v[j][2] + v[j][3] * v[j][3]); }
        const float rstd = 1.0f / sqrtf(wave_sum(s) * (1.0f / DM) + EPS);
#pragma unroll
        for (int j = 0; j < 4; ++j) { const f32x4 gg = *(const f32x4*)(g + 4 * (lane + 64 * j)); xr[64 * j] = (v[j] * rstd) * gg; }
    }
}

constexpr int HY_BSTR = 19264, HY_UL_BYTES = 4 * HY_BSTR, HY_RG = 544, HY_RL_OFF = HY_UL_BYTES, HY_RL_BYTES = (2 * HY_RG + 2 * SEQ) * 2;
static_assert(HY_RL_OFF + HY_RL_BYTES <= RING_BYTES && HY_UL_BYTES % 16 == 0, "hyena LDS");
__device__ __forceinline__ unsigned alignbit16(unsigned hi, unsigned lo) { return __builtin_amdgcn_alignbit(hi, lo, 16); }
__device__ __forceinline__ void hyena_make_filter(Ctx& C, int o, int c) {
    LAS unsigned short* RLx = (LAS unsigned short*)(C.lds + HY_RL_OFF) + HY_RG;
    const float* H2T = WSP(float, WS_H2); const float* w3 = INP(20);
    const int col0 = o * 1024 + c, tid = C.tid;
    const float delta = 3.0701134573253945f + (float)c * ((15.350567286626973f - 3.0701134573253945f) / 511.0f);
    f32x4 a0[4], a1[4];
#pragma unroll
    for (int j = 0; j < 4; ++j) { a0[j] = (f32x4){0.f, 0.f, 0.f, 0.f}; a1[j] = (f32x4){0.f, 0.f, 0.f, 0.f}; }
#pragma unroll 2
    for (int k = 0; k < 64; ++k) {
        const float w0 = w3[k * 2048 + col0], w1 = w3[k * 2048 + col0 + 512];
#pragma unroll
        for (int j = 0; j < 4; ++j) { const f32x4 h = *(const f32x4*)(H2T + (size_t)k * SEQ + 4 * (tid + NTHR * j)); a0[j] += h * w0; a1[j] += h * w1; }
    }
#pragma unroll
    for (int j = 0; j < 4; ++j)
#pragma unroll
        for (int e = 0; e < 4; ++e) {
            const int t = 4 * (tid + NTHR * j) + e; const float win = __expf(-((float)t * (1.0f / 8191.0f)) * delta) + 0.05f;
            RLx[SEQ - t] = (unsigned short)f2bf(a0[j][e] * win);
            if (t > 0) RLx[SEQ + t] = (unsigned short)f2bf(a1[j][e] * win);
        }
    if (tid == 0) RLx[0] = 0;
}
__device__ __forceinline__ void hyena_conv(Ctx& C, f32x4 (&acc)[2][8]) {
    const int lane = C.lane, w = C.wave, m = lane & 15, q = lane >> 4;
    const LAS unsigned char* UL = C.lds; const LAS unsigned char* RL = C.lds + HY_RL_OFF + HY_RG * 2;
#pragma unroll
    for (int g = 0; g < 2; ++g)
#pragma unroll
        for (int a = 0; a < 8; ++a) acc[g][a] = (f32x4){0.f, 0.f, 0.f, 0.f};
    const int cl = m >> 2, bt = m & 3;
    const int ub = bt * HY_BSTR + (8 * w + cl + 3) * 272 + 16 * q;
    for (int d = 8 * w - 63; d <= 8 * w + 7; ++d) {
        const bool v0 = d <= 8 * w + 3, v1 = d >= 8 * w + 4 - 63;
#pragma unroll 1
        for (int kb = 0; kb < 4; ++kb) {
            const int base = SEQ - 128 * d - 8 * m + 32 * kb + 8 * q;
            const v4u lo = *(const LAS v4u*)(RL + (base - 8) * 2), hi = *(const LAS v4u*)(RL + base * 2);
            const unsigned wd[8] = {lo.x, lo.y, lo.z, lo.w, hi.x, hi.y, hi.z, hi.w};
            bf16x8 af[8];
#pragma unroll
            for (int p = 0; p < 4; ++p) {
                const v4u ev = (v4u){wd[4 - p], wd[5 - p], wd[6 - p], wd[7 - p]};
                const v4u od = (v4u){alignbit16(wd[4 - p], wd[3 - p]), alignbit16(wd[5 - p], wd[4 - p]), alignbit16(wd[6 - p], wd[5 - p]), alignbit16(wd[7 - p], wd[6 - p])};
                af[2 * p] = __builtin_bit_cast(bf16x8, ev); af[2 * p + 1] = __builtin_bit_cast(bf16x8, od);
            }
            if (v0) {
                const bf16x8 bfr = *(const LAS bf16x8*)(UL + ub - d * 272 + 64 * kb);
#pragma unroll
                for (int a = 0; a < 8; ++a) acc[0][a] = __builtin_amdgcn_mfma_f32_16x16x32_bf16(af[a], bfr, acc[0][a], 0, 0, 0);
            }
            if (v1) {
                const bf16x8 bfr = *(const LAS bf16x8*)(UL + ub + 4 * 272 - d * 272 + 64 * kb);
#pragma unroll
                for (int a = 0; a < 8; ++a) acc[1][a] = __builtin_amdgcn_mfma_f32_16x16x32_bf16(af[a], bfr, acc[1][a], 0, 0, 0);
            }
        }
    }
}
__device__ __forceinline__ void hyena_item(Ctx& C, int c) {
    const int lane = C.lane, w = C.wave, tid = C.tid;
    LAS unsigned char* UL = C.lds; LAS unsigned char* RL = C.lds + HY_RL_OFF;
    const bf16* HY = WSP(bf16, WS_HY);
    for (int i = tid; i < 4 * 6 * 17; i += NTHR) { const int bt = i / 102, r = i % 102, sl = r / 17, pc = r % 17; const int slot = sl < 3 ? sl : 64 + sl;
        *(LAS v4u*)(UL + bt * HY_BSTR + slot * 272 + pc * 16) = (v4u){0u, 0u, 0u, 0u}; }
    for (int i = tid; i < 2 * (HY_RG / 8); i += NTHR) { const int side = i / (HY_RG / 8), pc = i % (HY_RG / 8);
        *(LAS v4u*)(RL + (side ? (HY_RG + 2 * SEQ) * 2 : 0) + pc * 16) = (v4u){0u, 0u, 0u, 0u}; }
#pragma unroll
    for (int i = 0; i < 8; ++i) { const int p = i * NTHR + tid, bt = p >> 10, r = p & 1023, ch = r >> 4, pc = r & 15;
        *(LAS v4u*)(UL + bt * HY_BSTR + (ch + 3) * 272 + pc * 16) = *(const v4u*)(HY + ((size_t)(bt * 1536 + c) * SEQ) + r * 8); }
    hyena_make_filter(C, 0, c);
    __syncthreads();
    f32x4 acc[2][8];
    const int mcol = lane & 15, q = lane >> 4, cl = mcol >> 2, bt = mcol & 3;
#pragma unroll 1
    for (int o = 0; o < 2; ++o) {
        hyena_conv(C, acc);
        __syncthreads();
        const float dsk = INP(21)[o * 512 + c];
#pragma unroll
        for (int g = 0; g < 2; ++g) {
            const int chunk = 8 * w + 4 * g + cl, p0 = 128 * chunk + 32 * q;
            LAS unsigned char* zl = UL + bt * HY_BSTR + (chunk + 3) * 272 + 64 * q;
            const bf16* gate = HY + ((size_t)(bt * 1536 + (o + 1) * 512 + c) * SEQ) + p0;
            unsigned short outv[32];
#pragma unroll
            for (int k = 0; k < 4; ++k) {
                const v4u zz = *(LAS v4u*)(zl + 16 * k), gg = *(const v4u*)(gate + 8 * k);
                const unsigned zw[4] = {zz.x, zz.y, zz.z, zz.w}, gw[4] = {gg.x, gg.y, gg.z, gg.w};
#pragma unroll
                for (int e = 0; e < 8; ++e) {
                    const float zv = (e & 1) ? bfhi(zw[e >> 1]) : bflo(zw[e >> 1]), gv = (e & 1) ? bfhi(gw[e >> 1]) : bflo(gw[e >> 1]);
                    outv[8 * k + e] = (unsigned short)f2bf(gv * (acc[g][e][k] + dsk * zv));
                }
            }
#pragma unroll
            for (int k = 0; k < 4; ++k) {
                const v4u ov = (v4u){(unsigned)outv[8 * k] | ((unsigned)outv[8 * k + 1] << 16), (unsigned)outv[8 * k + 2] | ((unsigned)outv[8 * k + 3] << 16),
                                     (unsigned)outv[8 * k + 4] | ((unsigned)outv[8 * k + 5] << 16), (unsigned)outv[8 * k + 6] | ((unsigned)outv[8 * k + 7] << 16)};
                if (o == 0) *(LAS v4u*)(zl + 16 * k) = ov;
                else *(v4u*)(WSP(bf16, WS_YAT) + ((size_t)(bt * 512 + c) * SEQ) + p0 + 8 * k) = ov;
            }
        }
        if (o == 0) hyena_make_filter(C, 1, c);
        __syncthreads();
    }
}

__device__ __forceinline__ void phase_hyena(Ctx& C) {
#pragma unroll 1
    for (int c = C.bx; c < DHY; c += C.G) hyena_item(C, c);
}
__device__ __forceinline__ void phase_attn(Ctx& C) {
    const int v = (C.G % 8 == 0) ? (C.bx % 8) * (C.G / 8) + C.bx / 8 : C.bx;
#pragma unroll 1
    for (int u = v; u < 2048; u += C.G) {
        const int combo = u >> 5, qb = u & 31;
        const int b = combo >> 4, hm = (combo >> 1) & 7, vh = combo & 1, h = hm >> 1, mm = hm & 1;
        const attn_body::bf16* Qp = (const attn_body::bf16*)(WSP(bf16, WS_Q) + ((size_t)(b * SEQ + qb * 256) * 512 + hm * 64));
        const attn_body::bf16* Kp = (const attn_body::bf16*)(WSP(bf16, WS_K) + ((size_t)b * NKV * 512 + hm * 64));
        const attn_body::bf16* Vp = (const attn_body::bf16*)(WSP(bf16, WS_V) + ((size_t)b * NKV * 512 + h * 128 + vh * 64));
        attn_body::bf16* Op = (attn_body::bf16*)(WSP(bf16, WS_O) + ((size_t)(b * SEQ + qb * 256) * 1024 + mm * 512 + h * 128 + vh * 64));
        attn_body::attn_unit<8>(Qp, Kp, Vp, Op, (char*)C.ldsg);
    }
    __syncthreads();
}

__device__ __forceinline__ void phase_combine(Ctx& C, bf16* MIX) {
    const int gw = C.bx * NWAVES + C.wave, NGW = C.G * NWAVES, lane = C.lane;
    const float lam_init = 0.2f;
    const float* dl = INP(22);
    const float lam = __expf(wave_sum(dl[lane] * dl[64 + lane])) - __expf(wave_sum(dl[128 + lane] * dl[192 + lane])) + lam_init;
    const bf16* O = WSP(bf16, WS_O);
    const float* sg = INP(23) + (lane & 15) * 8;
    const f32x4 g0 = *(const f32x4*)sg, g1 = *(const f32x4*)(sg + 4);
    for (int r = gw; r < NTOK; r += NGW) {
        const v4u a = *(const v4u*)(O + (size_t)r * 1024 + 8 * lane), b = *(const v4u*)(O + (size_t)r * 1024 + 512 + 8 * lane);
        const unsigned aw[4] = {a.x, a.y, a.z, a.w}, bw[4] = {b.x, b.y, b.z, b.w};
        float o[8]; float ss = 0.f;
#pragma unroll
        for (int e = 0; e < 4; ++e) { o[2 * e] = bflo(aw[e]) - lam * bflo(bw[e]); o[2 * e + 1] = bfhi(aw[e]) - lam * bfhi(bw[e]); ss += o[2 * e] * o[2 * e] + o[2 * e + 1] * o[2 * e + 1]; }
        ss += __shfl_xor(ss, 1); ss += __shfl_xor(ss, 2); ss += __shfl_xor(ss, 4); ss += __shfl_xor(ss, 8);
        const float rs = (1.0f / sqrtf(ss * (1.0f / 128.0f) + EPS)) * (1.0f - lam_init);
        *(v4u*)(MIX + (size_t)r * DM + 512 + 8 * lane) = (v4u){pk2(o[0] * rs * g0[0], o[1] * rs * g0[1]), pk2(o[2] * rs * g0[2], o[3] * rs * g0[3]), pk2(o[4] * rs * g1[0], o[5] * rs * g1[1]), pk2(o[6] * rs * g1[2], o[7] * rs * g1[3])};
    }
    LAS unsigned* tl = (LAS unsigned*)(C.lds + C.wave * 16384);
    const bf16* YAT = WSP(bf16, WS_YAT);
    for (int it = gw; it < 4 * 128 * 8; it += NGW) {
        const int b = it >> 10, tt = (it >> 3) & 127, ct = it & 7;
#pragma unroll
        for (int r = 0; r < 8; ++r) { const int c = r * 8 + (lane >> 3), tc = lane & 7;
            const v4u v = *(const v4u*)(YAT + ((size_t)(b * 512 + ct * 64 + c) * SEQ) + tt * 64 + tc * 8);
            tl[c * 33 + tc * 4 + 0] = v.x; tl[c * 33 + tc * 4 + 1] = v.y; tl[c * 33 + tc * 4 + 2] = v.z; tl[c * 33 + tc * 4 + 3] = v.w; }
        LDS_WAIT(); asm volatile("" ::: "memory");
#pragma unroll
        for (int r = 0; r < 8; ++r) { const int t = r * 8 + (lane >> 3), cc = lane & 7;
            unsigned short e[8];
#pragma unroll
            for (int k = 0; k < 8; ++k) { const unsigned wv = tl[(cc * 8 + k) * 33 + (t >> 1)]; e[k] = (unsigned short)((t & 1) ? (wv >> 16) : (wv & 0xffffu)); }
            *(v4u*)(MIX + (size_t)(b * SEQ + tt * 64 + t) * DM + ct * 64 + cc * 8) = (v4u){(unsigned)e[0] | ((unsigned)e[1] << 16), (unsigned)e[2] | ((unsigned)e[3] << 16), (unsigned)e[4] | ((unsigned)e[5] << 16), (unsigned)e[6] | ((unsigned)e[7] << 16)}; }
        LDS_WAIT(); asm volatile("" ::: "memory");
    }
}

__device__ __forceinline__ void phase_sgu_spatial(Ctx& C, bf16* GATED) {
    const int lane = C.lane, w = C.wave, tid = C.tid;
    LAS unsigned short* vt = (LAS unsigned short*)C.lds;
    const bf16* SU = WSP(bf16, WS_SU); const bf16* SV = WSP(bf16, WS_SV); const float* stat = WSP(float, WS_STAT); const bf16* WSb = WSP(bf16, WS_WS);
    const float* lng = INP(27); const float* lnb = INP(28); const float* bs = INP(30);
    for (int it = C.bx; it < 4 * 64 * 8; it += C.G) {
        const int g = it & 7, n = (it >> 3) & 63, b = it >> 9, tok0 = b * SEQ + n * 128;
        __syncthreads();
#pragma unroll
        for (int i = 0; i < 4; ++i) {
            const int p = i * NTHR + tid, s = p & 127, cp = p >> 7;
            const v4u v = *(const v4u*)(SV + (size_t)(tok0 + s) * DM + g * 128 + cp * 8);
            const float sm = stat[2 * (tok0 + s)], sq = stat[2 * (tok0 + s) + 1];
            const float mean = sm * (1.0f / 1024.0f), var = sq * (1.0f / 1024.0f) - mean * mean, rstd = 1.0f / sqrtf(var + EPS);
            const unsigned vw[4] = {v.x, v.y, v.z, v.w};
            const f32x4 ga = *(const f32x4*)(lng + g * 128 + cp * 8), gb = *(const f32x4*)(lng + g * 128 + cp * 8 + 4), ba = *(const f32x4*)(lnb + g * 128 + cp * 8), bb = *(const f32x4*)(lnb + g * 128 + cp * 8 + 4);
            const float gg[8] = {ga[0], ga[1], ga[2], ga[3], gb[0], gb[1], gb[2], gb[3]}, bq[8] = {ba[0], ba[1], ba[2], ba[3], bb[0], bb[1], bb[2], bb[3]};
#pragma unroll
            for (int e = 0; e < 8; ++e) { const float x = (e & 1) ? bfhi(vw[e >> 1]) : bflo(vw[e >> 1]); vt[(cp * 8 + e) * 136 + s] = (unsigned short)f2bf((x - mean) * rstd * gg[e] + bq[e]); }
        }
        __syncthreads();
        f32x4 acc[8];
#pragma unroll
        for (int cb = 0; cb < 8; ++cb) acc[cb] = (f32x4){0.f, 0.f, 0.f, 0.f};
        const int fr = lane & 15, fq = lane >> 4;
#pragma unroll
        for (int kb = 0; kb < 4; ++kb) {
            const bf16x8 a = *(const bf16x8*)(WSb + ((size_t)(g * 128 + 16 * w + fr) * 128) + 32 * kb + 8 * fq);
#pragma unroll
            for (int cb = 0; cb < 8; ++cb) { const bf16x8 bfr = *(const LAS bf16x8*)(vt + (16 * cb + fr) * 136 + 32 * kb + 8 * fq); acc[cb] = __builtin_amdgcn_mfma_f32_16x16x32_bf16(a, bfr, acc[cb], 0, 0, 0); }
        }
#pragma unroll
        for (int reg = 0; reg < 4; ++reg) {
            const int t = 16 * w + 4 * fq + reg; const float bias = bs[g * 128 + t];
#pragma unroll
            for (int cb = 0; cb < 8; ++cb) { const size_t off = (size_t)(tok0 + t) * DM + g * 128 + 16 * cb + fr; GATED[off] = (bf16)f2bf(bf2f(SU[off]) * (acc[cb][reg] + bias)); }
        }
    }
    __syncthreads();
}

struct Args { const float* in[33]; float* out; unsigned char* ws; int ph_lo, ph_hi; };
constexpr int N_PHASES = 17;
__global__ void __launch_bounds__(NTHR, 2) fwd_megakernel(Args args) {
    extern __shared__ __attribute__((aligned(16))) unsigned char lds_raw[];
    cg::grid_group grid = cg::this_grid();
    Ctx C;
    C.lds = (LAS unsigned char*)lds_raw; C.ldsg = lds_raw; C.tid = threadIdx.x; C.lane = C.tid & 63; C.wave = __builtin_amdgcn_readfirstlane(C.tid >> 6); C.G = gridDim.x; C.bx = blockIdx.x;
    C.kin = (ktab)__builtin_amdgcn_kernarg_segment_ptr();
    C.out = args.out; C.ws = args.ws;
    const int lo = args.ph_lo, hi = args.ph_hi;
#ifndef PHMASK
#define PHMASK 0x1ffff
#endif
#define IN(k) ((((PHMASK) >> (k)) & 1) && lo <= (k) && (k) < hi)
#define SEAM(k) do { if (IN(k) && IN((k) + 1)) grid.sync(); } while (0)
    bf16* ACT = WSP(bf16, WS_ACT);
    const float* MOD = WSP(float, WS_MOD);

    if (IN(0)) phase_p0(C);
    SEAM(0);
    if (IN(1)) {
        phase_norm_mod(C, INP(0), NTOK, SEQ, INP(6), MOD, MOD + 1024, 6144, ACT + DM);
        phase_norm_mod(C, INP(2), NCTX, NCTX, INP(6), WSP(float, WS_CMOD), WSP(float, WS_CMOD) + 1024, 0, WSP(bf16, WS_HC));
    }
    SEAM(1);
    if (IN(2)) {
#ifndef NO_G1
        { pg8::Gemm g{ACT, WSP(bf16, WS_WIN), SLAB_TILES * 256, NIN, 1024, 1}; pg8::StaticOrder S; S.init(SLAB_TILES * 256, NIN, C.G, C.bx);
          epi::EpiInProj E{WSP(bf16, WS_HY), WSP(bf16, WS_Q), WSP(bf16, WS_K), WSP(bf16, WS_V), INP(13), INP(14), WSP(float, WS_ROPE)};
          pg8::gemm_phase<epi::EpiInProj, pg8::StaticOrder, true, true>(C.lds, g, S, E); }
#endif
#ifndef NO_G2
        { pg8::Gemm g{WSP(bf16, WS_HC), WSP(bf16, WS_WIN) + (size_t)2048 * 1024, NCTX, 1024, 1024, 0}; pg8::StaticOrder S; S.init(NCTX, 1024, C.G, (C.bx + C.G - 64) % C.G);
          epi::EpiCtxKV E{WSP(bf16, WS_K), WSP(bf16, WS_V)};
          pg8::gemm_phase<epi::EpiCtxKV, pg8::StaticOrder, true, true>(C.lds, g, S, E); }
#endif
    }
    SEAM(2);
    if (IN(3)) {
#ifndef NO_HYENA
        phase_hyena(C);
#endif
#ifndef NO_ATTN
        phase_attn(C);
#endif
    }
    SEAM(3);
    if (IN(4)) phase_combine(C, ACT + DM);
    SEAM(4);
    if (IN(5)) {
        pg8::Gemm g{ACT + DM, WSP(bf16, WS_WOUT), NTOK, 1024, 1024, 0}; pg8::StaticOrder S; S.init(NTOK, 1024, C.G, C.bx);
        epi::EpiResid E{INP(0), C.out, MOD + 2048};
        pg8::gemm_phase<epi::EpiResid, pg8::StaticOrder, true, true>(C.lds, g, S, E);
    }
    SEAM(5);
    const float* MOD1 = MOD + (size_t)4 * 6144;
#define FFN_BLOCK(l, pb, MODL) \
    if (IN(pb)) phase_norm_mod(C, C.out, NTOK, SEQ, INP(7) + (l) * 1024, (MODL) + 3072, (MODL) + 4096, 6144, ACT + DM); \
    SEAM(pb); \
    if (IN((pb) + 1)) { \
        pg8::Gemm g{ACT, WSP(bf16, (l) ? WS_WUP1 : WS_WUP0), SLAB_TILES * 256, NUP, 1024, 1}; pg8::StaticOrder S; S.init(SLAB_TILES * 256, NUP, C.G, C.bx); \
        epi::EpiFfnUp E{WSP(bf16, WS_HID), INP(9) + (size_t)(l) * 3 * NUP, INP(10) + (size_t)(l) * NUP}; \
        pg8::gemm_phase<epi::EpiFfnUp, pg8::StaticOrder, true, true>(C.lds, g, S, E); \
    } \
    SEAM((pb) + 1); \
    if (IN((pb) + 2)) { \
        pg8::Gemm g{WSP(bf16, WS_HID), WSP(bf16, (l) ? WS_WDN1 : WS_WDN0), NTOK, 1024, DFF, 0}; pg8::StaticOrder S; S.init(NTOK, 1024, C.G, C.bx); \
        epi::EpiResid E{C.out, C.out, (MODL) + 5120}; \
        pg8::gemm_phase<epi::EpiResid, pg8::StaticOrder, true, true>(C.lds, g, S, E); \
    } \
    SEAM((pb) + 2);
    FFN_BLOCK(0, 6, MOD)
    if (IN(9)) phase_norm_mod(C, C.out, NTOK, SEQ, INP(6) + 1024, MOD1, MOD1 + 1024, 6144, ACT + DM);
    SEAM(9);
    if (IN(10)) {
        pg8::Gemm g{ACT + DM, WSP(bf16, WS_WSIN), NTOK, 2048, 1024, 0}; pg8::StaticOrder S; S.init(NTOK, 2048, C.G, C.bx);
        epi::EpiSguIn E{WSP(bf16, WS_SU), WSP(bf16, WS_SV), INP(26), WSP(float, WS_STAT)};
        pg8::gemm_phase<epi::EpiSguIn, pg8::StaticOrder, true, true>(C.lds, g, S, E);
    }
    SEAM(10);
    if (IN(11)) phase_sgu_spatial(C, ACT + DM);
    SEAM(11);
    if (IN(12)) {
        pg8::Gemm g{ACT + DM, WSP(bf16, WS_WSOUT), NTOK, 1024, 1024, 0}; pg8::StaticOrder S; S.init(NTOK, 1024, C.G, C.bx);
        epi::EpiResid E{C.out, C.out, MOD1 + 2048};
        pg8::gemm_phase<epi::EpiResid, pg8::StaticOrder, true, true>(C.lds, g, S, E);
    }
    SEAM(12);
    FFN_BLOCK(1, 13, MOD1)
#undef FFN_BLOCK
    if (IN(16)) phase_final_norm(C, C.out, INP(32));
#undef IN
#undef SEAM
}

extern "C" void kernel_launch(void* const* d_in, const int* in_sizes, int n_in, void* d_out, int out_size, void* d_ws, size_t ws_size, hipStream_t stream) {
    static int grid = 0;
    if (grid == 0) {
        if (n_in != 33 || out_size != NTOK * DM || ws_size < WS_END) { fprintf(stderr, "kernel_launch: unexpected shapes (n_in %d out %d ws %zu)\n", n_in, out_size, ws_size); grid = -1; return; }
        int dev = 0, cus = 0, per_cu = 0;
        hipGetDevice(&dev); hipDeviceGetAttribute(&cus, hipDeviceAttributeMultiprocessorCount, dev);
        hipFuncSetAttribute((const void*)fwd_megakernel, hipFuncAttributeMaxDynamicSharedMemorySize, LDS_BYTES);
        if (hipOccupancyMaxActiveBlocksPerMultiprocessor(&per_cu, (const void*)fwd_megakernel, NTHR, LDS_BYTES) != hipSuccess || per_cu < 1) per_cu = 1;
        (void)hipGetLastError();
        grid = cus * per_cu;
    }
    if (grid < 0) return;
    Args a{};
    for (int i = 0; i < 33; ++i) a.in[i] = (const float*)d_in[i];
    a.out = (float*)d_out; a.ws = (unsigned char*)d_ws;
#ifndef N_LAUNCH_SPLIT
    a.ph_lo = 0; a.ph_hi = N_PHASES;
    void* params[] = {&a};
    hipError_t e = hipLaunchCooperativeKernel((const void*)fwd_megakernel, dim3(grid), dim3(NTHR), params, LDS_BYTES, stream);
    if (e != hipSuccess) fprintf(stderr, "cooperative launch failed: %s (grid %d)\n", hipGetErrorString(e), grid);
#else
    for (int p = 0; p < N_PHASES; ++p) { a.ph_lo = p; a.ph_hi = p + 1; hipLaunchKernelGGL(fwd_megakernel, dim3(grid), dim3(NTHR), LDS_BYTES, stream, a); }
#endif
}
```

```cpp
#include <hip/hip_runtime.h>
#include <hip/hip_cooperative_groups.h>
#include <hip/hip_bf16.h>
#include <cstdio>
#include <cstdint>
#include <cmath>
namespace cg = cooperative_groups;
namespace pg8 {
#define PG8_LAS __attribute__((address_space(3)))
typedef unsigned short bf16_t;
typedef short bf16x8 __attribute__((ext_vector_type(8)));
typedef float f32x4 __attribute__((ext_vector_type(4)));
typedef unsigned u32x4 __attribute__((ext_vector_type(4)));
constexpr int BM = 256, BK = 64, HALF = 128, HTB = HALF * BK * 2  , STAGE_BYTES = 8 * HTB, NXCD = 8, WGM = 8;

__host__ __device__ __forceinline__ int lds_byte(int r, int c) { const int st = (r >> 4) * 2 + (c >> 5), rr = r & 15, cc = c & 31, ob = rr * 64 + cc * 2; return st * 1024 + (ob ^ (((ob >> 9) & 1) << 5)); }
__host__ __device__ __forceinline__ void stage_rc(int b, int& R, int& C) { const int st = b / 1024, sb = b % 1024, swz = sb ^ (((sb >> 9) & 1) << 5); R = (st >> 1) * 16 + swz / 64; C = (st & 1) * 32 + (swz % 64) / 2; }
__host__ __device__ __forceinline__ int perm32(int rho) { const int n = rho >> 4, i = rho & 15; return 8 * (i >> 2) + 4 * n + (i & 3); }

struct Unit { int pm, pn; };
struct Gemm { const bf16_t* A; const bf16_t* Bt; int M, N, K; int slab; };

struct StaticOrder {
    int nM, nN, nwg, G, c;
    __host__ __device__ void init(int M, int N, int G_, int c_) { nM = M / BM; nN = N / BM; nwg = nM * nN; G = G_; c = c_; }
    __host__ __device__ bool next(int i, Unit& u) const {
        const long L = (long)i * G + c; if (L >= nwg) return false;
        int wgid = (int)L; { const int q = nwg / NXCD, r = nwg % NXCD, xcd = wgid % NXCD, off = wgid / NXCD; wgid = (xcd < r ? xcd * (q + 1) : r * (q + 1) + (xcd - r) * q) + off; }
        const int nig = WGM * nN, gid = wgid / nig, fm = gid * WGM, gsz = (nM - fm) < WGM ? (nM - fm) : WGM;
        u.pm = fm + ((wgid % nig) % gsz); u.pn = (wgid % nig) / gsz; return true;
    }
    __device__ __forceinline__ void a_ready(const Unit&) const {}
    __device__ __forceinline__ void done(const Unit&) const {}
};

__device__ __forceinline__ unsigned cvt_pk_bf16(float lo, float hi) { unsigned r; asm volatile("v_cvt_pk_bf16_f32 %0, %1, %2" : "=v"(r) : "v"(lo), "v"(hi)); return r; }
typedef float f32x2 __attribute__((ext_vector_type(2)));
__device__ __forceinline__ f32x2 gelu_pk(f32x2 v) {
    const f32x2 av = __builtin_elementwise_abs(v), d = av * 0.2316418882f + 1.0f;
    f32x2 t; t.x = __builtin_amdgcn_rcpf(d.x); t.y = __builtin_amdgcn_rcpf(d.y);
    f32x2 q = t * 0.5307027145f + (-0.7265760135f); q = q * t + 0.7107068705f; q = q * t + (-0.142248368f); q = q * t + 0.127414796f; q = q * t;
    const f32x2 s = (v * v) * (-0.72134752044f);
    f32x2 e; e.x = __builtin_amdgcn_exp2f(s.x); e.y = __builtin_amdgcn_exp2f(s.y);
    const f32x2 m = v * (q * e), r = v - m;
    f32x2 o; o.x = v.x < 0.f ? m.x : r.x; o.y = v.y < 0.f ? m.y : r.y; return o;
}

template <class Epi, class Sched, bool ALIGN_EPI = false, bool SP2 = false>
__device__ __forceinline__ void gemm_phase(PG8_LAS unsigned char* lds, const Gemm g, const Sched& S, const Epi& E) {
    int tid_ = threadIdx.x; asm volatile("" : "+v"(tid_));
    const int tid = tid_, wid = __builtin_amdgcn_readfirstlane(tid >> 6), lane = tid & 63, wr = wid >> 2, wc = wid & 3, fr = lane & 15, fq = lane >> 4;
    const int K = g.K, nt = K / BK;
    unsigned voffA[2], voffB[2];
#pragma unroll
    for (int i = 0; i < 2; ++i) { int R, C; stage_rc(tid * 16 + i * 8192, R, C); const int Rb = Epi::PERM ? ((R & ~31) + perm32(R & 31)) : R;
        const int Ra = g.slab ? ((R >> 6) * 62 + (R & 63)) : R; voffA[i] = (unsigned)(Ra * K + C) * 2u; voffB[i] = (unsigned)(Rb * K + C) * 2u; }
    const size_t kstep = (size_t)(BK * 2);
    const size_t hstep = (size_t)HALF * K * 2;
    const size_t tstep = 2 * hstep;
    const size_t hstepA = g.slab ? (size_t)124 * K * 2 : hstep, tstepA = g.slab ? (size_t)248 * K * 2 : tstep;
    const unsigned ldsw = (unsigned)wid * 1024u;
    const int aoff = lds_byte(wr * 64 + fr, fq * 8), boff = lds_byte(wc * 32 + fr, fq * 8);
#define PG8_SA(b, h) (((b) * 2 + (h)) * HTB)
#define PG8_SB(b, h) ((4 + (b) * 2 + (h)) * HTB)
#define PG8_STAGE(bufoff, gbase, voff) do { _Pragma("unroll") for (int _i = 0; _i < 2; ++_i) \
        __builtin_amdgcn_global_load_lds((const unsigned*)((const char*)(gbase) + (voff)[_i]), (PG8_LAS unsigned*)(lds + (bufoff) + ldsw + _i * 8192), 16, 0, 0); } while (0)
#define PG8_LDA(dst, b, h) do { _Pragma("unroll") for (int m = 0; m < 4; ++m) _Pragma("unroll") for (int k = 0; k < 2; ++k) dst[m][k] = *(const PG8_LAS bf16x8*)(lds + PG8_SA(b, h) + aoff + m * 2048 + k * 1024); } while (0)
#define PG8_LDB(dst, b, h) do { _Pragma("unroll") for (int n = 0; n < 2; ++n) _Pragma("unroll") for (int k = 0; k < 2; ++k) dst[n][k] = *(const PG8_LAS bf16x8*)(lds + PG8_SB(b, h) + boff + n * 2048 + k * 1024); } while (0)
#define PG8_MMA(ai, bj, At, Bt) do { __builtin_amdgcn_s_setprio(1); _Pragma("unroll") for (int m = 0; m < 4; ++m) _Pragma("unroll") for (int n = 0; n < 2; ++n) _Pragma("unroll") for (int k = 0; k < 2; ++k) \
        acc[ai][bj][m][n] = __builtin_amdgcn_mfma_f32_16x16x32_bf16(Bt[n][k], At[m][k], acc[ai][bj][m][n], 0, 0, 0); __builtin_amdgcn_s_setprio(0); } while (0)
#define PG8_WAIT_V(n) asm volatile("s_waitcnt vmcnt(" #n ")" ::: "memory")
#define PG8_WAIT_L(n) asm volatile("s_waitcnt lgkmcnt(" #n ")" ::: "memory")
#define PG8_BAR __builtin_amdgcn_s_barrier()
#define PG8_SCHED __builtin_amdgcn_sched_barrier(0)
    Unit cur, nxt; int ui = 0;
    if (!S.next(0, cur)) return;
    f32x4 acc[2][2][4][2];
#pragma unroll
    for (int a = 0; a < 2; ++a)
#pragma unroll
        for (int b = 0; b < 2; ++b)
#pragma unroll
            for (int m = 0; m < 4; ++m)
#pragma unroll
                for (int n = 0; n < 2; ++n) acc[a][b][m][n] = (f32x4){0.f, 0.f, 0.f, 0.f};
    bf16x8 At[4][2], B0[2][2], B1[2][2];
    const char* cA = (const char*)g.A + (size_t)cur.pm * tstepA; const char* cB = (const char*)g.Bt + (size_t)cur.pn * tstep;
    S.a_ready(cur);
    if constexpr (SP2) {
        PG8_STAGE(PG8_SB(0, 0), cB, voffB); PG8_STAGE(PG8_SB(0, 1), cB + hstep, voffB); PG8_STAGE(PG8_SA(0, 0), cA, voffA); PG8_STAGE(PG8_SA(0, 1), cA + hstepA, voffA);
        if (wr == 1) PG8_BAR;
        PG8_WAIT_V(2); PG8_BAR;
        PG8_STAGE(PG8_SB(1, 0), cB + kstep, voffB); PG8_STAGE(PG8_SA(1, 0), cA + kstep, voffA); PG8_STAGE(PG8_SB(1, 1), cB + hstep + kstep, voffB);
        PG8_WAIT_V(6); PG8_BAR;
    } else {
        PG8_STAGE(PG8_SB(0, 0), cB, voffB); PG8_STAGE(PG8_SA(0, 0), cA, voffA); PG8_STAGE(PG8_SB(0, 1), cB + hstep, voffB); PG8_STAGE(PG8_SA(0, 1), cA + hstepA, voffA);
        if (wr == 1) PG8_BAR;
        PG8_WAIT_V(4); PG8_BAR;
        PG8_STAGE(PG8_SB(1, 0), cB + kstep, voffB); PG8_STAGE(PG8_SA(1, 0), cA + kstep, voffA); PG8_STAGE(PG8_SB(1, 1), cB + hstep + kstep, voffB);
        PG8_WAIT_V(6); PG8_BAR;
    }
    for (;;) {
        const bool has_next = S.next(ui + 1, nxt);
        const char* nA = has_next ? (const char*)g.A + (size_t)nxt.pm * tstepA : cA; const char* nB = has_next ? (const char*)g.Bt + (size_t)nxt.pn * tstep : cB;
        for (int t = 0; t < nt; t += 2) {
            const bool last = (t == nt - 2);
            const char* a1 = cA + (size_t)(t + 1) * kstep;
            const char* a2 = last ? nA : cA + (size_t)(t + 2) * kstep; const char* b2 = last ? nB : cB + (size_t)(t + 2) * kstep;
            const char* a3 = a2 + kstep; const char* b3 = b2 + kstep;
            if (last && has_next) S.a_ready(nxt);
            if constexpr (SP2) {
            PG8_LDB(B0, 0, 0); PG8_LDB(B1, 0, 1); PG8_SCHED; PG8_LDA(At, 0, 0); PG8_STAGE(PG8_SA(1, 1), a1 + hstepA, voffA);
            PG8_WAIT_V(8); PG8_WAIT_L(0); PG8_BAR; PG8_MMA(0, 0, At, B0); PG8_MMA(0, 1, At, B1); PG8_BAR; PG8_SCHED;
            PG8_LDA(At, 0, 1); PG8_STAGE(PG8_SB(0, 0), b2, voffB); PG8_STAGE(PG8_SB(0, 1), b2 + hstep, voffB); PG8_STAGE(PG8_SA(0, 0), a2, voffA);
            PG8_WAIT_V(8); PG8_WAIT_L(0); PG8_BAR; PG8_MMA(1, 0, At, B0); PG8_MMA(1, 1, At, B1); PG8_BAR; PG8_SCHED;
            PG8_LDB(B0, 1, 0); PG8_LDB(B1, 1, 1); PG8_SCHED; PG8_LDA(At, 1, 0); PG8_STAGE(PG8_SA(0, 1), a2 + hstepA, voffA);
            PG8_WAIT_V(8); PG8_WAIT_L(0); PG8_BAR; PG8_MMA(0, 0, At, B0); PG8_MMA(0, 1, At, B1); PG8_BAR; PG8_SCHED;
            PG8_LDA(At, 1, 1); PG8_STAGE(PG8_SB(1, 0), b3, voffB); PG8_STAGE(PG8_SB(1, 1), b3 + hstep, voffB); PG8_STAGE(PG8_SA(1, 0), a3, voffA);
            PG8_WAIT_V(8); PG8_WAIT_L(0); PG8_BAR; PG8_MMA(1, 0, At, B0); PG8_MMA(1, 1, At, B1); PG8_BAR; PG8_SCHED;
            } else {
            PG8_LDB(B0, 0, 0); PG8_SCHED; PG8_LDA(At, 0, 0); PG8_STAGE(PG8_SA(1, 1), a1 + hstepA, voffA);
            PG8_WAIT_L(8); PG8_BAR; PG8_WAIT_L(0); PG8_MMA(0, 0, At, B0); PG8_BAR; PG8_SCHED;
            PG8_LDB(B1, 0, 1); PG8_STAGE(PG8_SB(0, 0), b2, voffB);
            PG8_BAR; PG8_WAIT_L(0); PG8_MMA(0, 1, At, B1); PG8_BAR;
            PG8_LDA(At, 0, 1); PG8_STAGE(PG8_SA(0, 0), a2, voffA);
            PG8_BAR; PG8_WAIT_L(0); PG8_MMA(1, 0, At, B0); PG8_BAR; PG8_SCHED;
            PG8_STAGE(PG8_SB(0, 1), b2 + hstep, voffB);
            PG8_WAIT_V(6); PG8_BAR; PG8_MMA(1, 1, At, B1); PG8_BAR;
            PG8_LDB(B0, 1, 0); PG8_SCHED; PG8_LDA(At, 1, 0); PG8_STAGE(PG8_SA(0, 1), a2 + hstepA, voffA);
            PG8_WAIT_L(8); PG8_BAR; PG8_WAIT_L(0); PG8_MMA(0, 0, At, B0); PG8_BAR; PG8_SCHED;
            PG8_LDB(B1, 1, 1); PG8_STAGE(PG8_SB(1, 0), b3, voffB);
            PG8_BAR; PG8_WAIT_L(0); PG8_MMA(0, 1, At, B1); PG8_BAR;
            PG8_LDA(At, 1, 1); PG8_STAGE(PG8_SA(1, 0), a3, voffA);
            PG8_BAR; PG8_WAIT_L(0); PG8_MMA(1, 0, At, B0); PG8_BAR; PG8_SCHED;
            PG8_STAGE(PG8_SB(1, 1), b3 + hstep, voffB);
            PG8_WAIT_V(6); PG8_BAR; PG8_MMA(1, 1, At, B1); PG8_BAR;
            }
        }
        if constexpr (ALIGN_EPI) { if (wr == 0) PG8_BAR; }
        if constexpr (!Epi::AFTER_DRAIN) { E(acc, cur, wr, wc, fr, fq); S.done(cur); }
        if (!has_next) break;
#pragma unroll
        for (int a = 0; a < 2; ++a)
#pragma unroll
            for (int b = 0; b < 2; ++b)
#pragma unroll
                for (int m = 0; m < 4; ++m)
#pragma unroll
                    for (int n = 0; n < 2; ++n) acc[a][b][m][n] = (f32x4){0.f, 0.f, 0.f, 0.f};
        cur = nxt; cA = nA; cB = nB; ++ui;
        if constexpr (ALIGN_EPI) { if (wr == 1) PG8_BAR; }
    }
    PG8_WAIT_V(0);
    if constexpr (!ALIGN_EPI) { if (wr == 0) PG8_BAR; }
    PG8_BAR;
    if constexpr (Epi::AFTER_DRAIN) { E.fused(acc, cur, wr, wc, fr, fq, lds, wid, lane); S.done(cur); }
#undef PG8_SA
#undef PG8_SB
#undef PG8_STAGE
#undef PG8_LDA
#undef PG8_LDB
#undef PG8_MMA
#undef PG8_WAIT_V
#undef PG8_WAIT_L
#undef PG8_BAR
#undef PG8_SCHED
}
}

namespace attn_body {
using bf16=__hip_bfloat16;
using bf16x8=__attribute__((ext_vector_type(8)))short;
using s16x4=__attribute__((ext_vector_type(4)))short;
using f32x16=__attribute__((ext_vector_type(16)))float;
using u32x4=__attribute__((ext_vector_type(4)))unsigned;
constexpr int D=64,QP=512,KP=512,VP=512,OP=1024,NT_ALL=132;
constexpr int NW=8,QBLK=32,QB=QBLK*NW,KVBLK=64;
__device__ __forceinline__ int crow(int r,int hi){return (r&3)+8*(r>>2)+4*hi;}
#define SBAR() __builtin_amdgcn_sched_barrier(0)
__device__ __forceinline__ void cmask(f32x16&p0,f32x16&p1,int jb,int qrel,int hi){
  const float NEG=-INFINITY; int kb=64*jb+4*hi;
  #pragma unroll
  for(int r=0;r<16;++r){int kv=kb+(r&3)+8*(r>>2); if(kv>qrel)p0[r]=NEG; if(kv+32>qrel)p1[r]=NEG;}
}

constexpr int NSLOT=3, SLOTB=8192;
constexpr int LDS_K=0, LDS_V=NSLOT*SLOTB, LDS_WS=2*NSLOT*SLOTB, LDS_OST=LDS_WS+NW*64*4, LDS_BYTES=LDS_OST+NW*4096;
constexpr float C2=0.125f*1.4426950408889634f;
__device__ __forceinline__ void glds16(const void*gsrc,unsigned lds_dst){unsigned keep;
  asm volatile("s_mov_b32 %0, m0\n\ts_mov_b32 m0, %2\n\ts_nop 0\n\tglobal_load_lds_dwordx4 %1, off\n\ts_mov_b32 m0, %0":"=&s"(keep):"v"(gsrc),"s"(lds_dst):"memory");}
__device__ __forceinline__ float max3f(float a,float b,float c){float r;asm("v_max3_f32 %0, %1, %2, %3":"=v"(r):"v"(a),"v"(b),"v"(c));return r;}
__device__ __forceinline__ float max2f(float a,float b){float r;asm("v_max_f32_e32 %0, %1, %2":"=v"(r):"v"(a),"v"(b));return r;}
__device__ __forceinline__ float fadd_s(float a,float b){float r;asm("v_add_f32_e32 %0, %1, %2":"=v"(r):"v"(a),"v"(b));return r;}
__device__ __forceinline__ float fsub_s(float a,float b){float r;asm("v_sub_f32_e32 %0, %1, %2":"=v"(r):"v"(a),"v"(b));return r;}
typedef float f32x2_t __attribute__((ext_vector_type(2))); typedef __bf16 bf16x2_t __attribute__((ext_vector_type(2)));
__device__ __forceinline__ unsigned cvtpk_s(float lo,float hi){f32x2_t v={lo,hi};bf16x2_t b=__builtin_convertvector(v,bf16x2_t);return __builtin_bit_cast(unsigned,b);}
#define WAIT_BAR(N) asm volatile("s_waitcnt vmcnt(" #N ") lgkmcnt(0)\n\ts_barrier":::"memory")

__device__ __forceinline__ void qkt(f32x16&p0,f32x16&p1,const char*Kslot,const bf16x8*qr,const f32x16&negm,int r32,int hi){
  const char*kb=Kslot+hi*1024+r32*16;
  #pragma unroll
  for(int d0=0;d0<4;++d0){
    const bf16x8 b0=*reinterpret_cast<const bf16x8*>(kb+d0*2048);
    const bf16x8 b1=*reinterpret_cast<const bf16x8*>(kb+d0*2048+512);
    if(d0==0){p0=__builtin_amdgcn_mfma_f32_32x32x16_bf16(b0,qr[0],negm,0,0,0);p1=__builtin_amdgcn_mfma_f32_32x32x16_bf16(b1,qr[0],negm,0,0,0);}
    else{p0=__builtin_amdgcn_mfma_f32_32x32x16_bf16(b0,qr[d0],p0,0,0,0);p1=__builtin_amdgcn_mfma_f32_32x32x16_bf16(b1,qr[d0],p1,0,0,0);}}
}
typedef __attribute__((address_space(3))) const char* lds_cptr;
typedef short v4i16_t __attribute__((ext_vector_type(4)));
__device__ __forceinline__ void kload8(bf16x8*kf,lds_cptr kp){
  kf[0]=*(const __attribute__((address_space(3))) bf16x8*)(kp);      kf[1]=*(const __attribute__((address_space(3))) bf16x8*)(kp+512);
  kf[2]=*(const __attribute__((address_space(3))) bf16x8*)(kp+2048); kf[3]=*(const __attribute__((address_space(3))) bf16x8*)(kp+2560);
  kf[4]=*(const __attribute__((address_space(3))) bf16x8*)(kp+4096); kf[5]=*(const __attribute__((address_space(3))) bf16x8*)(kp+4608);
  kf[6]=*(const __attribute__((address_space(3))) bf16x8*)(kp+6144); kf[7]=*(const __attribute__((address_space(3))) bf16x8*)(kp+6656);
}
__device__ __forceinline__ void kload2(bf16x8*kf,lds_cptr kp,int j){ kf[2*j]=*(const __attribute__((address_space(3))) bf16x8*)(kp+j*2048); kf[2*j+1]=*(const __attribute__((address_space(3))) bf16x8*)(kp+j*2048+512); }
__device__ __forceinline__ s16x4 vtr(lds_cptr p){ return __builtin_bit_cast(s16x4,__builtin_amdgcn_ds_read_tr16_b64_v4i16((__attribute__((address_space(3))) v4i16_t*)p)); }
__device__ __forceinline__ float rowmax(const f32x16&p0,const f32x16&p1){
  float a=max3f(p0[0],p0[1],p1[0]),b=max3f(p0[2],p0[3],p1[1]);a=max3f(a,p1[2],p1[3]);
  #pragma unroll
  for(int r=4;r<16;r+=4){a=max3f(a,p0[r],p0[r+1]);b=max3f(b,p0[r+2],p0[r+3]);a=max3f(a,p1[r],p1[r+1]);b=max3f(b,p1[r+2],p1[r+3]);}
  const float m=max2f(a,b);
  auto rr=__builtin_amdgcn_permlane32_swap(__float_as_uint(m),__float_as_uint(m),false,false);
  return max2f(__uint_as_float(rr[0]),__uint_as_float(rr[1]));
}
__device__ __forceinline__ void pv(f32x16*o,int vb,bf16x8 pa0,bf16x8 pa1,bf16x8 pa2,bf16x8 pa3){
  #pragma unroll
  for(int d0=0;d0<2;++d0){s16x4 lo[4],hi[4];
    #pragma unroll
    for(int ks=0;ks<4;++ks){
      asm volatile("ds_read_b64_tr_b16 %0,%1 offset:%c2":"=&v"(lo[ks]):"v"(vb),"i"(d0*4096+ks*1024):"memory");
      asm volatile("ds_read_b64_tr_b16 %0,%1 offset:%c2":"=&v"(hi[ks]):"v"(vb),"i"(d0*4096+ks*1024+512):"memory");}
    asm volatile("s_waitcnt lgkmcnt(0)":::"memory");SBAR();
    #define PK(k) (bf16x8){lo[k][0],lo[k][1],lo[k][2],lo[k][3],hi[k][0],hi[k][1],hi[k][2],hi[k][3]}
    o[d0]=__builtin_amdgcn_mfma_f32_32x32x16_bf16(pa0,PK(0),o[d0],0,0,0);
    o[d0]=__builtin_amdgcn_mfma_f32_32x32x16_bf16(pa1,PK(1),o[d0],0,0,0);
    o[d0]=__builtin_amdgcn_mfma_f32_32x32x16_bf16(pa2,PK(2),o[d0],0,0,0);
    o[d0]=__builtin_amdgcn_mfma_f32_32x32x16_bf16(pa3,PK(3),o[d0],0,0,0);
    #undef PK
  }
}

#ifndef ATTN_STORE16
#define ATTN_STORE16(p,v) (*(u32x4*)(p)=(v))
#endif
template<int THRL> __device__ __forceinline__ void attn_unit(const bf16*Qblk,const bf16*__restrict__ Kh,const bf16*__restrict__ Vh,bf16*Oblk,char*shm){
  const int tid=threadIdx.x,lane=tid&63,r32=lane&31,hi=lane>>5; const int wid=__builtin_amdgcn_readfirstlane(tid>>6);
  const bf16*Qw=Qblk+(long)(wid*QBLK)*QP;
  const unsigned lds0=(unsigned)(uintptr_t)shm;
  float*wsf=(float*)(shm+LDS_WS)+wid*64;
  const bf16*ksrc=Kh+(long)lane*KP+wid*8;
  const bf16*vsrc=Vh+(long)(16*(wid&3)+(lane>>2))*VP+(wid>>2)*32+(lane&3)*8;
  const unsigned kdst=lds0+LDS_K+wid*1024, vdst=lds0+LDS_V+wid*1024;
  #define DMA_K(t,slot) glds16(ksrc+(long)(t)*KVBLK*KP,(unsigned)__builtin_amdgcn_readfirstlane(kdst+(slot)))
  #define DMA_V(t,slot) glds16(vsrc+(long)(t)*KVBLK*VP,(unsigned)__builtin_amdgcn_readfirstlane(vdst+(slot)))
  const int vb0=(int)(lds0+LDS_V)+((lane>>4)&1)*32+(lane&3)*8+(4*hi+((lane&15)>>2))*64;
  const char*Kbase=shm+LDS_K; bf16x8 kf[8];
  const lds_cptr shm3=(lds_cptr)shm; const lds_cptr kp0=shm3+LDS_K+hi*1024+r32*16; const lds_cptr vp0=shm3+LDS_V+((lane>>4)&1)*32+(lane&3)*8+(4*hi+((lane&15)>>2))*64;
  const int NT=NT_ALL;
  DMA_K(0,0);DMA_V(0,0);DMA_K(1,SLOTB);
  bf16x8 qr[4];
  #pragma unroll
  for(int d0=0;d0<4;++d0)qr[d0]=*reinterpret_cast<const bf16x8*>(&Qw[(long)r32*QP+d0*16+hi*8]);
  float mhat=0.f,l_reg=0.f;f32x16 o[2];o[0]=f32x16{};o[1]=f32x16{};f32x16 negm=f32x16{};asm volatile("":"+v"(negm));
  #define CMASK(P0,P1,t) do{}while(0)
  bool resc=false;
  #define START(P0,P1) do{ const float rm=rowmax(P0,P1); resc=false; \
    { const float dl=rm; mhat=fadd_s(mhat,dl); \
      _Pragma("unroll") for(int r=0;r<16;++r){P0[r]=fsub_s(P0[r],dl);P1[r]=fsub_s(P1[r],dl);} \
      _Pragma("unroll") for(int r=0;r<16;++r)negm[r]=-mhat; asm volatile("":"+v"(negm)); } \
    _Pragma("unroll") for(int r=0;r<16;++r)P0[r]=__builtin_amdgcn_exp2f(P0[r]); }while(0)
  #define RESC() do{ if(resc){ asm volatile("s_waitcnt lgkmcnt(0)":::"memory"); \
      _Pragma("unroll") for(int d_=0;d_<2;++d_) _Pragma("unroll") for(int r=0;r<16;++r)o[d_][r]*=wsf[crow(r,hi)]; } }while(0)
  f32x16 pA0,pA1,pB0,pB1;
  int sl_prev=0,sl_cur=0,sl_next=SLOTB;
  #define ROT() do{sl_prev=sl_cur;sl_cur=sl_next;sl_next=(sl_next==(NSLOT-1)*SLOTB)?0:sl_next+SLOTB;}while(0)
  DMA_K(2,2*SLOTB);
  WAIT_BAR(3);
  qkt(pA0,pA1,Kbase,qr,negm,r32,hi);asm volatile("s_nop 15\n\ts_nop 7":"+v"(pA0),"+v"(pA1));CMASK(pA0,pA1,0);
  START(pA0,pA1);
  _Pragma("unroll") for(int r=0;r<16;++r)pA1[r]=__builtin_amdgcn_exp2f(pA1[r]);
  WAIT_BAR(0);
  DMA_K(3,0);DMA_V(1,SLOTB);
  ROT();
  kload8(kf,kp0+sl_cur);
  WAIT_BAR(2);
  s16x4 vlo[8],vhi[8]; u32x4 pw0,pw1,pw2,pw3;
  #define PKW(P,B) cvtpk_s(P[B],P[B+1])
  #define PAF(k) __builtin_bit_cast(bf16x8,pw##k)
  #define VFR(i) (bf16x8){vlo[i][0],vlo[i][1],vlo[i][2],vlo[i][3],vhi[i][0],vhi[i][1],vhi[i][2],vhi[i][3]}
  #define PIN(x) asm volatile("":"+v"(x))
  #define MX3(a,b,c) __builtin_fmaxf(__builtin_fmaxf((a),(b)),(c))
  #define GAPA(MF,A0,A1,A2,A3,W0,W1,PW) do{ MF; sacc+=A0; sacc+=A1; sacc+=A2; sacc+=A3; PIN(sacc); W0; W1; PIN(PW); SBAR(); }while(0)
  #define EX(v) __builtin_amdgcn_exp2f(v)
  #define GAPB(MF,X,B) do{ MF; X[B]=EX(X[B]); X[B+1]=EX(X[B+1]); X[B+2]=EX(X[B+2]); X[B+3]=EX(X[B+3]); PIN(X); SBAR(); }while(0)
  #define VRD(i) do{ vlo[i]=vtr(vp_+(((i)>>2)*4096+((i)&3)*1024)); vhi[i]=vtr(vp_+(((i)>>2)*4096+((i)&3)*1024+512)); }while(0)
  #define KRD(G,j) do{ if(G){ kload2(kf,kp0+sl_next,j); SBAR(); } }while(0)
  #define STEP(C0,C1,P0,P1,t,GK,GV,GL) do{ SBAR(); \
    const lds_cptr vp_=vp0+sl_prev; \
    VRD(0); SBAR(); float sacc=(P0[0]+P0[1]); \
    GAPA(C0=__builtin_amdgcn_mfma_f32_32x32x16_bf16(kf[0],qr[0],negm,0,0,0), P0[2],P0[3],P0[4],P0[5],     pw0[0]=PKW(P0,0), pw0[1]=PKW(P0,2), pw0); \
    VRD(4); SBAR(); GAPA(C1=__builtin_amdgcn_mfma_f32_32x32x16_bf16(kf[1],qr[0],negm,0,0,0), P0[6],P0[7],P0[8],P0[9],     pw0[2]=PKW(P0,4), pw0[3]=PKW(P0,6), pw0); \
    VRD(1); SBAR(); GAPA(C0=__builtin_amdgcn_mfma_f32_32x32x16_bf16(kf[2],qr[1],C0,0,0,0),   P0[10],P0[11],P0[12],P0[13], pw1[0]=PKW(P0,8), pw1[1]=PKW(P0,10), pw1); \
    VRD(5); SBAR(); GAPA(C1=__builtin_amdgcn_mfma_f32_32x32x16_bf16(kf[3],qr[1],C1,0,0,0),   P0[14],P0[15],P1[0],P1[1],   pw1[2]=PKW(P0,12),pw1[3]=PKW(P0,14), pw1); \
    VRD(2); SBAR(); GAPA(C0=__builtin_amdgcn_mfma_f32_32x32x16_bf16(kf[4],qr[2],C0,0,0,0),   P1[2],P1[3],P1[4],P1[5],     pw2[0]=PKW(P1,0), pw2[1]=PKW(P1,2), pw2); \
    VRD(6); SBAR(); GAPA(C1=__builtin_amdgcn_mfma_f32_32x32x16_bf16(kf[5],qr[2],C1,0,0,0),   P1[6],P1[7],P1[8],P1[9],     pw2[2]=PKW(P1,4), pw2[3]=PKW(P1,6), pw2); \
    VRD(3); SBAR(); GAPA(C0=__builtin_amdgcn_mfma_f32_32x32x16_bf16(kf[6],qr[3],C0,0,0,0),   P1[10],P1[11],P1[12],P1[13], pw3[0]=PKW(P1,8), pw3[1]=PKW(P1,10), pw3); \
    VRD(7); SBAR(); GAPA(C1=__builtin_amdgcn_mfma_f32_32x32x16_bf16(kf[7],qr[3],C1,0,0,0),   P1[14],P1[15],0.f,0.f,       pw3[2]=PKW(P1,12),pw3[3]=PKW(P1,14), pw3); \
    l_reg+=sacc; \
    if(GK){DMA_K((t)+3,sl_cur);} if(GV){DMA_V((t)+1,sl_next);} \
    CMASK(C0,C1,t); \
    { float a=MX3(C0[0],C0[1],C1[0]),b=MX3(C0[2],C0[3],C1[1]); a=MX3(a,C1[2],C1[3]); \
      _Pragma("unroll") for(int r=4;r<16;r+=4){a=MX3(a,C0[r],C0[r+1]);b=MX3(b,C0[r+2],C0[r+3]);a=MX3(a,C1[r],C1[r+1]);b=MX3(b,C1[r+2],C1[r+3]);} \
      float rm=__builtin_fmaxf(a,b); { auto rr=__builtin_amdgcn_permlane32_swap(__float_as_uint(rm),__float_as_uint(rm),false,false); rm=__builtin_fmaxf(__uint_as_float(rr[0]),__uint_as_float(rr[1])); } \
      resc=false; \
      if(__builtin_expect(__any(rm>(float)THRL),0)){ const float dl=__builtin_fmaxf(rm,0.f); mhat+=dl; \
        _Pragma("unroll") for(int r=0;r<16;++r){C0[r]-=dl;C1[r]-=dl;} \
        _Pragma("unroll") for(int r=0;r<16;++r)negm[r]=-mhat; asm volatile("":"+v"(negm)); \
        const float f=__builtin_amdgcn_exp2f(-dl); l_reg*=f; if(hi==0)wsf[r32]=f; resc=true; } } \
    SBAR(); \
    GAPB(o[0]=__builtin_amdgcn_mfma_f32_32x32x16_bf16(PAF(0),VFR(0),o[0],0,0,0), C0,0); \
    GAPB(o[1]=__builtin_amdgcn_mfma_f32_32x32x16_bf16(PAF(0),VFR(4),o[1],0,0,0), C0,4); \
    KRD(GL,0); GAPB(o[0]=__builtin_amdgcn_mfma_f32_32x32x16_bf16(PAF(1),VFR(1),o[0],0,0,0), C0,8); \
    KRD(GL,1); GAPB(o[1]=__builtin_amdgcn_mfma_f32_32x32x16_bf16(PAF(1),VFR(5),o[1],0,0,0), C0,12); \
    KRD(GL,2); GAPB(o[0]=__builtin_amdgcn_mfma_f32_32x32x16_bf16(PAF(2),VFR(2),o[0],0,0,0), C1,0); \
    KRD(GL,3); GAPB(o[1]=__builtin_amdgcn_mfma_f32_32x32x16_bf16(PAF(2),VFR(6),o[1],0,0,0), C1,4); \
    GAPB(o[0]=__builtin_amdgcn_mfma_f32_32x32x16_bf16(PAF(3),VFR(3),o[0],0,0,0), C1,8); \
    GAPB(o[1]=__builtin_amdgcn_mfma_f32_32x32x16_bf16(PAF(3),VFR(7),o[1],0,0,0), C1,12); \
    }while(0)
  int t=1;
  #undef CMASK
  #define CMASK(P0,P1,t) do{}while(0)
  for(;t+5<NT;t+=2){
    STEP(pB0,pB1,pA0,pA1,t,true,true,true);     WAIT_BAR(2); RESC(); ROT();
    STEP(pA0,pA1,pB0,pB1,t+1,true,true,true);   WAIT_BAR(2); RESC(); ROT();
  }
  #undef CMASK
  #define CMASK(P0,P1,t) do{}while(0)
  #define ENDW(tt) do{ if((tt)+3<NT){WAIT_BAR(2);} else if((tt)+2<NT){WAIT_BAR(1);} else {WAIT_BAR(0);} }while(0)
  for(;t+1<NT;t+=2){
    STEP(pB0,pB1,pA0,pA1,t,(t+3<NT),(t+1<NT),(t+1<NT));       ENDW(t);   RESC(); ROT();
    STEP(pA0,pA1,pB0,pB1,t+1,(t+4<NT),(t+2<NT),(t+2<NT));     ENDW(t+1); RESC(); ROT();
  }
  STEP(pB0,pB1,pA0,pA1,NT-1,false,false,false); RESC();
  { float sacc=pB0[0]+pB0[1]; _Pragma("unroll") for(int r=2;r<16;++r)sacc+=pB0[r]; _Pragma("unroll") for(int r=0;r<16;++r)sacc+=pB1[r]; l_reg+=sacc;
    pw0=(u32x4){PKW(pB0,0),PKW(pB0,2),PKW(pB0,4),PKW(pB0,6)};pw1=(u32x4){PKW(pB0,8),PKW(pB0,10),PKW(pB0,12),PKW(pB0,14)};pw2=(u32x4){PKW(pB1,0),PKW(pB1,2),PKW(pB1,4),PKW(pB1,6)};pw3=(u32x4){PKW(pB1,8),PKW(pB1,10),PKW(pB1,12),PKW(pB1,14)};
    SBAR(); pv(o,vb0+sl_cur,PAF(0),PAF(1),PAF(2),PAF(3)); }
  #undef PKW
  #undef PAF
  #undef VFR
  #undef PIN
  #undef MX3
  #undef GAPA
  #undef GAPB
  #undef EX
  #undef VRD
  #undef KRD
  #undef STEP
  #undef ENDW
  {auto rr=__builtin_amdgcn_permlane32_swap(__float_as_uint(l_reg),__float_as_uint(l_reg),false,false);l_reg=__uint_as_float(rr[0])+__uint_as_float(rr[1]);}
  if(hi==0)wsf[32+r32]=l_reg;asm volatile("s_waitcnt lgkmcnt(0)":::"memory");
  float rli[16];
  #pragma unroll
  for(int r=0;r<16;++r)rli[r]=__builtin_amdgcn_rcpf(wsf[32+crow(r,hi)]);
  bf16*Ow=Oblk+(long)(wid*QBLK)*OP;
  { bf16*stg=(bf16*)(shm+LDS_OST)+wid*2048;
    #pragma unroll
    for(int r=0;r<16;++r){const int orow=crow(r,hi);
      #pragma unroll
      for(int d0=0;d0<2;++d0)stg[orow*64+d0*32+r32]=__float2bfloat16(o[d0][r]*rli[r]);}
    asm volatile("s_waitcnt lgkmcnt(0)":::"memory");
    #pragma unroll
    for(int i=0;i<4;++i){const int row=i*8+(lane>>3),ch=lane&7; const u32x4 v=*(const u32x4*)(stg+row*64+ch*8); ATTN_STORE16(Ow+(long)row*OP+ch*8,v);} }
  asm volatile("s_waitcnt lgkmcnt(0)\n\ts_barrier":::"memory");
  #undef DMA_K
  #undef DMA_V
  #undef CMASK
  #undef START
  #undef RESC
  #undef ROT
}
constexpr int ATTN_LDS_BYTES=LDS_BYTES;
#undef SBAR
#undef WAIT_BAR
}


#define GAS __attribute__((address_space(1)))
#define LAS __attribute__((address_space(3)))
typedef unsigned short bf16;
typedef unsigned v4u __attribute__((ext_vector_type(4)));
typedef unsigned v2u __attribute__((ext_vector_type(2)));
typedef float f32x4 __attribute__((ext_vector_type(4)));
typedef short bf16x8 __attribute__((ext_vector_type(8)));
typedef GAS unsigned gu32;

constexpr int NWAVES = 8, NTHR = 512;
constexpr int DM = 1024, NB = 4, SEQ = 8192, NTOK = NB * SEQ, CTX = 256, NCTX = NB * CTX, DFF = 2816, NKV = SEQ + CTX;
constexpr int DHY = 512, NIN = 3072, NUP = 2 * DFF;
constexpr float EPS = 1e-6f;
constexpr int SLAB_TILES = 133;
constexpr size_t MiB = 1u << 20;
constexpr size_t WS_CTL = 0, WS_STAT = 1 * MiB, WS_MOD = 2 * MiB, WS_CMOD = WS_MOD + 256 * 1024, WS_ROPE = WS_CMOD + 16 * 1024, WS_H2 = 3 * MiB;
constexpr size_t WS_WIN = 8 * MiB, WS_WOUT = 14 * MiB, WS_WUP0 = 16 * MiB, WS_WUP1 = 27 * MiB, WS_WDN0 = 38 * MiB, WS_WDN1 = 44 * MiB, WS_WSIN = 50 * MiB, WS_WSOUT = 54 * MiB, WS_W3 = 56 * MiB, WS_WS = 57 * MiB;
constexpr size_t WS_ACT = 58 * MiB, WS_HC = 124 * MiB, WS_R = 126 * MiB, WS_HY = 158 * MiB, WS_Q = 254 * MiB, WS_K = 286 * MiB, WS_V = 320 * MiB, WS_O = 354 * MiB, WS_YAT = 418 * MiB, WS_END = 450 * MiB;
constexpr size_t WS_HID = 158 * MiB, WS_SU = 158 * MiB, WS_SV = 222 * MiB;
static_assert(WS_ACT + (size_t)(NTOK + 301) * DM * 2 <= WS_HC && WS_HID + (size_t)NTOK * DFF * 2 <= WS_O, "ws map");
constexpr int LDS_BYTES = 147456, RING_BYTES = 131072, MISC_OFF = LDS_BYTES - 256;

#define RLX_AGENT __ATOMIC_RELAXED, __HIP_MEMORY_SCOPE_AGENT
#define LDS_WAIT() asm volatile("s_waitcnt lgkmcnt(0)" ::: "memory")
__device__ __forceinline__ unsigned f2bf(float f) { unsigned u = __builtin_bit_cast(unsigned, f); return (u + 0x7fffu + ((u >> 16) & 1u)) >> 16; }
__device__ __forceinline__ unsigned pk2(float lo, float hi) { return f2bf(lo) | (f2bf(hi) << 16); }
__device__ __forceinline__ float bf2f(unsigned h) { return __builtin_bit_cast(float, h << 16); }
__device__ __forceinline__ float bflo(unsigned w) { return __builtin_bit_cast(float, w << 16); }
__device__ __forceinline__ float bfhi(unsigned w) { return __builtin_bit_cast(float, w & 0xffff0000u); }
__device__ __forceinline__ float wave_sum(float v) {
#pragma unroll
    for (int o = 1; o < 64; o <<= 1) v += __shfl_xor(v, o);
    return v;
}
#ifndef USE_DPP
#define USE_DPP 1
#endif
__device__ __forceinline__ float rot_prev(float v) {
#if USE_DPP
    return __builtin_bit_cast(float, __builtin_amdgcn_update_dpp(0, __builtin_bit_cast(int, v), 0x121, 0xf, 0xf, false));
#else
    const int l = threadIdx.x & 63; return __shfl(v, (l & 48) | ((l - 1) & 15));
#endif
}
__device__ __forceinline__ float rot_next(float v) {
#if USE_DPP
    return __builtin_bit_cast(float, __builtin_amdgcn_update_dpp(0, __builtin_bit_cast(int, v), 0x12F, 0xf, 0xf, false));
#else
    const int l = threadIdx.x & 63; return __shfl(v, (l & 48) | ((l + 1) & 15));
#endif
}
__device__ __forceinline__ f32x4 rot_prev4(f32x4 v) { return (f32x4){rot_prev(v[0]), rot_prev(v[1]), rot_prev(v[2]), rot_prev(v[3])}; }
__device__ __forceinline__ f32x4 rot_next4(f32x4 v) { return (f32x4){rot_next(v[0]), rot_next(v[1]), rot_next(v[2]), rot_next(v[3])}; }

namespace epi {
using pg8::Unit; using pg8::bf16_t;
typedef float f32x4 __attribute__((ext_vector_type(4)));

struct EpiInProj {
    static constexpr bool PERM = false, AFTER_DRAIN = false;
    bf16_t* HY; bf16_t* Q; bf16_t* Kb; bf16_t* Vb; const float* cw; const float* cb; const float* rope;
    __device__ __forceinline__ void operator()(const f32x4 (&acc)[2][2][4][2], const Unit& u, int wr, int wc, int fr, int fq) const {
        if (u.pn < 6) {
#pragma unroll
            for (int ai = 0; ai < 2; ++ai) {
                const int gbase = 248 * u.pm + 62 * (2 * ai + wr) - 1;
#pragma unroll
                for (int bj = 0; bj < 2; ++bj)
#pragma unroll
                    for (int n = 0; n < 2; ++n) {
                        const int col = 256 * u.pn + 128 * bj + 32 * wc + 16 * n + 4 * fq;
                        const f32x4 w0 = *(const f32x4*)(cw + col), w1 = *(const f32x4*)(cw + 1536 + col), w2 = *(const f32x4*)(cw + 3072 + col), bb = *(const f32x4*)(cb + col);
                        f32x4 rp_prev = (f32x4){0.f, 0.f, 0.f, 0.f}, rn_cur = rot_next4(acc[ai][bj][0][n]);
#pragma unroll
                        for (int m = 0; m < 4; ++m) {
                            const int j = 16 * m + fr, g = gbase + j, t = g & (SEQ - 1), b = g >> 13;
                            const f32x4 rp_cur = rot_prev4(acc[ai][bj][m][n]);
                            const f32x4 rn_next = (m < 3) ? rot_next4(acc[ai][bj][m < 3 ? m + 1 : 3][n]) : rn_cur;
                            f32x4 p = (fr == 0) ? rp_prev : rp_cur;
                            f32x4 q = (fr == 15) ? rn_next : rn_cur;
                            rp_prev = rp_cur; rn_cur = rn_next;
                            if (t == 0) p = (f32x4){0.f, 0.f, 0.f, 0.f};
                            if (t == SEQ - 1) q = (f32x4){0.f, 0.f, 0.f, 0.f};
                            const f32x4 o = w0 * p + w1 * acc[ai][bj][m][n] + w2 * q + bb;
                            if (j >= 1 && j <= 62 && g < NTOK) {
                                bf16_t* dst = HY + ((size_t)(b * 1536 + col) * SEQ + t);
                                dst[0] = (bf16_t)f2bf(o[0]); dst[SEQ] = (bf16_t)f2bf(o[1]); dst[2 * SEQ] = (bf16_t)f2bf(o[2]); dst[3 * SEQ] = (bf16_t)f2bf(o[3]);
                            }
                        }
                        asm volatile("" ::: "memory");
                    }
            }
        } else if (u.pn < 10) {
            const bool isq = u.pn < 8;
            const float sc = isq ? attn_body::C2 : 1.0f;
#pragma unroll
            for (int ai = 0; ai < 2; ++ai) {
                const int gbase = 248 * u.pm + 62 * (2 * ai + wr) - 1;
#pragma unroll
                for (int m = 0; m < 4; ++m) {
                    const int j = 16 * m + fr, g = gbase + j, t = g & (SEQ - 1), b = g >> 13;
                    const bool ok = (j >= 1 && j <= 62 && g < NTOK);
                    const int pos = (wc & 1) ? (t & 63) : (t >> 6);
                    const float* rp = rope + (size_t)(pos * 16 + 4 * fq) * 2;
                    const f32x4 cs0 = *(const f32x4*)rp, cs1 = *(const f32x4*)(rp + 4);
                    const f32x4 cc = (f32x4){cs0[0], cs0[2], cs1[0], cs1[2]}, ss = (f32x4){cs0[1], cs0[3], cs1[1], cs1[3]};
#pragma unroll
                    for (int bj = 0; bj < 2; ++bj) {
                        const f32x4 x1 = acc[ai][bj][m][0], x2 = acc[ai][bj][m][1];
                        const f32x4 o1 = (x1 * cc - x2 * ss) * sc, o2 = (x1 * ss + x2 * cc) * sc;
                        const int col = 256 * (u.pn - (isq ? 6 : 8)) + 128 * bj + 32 * wc + 4 * fq;
                        if (ok) {
                            bf16_t* dst = isq ? (Q + (size_t)g * 512 + col) : (Kb + ((size_t)b * NKV + CTX + t) * 512 + col);
                            *(v2u*)dst = (v2u){pk2(o1[0], o1[1]), pk2(o1[2], o1[3])};
                            *(v2u*)(dst + 16) = (v2u){pk2(o2[0], o2[1]), pk2(o2[2], o2[3])};
                        }
                    }
                    asm volatile("" ::: "memory");
                }
            }
        } else {
#pragma unroll
            for (int ai = 0; ai < 2; ++ai) {
                const int gbase = 248 * u.pm + 62 * (2 * ai + wr) - 1;
#pragma unroll
                for (int m = 0; m < 4; ++m) {
                    const int j = 16 * m + fr, g = gbase + j, t = g & (SEQ - 1), b = g >> 13;
                    if (j >= 1 && j <= 62 && g < NTOK) {
#pragma unroll
                        for (int bj = 0; bj < 2; ++bj)
#pragma unroll
                            for (int n = 0; n < 2; ++n) {
                                const int col = 256 * (u.pn - 10) + 128 * bj + 32 * wc + 16 * n + 4 * fq;
                                const f32x4 v = acc[ai][bj][m][n];
                                *(v2u*)(Vb + ((size_t)b * NKV + CTX + t) * 512 + col) = (v2u){pk2(v[0], v[1]), pk2(v[2], v[3])};
                            }
                    }
                }
            }
        }
    }
};

struct EpiCtxKV {
    static constexpr bool PERM = false, AFTER_DRAIN = false;
    bf16_t* Kb; bf16_t* Vb;
    __device__ __forceinline__ void operator()(const f32x4 (&acc)[2][2][4][2], const Unit& u, int wr, int wc, int fr, int fq) const {
#pragma unroll
        for (int ai = 0; ai < 2; ++ai)
#pragma unroll
            for (int m = 0; m < 4; ++m) {
                const int row = 256 * u.pm + 128 * ai + 64 * wr + 16 * m + fr, b = row >> 8, tc = row & 255;
#pragma unroll
                for (int bj = 0; bj < 2; ++bj)
#pragma unroll
                    for (int n = 0; n < 2; ++n) {
                        const int col = 256 * u.pn + 128 * bj + 32 * wc + 16 * n + 4 * fq;
                        const f32x4 v = acc[ai][bj][m][n];
                        bf16_t* dst = (col < 512) ? (Kb + ((size_t)b * NKV + tc) * 512 + col) : (Vb + ((size_t)b * NKV + tc) * 512 + (col - 512));
                        *(v2u*)dst = (v2u){pk2(v[0], v[1]), pk2(v[2], v[3])};
                    }
            }
    }
};

struct EpiResid {
    static constexpr bool PERM = false, AFTER_DRAIN = false;
    const float* base; float* out; const float* gate;
    __device__ __forceinline__ void operator()(const f32x4 (&acc)[2][2][4][2], const Unit& u, int wr, int wc, int fr, int fq) const {
#pragma unroll
        for (int ai = 0; ai < 2; ++ai)
#pragma unroll
            for (int m = 0; m < 4; ++m) {
                const int row = 256 * u.pm + 128 * ai + 64 * wr + 16 * m + fr, b = row >> 13;
#pragma unroll
                for (int bj = 0; bj < 2; ++bj)
#pragma unroll
                    for (int n = 0; n < 2; ++n) {
                        const int col = 256 * u.pn + 128 * bj + 32 * wc + 16 * n + 4 * fq;
                        const f32x4 gt = *(const f32x4*)(gate + b * 6144 + col), bs = *(const f32x4*)(base + (size_t)row * DM + col);
                        *(f32x4*)(out + (size_t)row * DM + col) = bs + gt * acc[ai][bj][m][n];
                    }
            }
    }
};

struct EpiFfnUp {
    static constexpr bool PERM = true, AFTER_DRAIN = false;
    bf16_t* H; const float* cw; const float* cb;
    __device__ __forceinline__ void operator()(const f32x4 (&acc)[2][2][4][2], const Unit& u, int wr, int wc, int fr, int fq) const {
#pragma unroll
        for (int ai = 0; ai < 2; ++ai) {
            const int gbase = 248 * u.pm + 62 * (2 * ai + wr) - 1;
#pragma unroll
            for (int n = 0; n < 2; ++n) {
                const int ch = 128 * u.pn + 32 * wc + 8 * fq + 4 * n;
                const f32x4 g0 = *(const f32x4*)(cw + ch), g1 = *(const f32x4*)(cw + NUP + ch), g2 = *(const f32x4*)(cw + 2 * NUP + ch), gb = *(const f32x4*)(cb + ch);
                const f32x4 u0 = *(const f32x4*)(cw + DFF + ch), u1 = *(const f32x4*)(cw + NUP + DFF + ch), u2 = *(const f32x4*)(cw + 2 * NUP + DFF + ch), ub = *(const f32x4*)(cb + DFF + ch);
                const f32x4 z = (f32x4){0.f, 0.f, 0.f, 0.f};
                f32x4 gp_prev = z, up_prev = z, gn_cur = rot_next4(acc[ai][0][0][n]), un_cur = rot_next4(acc[ai][1][0][n]);
#pragma unroll
                for (int m = 0; m < 4; ++m) {
                    const int j = 16 * m + fr, g = gbase + j, t = g & (SEQ - 1);
                    const f32x4 gp_cur = rot_prev4(acc[ai][0][m][n]), up_cur = rot_prev4(acc[ai][1][m][n]);
                    const f32x4 gn_next = (m < 3) ? rot_next4(acc[ai][0][m < 3 ? m + 1 : 3][n]) : gn_cur, un_next = (m < 3) ? rot_next4(acc[ai][1][m < 3 ? m + 1 : 3][n]) : un_cur;
                    f32x4 pg = (fr == 0) ? gp_prev : gp_cur, ng = (fr == 15) ? gn_next : gn_cur;
                    f32x4 pu = (fr == 0) ? up_prev : up_cur, nu = (fr == 15) ? un_next : un_cur;
                    gp_prev = gp_cur; up_prev = up_cur; gn_cur = gn_next; un_cur = un_next;
                    if (t == 0) { pg = z; pu = z; }
                    if (t == SEQ - 1) { ng = z; nu = z; }
                    const f32x4 gc = g0 * pg + g1 * acc[ai][0][m][n] + g2 * ng + gb;
                    const f32x4 uc = u0 * pu + u1 * acc[ai][1][m][n] + u2 * nu + ub;
                    f32x4 h;
#pragma unroll
                    for (int e = 0; e < 4; ++e) h[e] = gc[e] / (1.0f + __expf(-gc[e])) * uc[e];
                    if (j >= 1 && j <= 62 && g < NTOK) *(v2u*)(H + (size_t)g * DFF + ch) = (v2u){pk2(h[0], h[1]), pk2(h[2], h[3])};
                }
                asm volatile("" ::: "memory");
            }
        }
    }
};

struct EpiSguIn {
    static constexpr bool PERM = true, AFTER_DRAIN = false;
    bf16_t* U; bf16_t* V; const float* bias; float* stat;
    __device__ __forceinline__ void operator()(const f32x4 (&acc)[2][2][4][2], const Unit& u, int wr, int wc, int fr, int fq) const {
        const bool isv = u.pn >= 4;
#pragma unroll
        for (int ai = 0; ai < 2; ++ai)
#pragma unroll
            for (int m = 0; m < 4; ++m) {
                const int row = 256 * u.pm + 128 * ai + 64 * wr + 16 * m + fr;
                float s = 0.f, s2 = 0.f;
#pragma unroll
                for (int bj = 0; bj < 2; ++bj) {
                    const int col = 256 * u.pn + 128 * bj + 32 * wc + 8 * fq;
                    const f32x4 b0 = *(const f32x4*)(bias + col), b1 = *(const f32x4*)(bias + col + 4);
                    const f32x4 v0 = acc[ai][bj][m][0] + b0, v1 = acc[ai][bj][m][1] + b1;
                    const pg8::f32x2 a = pg8::gelu_pk((pg8::f32x2){v0[0], v0[1]}), b = pg8::gelu_pk((pg8::f32x2){v0[2], v0[3]}), c = pg8::gelu_pk((pg8::f32x2){v1[0], v1[1]}), d = pg8::gelu_pk((pg8::f32x2){v1[2], v1[3]});
                    s += (a.x + a.y) + (b.x + b.y) + (c.x + c.y) + (d.x + d.y);
                    s2 += (a.x * a.x + a.y * a.y) + (b.x * b.x + b.y * b.y) + (c.x * c.x + c.y * c.y) + (d.x * d.x + d.y * d.y);
                    bf16_t* dst = (isv ? V : U) + (size_t)row * DM + (col & 1023);
                    *(v4u*)dst = (v4u){pk2(a.x, a.y), pk2(b.x, b.y), pk2(c.x, c.y), pk2(d.x, d.y)};
                }
                if (isv) {
                    s += __shfl_xor(s, 16); s += __shfl_xor(s, 32); s2 += __shfl_xor(s2, 16); s2 += __shfl_xor(s2, 32);
                    if (fq == 0) { atomicAdd(stat + 2 * row, s); atomicAdd(stat + 2 * row + 1, s2); }
                }
            }
    }
};
}

#define VM_WAIT() asm volatile("s_waitcnt vmcnt(0)" ::: "memory")
#define XB_TMO      128
#define XB_XCNT(j)  (256  + 64 * (j))
#define XB_XSUB(j)  (1280 + 64 * (j))
#define XB_XGEN(j)  (2304 + 64 * (j))
#define XB_TOP      3328
#define XB_TOPGEN   3392
#define XCD_BAR_WORDS 3456
#define XB_SPIN_CAP (1u << 18)

__device__ __forceinline__ unsigned xb_ld(unsigned* p)              { return __hip_atomic_load(p, __ATOMIC_RELAXED, __HIP_MEMORY_SCOPE_AGENT); }
__device__ __forceinline__ unsigned xb_add(unsigned* p, unsigned v) { return __hip_atomic_fetch_add(p, v, __ATOMIC_RELAXED, __HIP_MEMORY_SCOPE_AGENT); }
__device__ __forceinline__ unsigned xb_xcc_id() { return (unsigned)__builtin_amdgcn_s_getreg((3 << 11) | 20) & 0xFu; }
#define XB_SPIN(cond, bar) do { unsigned _sp = 0; while (cond) { __builtin_amdgcn_s_sleep(1); \
    if ((++_sp & 255u) == 0u) { if (xb_ld(&(bar)[XB_TMO])) break; if (_sp > XB_SPIN_CAP) { atomicAdd(&(bar)[XB_TMO], 1u); break; } } } } while (0)

struct XcdBarrier {
    unsigned* bar; unsigned x;
    volatile LAS unsigned* st;
};

__device__ __forceinline__ XcdBarrier xcd_barrier_post(unsigned* bar, volatile LAS unsigned* st) {
    XcdBarrier b; b.bar = bar; b.x = xb_xcc_id(); b.st = st;
    if (threadIdx.x == 0) (void)xb_add(&bar[XB_XCNT(b.x)], 1u);
    return b;
}
__device__ __forceinline__ void xcd_barrier_complete(unsigned* bar, unsigned x, unsigned& nloc, unsigned& nx) {
    const unsigned G = gridDim.x * gridDim.y * gridDim.z;
    unsigned sum, cnt, mine, sp = 0u;
    for (;;) {
        sum = 0u; cnt = 0u; mine = 0u;
#pragma unroll
        for (unsigned j = 0; j < 16; ++j) { const unsigned c = xb_ld(&bar[XB_XCNT(j)]); sum += c; cnt += (c > 0u) ? 1u : 0u; mine = (j == x) ? c : mine; }
        if (sum == G) break;
        __builtin_amdgcn_s_sleep(1);
        if ((++sp & 255u) == 0u) { if (xb_ld(&bar[XB_TMO])) break; if (sp > XB_SPIN_CAP) { atomicAdd(&bar[XB_TMO], 1u); break; } }
    }
    nloc = mine > 0u ? mine : 1u; nx = cnt > 0u ? cnt : 1u;
}

__device__ __forceinline__ void xcd_barrier(const XcdBarrier& b) {
    asm volatile("s_waitcnt vmcnt(0)" ::: "memory");
    __syncthreads();
    if (threadIdx.x == 0) {
        unsigned* bar = b.bar;
        __builtin_amdgcn_s_waitcnt(0);
        unsigned nloc = b.st[0], nx = b.st[1];
        if (nloc == 0u) { xcd_barrier_complete(bar, b.x, nloc, nx); b.st[0] = nloc; b.st[1] = nx; }
        const unsigned old = xb_add(&bar[XB_XSUB(b.x)], 1u);
        const unsigned gen = old / nloc;
        if (old + 1u == (gen + 1u) * nloc) {
            __builtin_amdgcn_fence(__ATOMIC_RELEASE, "agent");
            asm volatile("s_waitcnt vmcnt(0)" ::: "memory");
            const unsigned og = xb_add(&bar[XB_TOP], 1u);
            const unsigned tg = og / nx;
            if (og + 1u == (tg + 1u) * nx) xb_add(&bar[XB_TOPGEN], 1u);
            else XB_SPIN(xb_ld(&bar[XB_TOPGEN]) == tg, bar);
            __builtin_amdgcn_fence(__ATOMIC_ACQUIRE, "agent");
            xb_add(&bar[XB_XGEN(b.x)], 1u);
            asm volatile("s_waitcnt vmcnt(0)" ::: "memory");
        } else {
            XB_SPIN(xb_ld(&bar[XB_XGEN(b.x)]) == gen, bar);
            __builtin_amdgcn_fence(__ATOMIC_ACQUIRE, "agent");
            asm volatile("s_waitcnt vmcnt(0)" ::: "memory");
        }
    }
    __syncthreads();
}

typedef const float* fptr_t;
typedef __attribute__((address_space(4))) const fptr_t* ktab;
struct Ctx {
    LAS unsigned char* lds; unsigned char* ldsg; int tid, lane, wave, G, bx;
    ktab kin; float* out; unsigned char* ws;
};
__device__ __forceinline__ const float* ld_in(ktab t, int k) { asm volatile("" : "+s"(t)); return t[k]; }
#define INP(k) ld_in(C.kin, (k))
#define WSP(T, off) ((T*)(C.ws + (off)))

__device__ __forceinline__ void p0_transpose_item(const float* W, int ldw, int k0, int n0, bf16* WT, int ldt, int drow0, LAS float* scr, int lane) {
#pragma unroll 8
    for (int i = 0; i < 32; ++i) { const int kk = 2 * i + (lane >> 5); scr[kk * 33 + (lane & 31)] = W[(size_t)(k0 + kk) * ldw + n0 + (lane & 31)]; }
    LDS_WAIT(); asm volatile("" ::: "memory");
    const int c = lane & 7;
#pragma unroll
    for (int j = 0; j < 4; ++j) { const int n = (lane >> 3) + 8 * j; const LAS float* s = scr + (8 * c) * 33 + n;
        v4u o; o.x = pk2(s[0 * 33], s[1 * 33]); o.y = pk2(s[2 * 33], s[3 * 33]); o.z = pk2(s[4 * 33], s[5 * 33]); o.w = pk2(s[6 * 33], s[7 * 33]);
        *(v4u*)(WT + (size_t)(drow0 + n) * ldt + k0 + 8 * c) = o; }
    LDS_WAIT(); asm volatile("" ::: "memory");
}
__device__ __forceinline__ void p0_mat(const float* W, int K, int N, bf16* WT, int ldt, int item, bool ffn_perm, LAS float* scr, int lane) {
    const int nblk = N / 32, kb = item / nblk, nb = item % nblk, n0 = 32 * nb;
    int drow0 = n0;
    if (ffn_perm) { const int s = n0 / DFF, ch = n0 % DFF; drow0 = 256 * (ch >> 7) + 128 * s + (ch & 127); }
    p0_transpose_item(W, N, 64 * kb, n0, WT, ldt, drow0, scr, lane);
}
__device__ __forceinline__ float silu_f(float v) { return v / (1.0f + __expf(-v)); }

__device__ __forceinline__ void phase_p0(Ctx& C) {
    LAS float* scr = (LAS float*)(C.lds + C.wave * 16384);
    const int gw = C.bx * NWAVES + C.wave, NGW = C.G * NWAVES, lane = C.lane;
    const int gt = C.bx * NTHR + C.tid, NGT = C.G * NTHR;
    constexpr int I_IN = 16 * 96, I_OUT = 16 * 32, I_UP = 16 * 176, I_DN = 44 * 32, I_SIN = 16 * 64, I_SOUT = 16 * 32;
    constexpr int NITEMS = I_IN + I_OUT + 2 * I_UP + 2 * I_DN + I_SIN + I_SOUT;
    for (int it = gw; it < NITEMS; it += NGW) {
        int r = it;
        if (r < I_IN) { p0_mat(INP(12), 1024, NIN, WSP(bf16, WS_WIN), 1024, r, false, scr, lane); continue; } r -= I_IN;
        if (r < I_OUT) { p0_mat(INP(24), 1024, 1024, WSP(bf16, WS_WOUT), 1024, r, false, scr, lane); continue; } r -= I_OUT;
        if (r < I_UP) { p0_mat(INP(8), 1024, NUP, WSP(bf16, WS_WUP0), 1024, r, true, scr, lane); continue; } r -= I_UP;
        if (r < I_UP) { p0_mat(INP(8) + (size_t)1024 * NUP, 1024, NUP, WSP(bf16, WS_WUP1), 1024, r, true, scr, lane); continue; } r -= I_UP;
        if (r < I_DN) { p0_mat(INP(11), DFF, 1024, WSP(bf16, WS_WDN0), DFF, r, false, scr, lane); continue; } r -= I_DN;
        if (r < I_DN) { p0_mat(INP(11) + (size_t)DFF * 1024, DFF, 1024, WSP(bf16, WS_WDN1), DFF, r, false, scr, lane); continue; } r -= I_DN;
        if (r < I_SIN) { p0_mat(INP(25), 1024, 2048, WSP(bf16, WS_WSIN), 1024, r, false, scr, lane); continue; } r -= I_SIN;
        p0_mat(INP(31), 1024, 1024, WSP(bf16, WS_WSOUT), 1024, r, false, scr, lane);
    }
    for (int i = gt; i < 8 * 128 * 128 / 8; i += NGT) { const float* s = INP(29) + (size_t)i * 8; const f32x4 a = *(const f32x4*)s, b = *(const f32x4*)(s + 4);
        *(v4u*)(WSP(bf16, WS_WS) + (size_t)i * 8) = (v4u){pk2(a[0], a[1]), pk2(a[2], a[3]), pk2(b[0], b[1]), pk2(b[2], b[3])}; }
    for (int i = gt; i < NTOK * 2 / 4; i += NGT) *(f32x4*)(WSP(float, WS_STAT) + (size_t)i * 4) = (f32x4){0.f, 0.f, 0.f, 0.f};
    for (int i = gt; i < 128 * 16; i += NGT) { const int pos = i >> 4, k = i & 15; const float inv = powf(10000.0f, -(float)k / 16.0f), ang = (float)pos * inv; float sn, cs; sincosf(ang, &sn, &cs);
        WSP(float, WS_ROPE)[2 * i] = cs; WSP(float, WS_ROPE)[2 * i + 1] = sn; }
    {
        const float* w1 = INP(15); const float* b1 = INP(16); const float* fr = INP(17); const float* w2 = INP(18); const float* b2 = INP(19);
        const float f0 = fr[lane], f1 = fr[64 + lane], bb1 = b1[lane], bb2 = b2[lane];
        for (int t = gw; t < SEQ; t += NGW) {
            float z = 0.f;
            if (lane == 0) z = (float)t * (1.0f / 8191.0f);
            else if (lane <= 32) { const int k = (lane - 1) & 15; const float band = 1e-4f + (float)k * ((15.0f - 1e-4f) / 15.0f);
                const float ang = ((6.283185307179586f / 8192.0f) * (float)t) * band; z = (lane <= 16) ? cosf(ang) : -sinf(ang); }
            float a = bb1;
#pragma unroll
            for (int i = 0; i < 33; ++i) a += __shfl(z, i) * w1[i * 64 + lane];
            const float h1 = sinf(f0 * a);
            float a2 = bb2;
#pragma unroll 16
            for (int i = 0; i < 64; ++i) a2 += __shfl(h1, i) * w2[i * 64 + lane];
            const float h2 = sinf(f1 * a2);
            WSP(bf16, WS_H2)[(size_t)lane * SEQ + t] = (bf16)f2bf(h2);
        }
    }
    __syncthreads();
    {
        LAS float* red = (LAS float*)C.lds;
        for (int it = C.bx; it < 2 * 96; it += C.G) {
            const int l = it / 96, cb = it % 96, col = cb * 64 + lane;
            const float* W = INP(4) + (size_t)l * 1024 * 6144;
            float a0 = 0.f, a1 = 0.f, a2 = 0.f, a3 = 0.f, a4 = 0.f;
            const int kbeg = C.wave * 128;
#pragma unroll 4
            for (int k = kbeg; k < kbeg + 128; ++k) {
                const float w = W[(size_t)k * 6144 + col];
                a0 += silu_f(INP(1)[k]) * w; a1 += silu_f(INP(1)[1024 + k]) * w; a2 += silu_f(INP(1)[2048 + k]) * w; a3 += silu_f(INP(1)[3072 + k]) * w; a4 += silu_f(INP(3)[k]) * w;
            }
            red[(C.wave * 5 + 0) * 64 + lane] = a0; red[(C.wave * 5 + 1) * 64 + lane] = a1; red[(C.wave * 5 + 2) * 64 + lane] = a2; red[(C.wave * 5 + 3) * 64 + lane] = a3; red[(C.wave * 5 + 4) * 64 + lane] = a4;
            __syncthreads();
            if (C.tid < 320) { const int v = C.tid >> 6, cc = C.tid & 63; float s = 0.f;
#pragma unroll
                for (int w = 0; w < 8; ++w) s += red[(w * 5 + v) * 64 + cc];
                const int oc = cb * 64 + cc; s += INP(5)[l * 6144 + oc];
                if (v < 4) WSP(float, WS_MOD)[(size_t)(l * 4 + v) * 6144 + oc] = s;
                else if (l == 0 && oc < 2048) WSP(float, WS_CMOD)[oc] = s; }
            __syncthreads();
        }
    }
}

__device__ __forceinline__ void phase_norm_mod(Ctx& C, const float* src, int rows, int rows_per_batch, const float* g, const float* shift, const float* scale, int bstride, bf16* dst) {
    const int gw = C.bx * NWAVES + C.wave, NGW = C.G * NWAVES, lane = C.lane;
    for (int r = gw; r < rows; r += NGW) {
        const f32x4* xr = (const f32x4*)(src + (size_t)r * DM) + lane;
        const int b = r / rows_per_batch;
        f32x4 v[4]; float s = 0.f;
#pragma unroll
        for (int j = 0; j < 4; ++j) { v[j] = xr[64 * j]; s += (v[j][0] * v[j][0] + v[j][1] * v[j][1]) + (v[j][2] * v[j][2] + v[j][3] * v[j][3]); }
        const float rstd = 1.0f / sqrtf(wave_sum(s) * (1.0f / DM) + EPS);
        v2u* o = (v2u*)(dst + (size_t)r * DM) + lane;
#pragma unroll
        for (int j = 0; j < 4; ++j) {
            const int col = 4 * (lane + 64 * j);
            const f32x4 gg = *(const f32x4*)(g + col), sh = *(const f32x4*)(shift + (size_t)b * bstride + col), sc = *(const f32x4*)(scale + (size_t)b * bstride + col);
            const f32x4 y = (v[j] * rstd) * gg * (sc + 1.0f) + sh;
            o[64 * j] = (v2u){pk2(y[0], y[1]), pk2(y[2], y[3])};
        }
    }
}
__device__ __forceinline__ void phase_final_norm(Ctx& C, float* x, const float* g) {
    const int gw = C.bx * NWAVES + C.wave, NGW = C.G * NWAVES, lane = C.lane;
    for (int r = gw; r < NTOK; r += NGW) {
        f32x4* xr = (f32x4*)(x + (size_t)r * DM) + lane;
        f32x4 v[4]; float s = 0.f;
#pragma unroll
        for (int j = 0; j < 4; ++j) { v[j] = xr[64 * j]; s += (v[j][0] * v[j][0] + v[j][1] * v[j][1]) + (v[j][2] * v[j][2] + v[j][3] * v[j][3]); }
        const float rstd = 1.0f / sqrtf(wave_sum(s) * (1.0f / DM) + EPS);
#pragma unroll
        for (int j = 0; j < 4; ++j) { const f32x4 gg = *(const f32x4*)(g + 4 * (lane + 64 * j)); xr[64 * j] = (v[j] * rstd) * gg; }
    }
}

constexpr int HY_BSTR = 19264, HY_UL_BYTES = 4 * HY_BSTR, HY_RL_OFF = HY_UL_BYTES, HY_RL_BYTES = 2 * SEQ * 2;
static_assert(HY_RL_OFF + 2 * HY_RL_BYTES <= MISC_OFF && HY_UL_BYTES % 16 == 0, "hyena LDS");
__device__ __forceinline__ unsigned alignbit16(unsigned hi, unsigned lo) { return __builtin_amdgcn_alignbit(hi, lo, 16); }
__device__ __forceinline__ void hyena_make_filters(Ctx& C, int c) {
    LAS unsigned short* RL0 = (LAS unsigned short*)(C.lds + HY_RL_OFF);
    const bf16* H2T = WSP(bf16, WS_H2); const float* w3 = INP(20) + c;
    const int tid = C.tid;
    f32x4 acc[4][4];
#pragma unroll
    for (int i = 0; i < 4; ++i)
#pragma unroll
        for (int j = 0; j < 4; ++j) acc[i][j] = (f32x4){0.f, 0.f, 0.f, 0.f};
#pragma unroll 4
    for (int k = 0; k < 64; ++k) {
        const float w0 = w3[k * 2048], w1 = w3[k * 2048 + 512], w2 = w3[k * 2048 + 1024], w3v = w3[k * 2048 + 1536];
#pragma unroll
        for (int jj = 0; jj < 2; ++jj) {
            const v4u hv = *(const v4u*)(H2T + (size_t)k * SEQ + 8 * (tid + NTHR * jj));
            const f32x4 ha = (f32x4){bflo(hv.x), bfhi(hv.x), bflo(hv.y), bfhi(hv.y)}, hb = (f32x4){bflo(hv.z), bfhi(hv.z), bflo(hv.w), bfhi(hv.w)};
            acc[0][2 * jj] += ha * w0; acc[0][2 * jj + 1] += hb * w0; acc[1][2 * jj] += ha * w1; acc[1][2 * jj + 1] += hb * w1;
            acc[2][2 * jj] += ha * w2; acc[2][2 * jj + 1] += hb * w2; acc[3][2 * jj] += ha * w3v; acc[3][2 * jj + 1] += hb * w3v;
        }
    }
    const float dsc = (3.0701134573253945f + (float)c * ((15.350567286626973f - 3.0701134573253945f) / 511.0f)) * (1.4426950408889634f / 8191.0f);
#pragma unroll
    for (int j = 0; j < 4; ++j)
#pragma unroll
        for (int e = 0; e < 4; ++e) {
            const int t = 8 * (tid + NTHR * (j >> 1)) + 4 * (j & 1) + e; const float win = __builtin_amdgcn_exp2f(-(float)t * dsc) + 0.05f;
            RL0[SEQ - t] = (unsigned short)f2bf(acc[0][j][e] * win); RL0[2 * SEQ + SEQ - t] = (unsigned short)f2bf(acc[2][j][e] * win);
            if (t > 0) { RL0[SEQ + t] = (unsigned short)f2bf(acc[1][j][e] * win); RL0[2 * SEQ + SEQ + t] = (unsigned short)f2bf(acc[3][j][e] * win); }
        }
    if (tid == 0) { RL0[0] = 0; RL0[2 * SEQ] = 0; }
}
__device__ __forceinline__ void hyena_conv(Ctx& C, int o, f32x4 (&acc)[2][8]) {
    const int lane = C.lane, w = C.wave, m = lane & 15, q = lane >> 4;
    const LAS unsigned char* UL = C.lds; const LAS unsigned char* RL = C.lds + HY_RL_OFF + o * HY_RL_BYTES;
#pragma unroll
    for (int g = 0; g < 2; ++g)
#pragma unroll
        for (int a = 0; a < 8; ++a) acc[g][a] = (f32x4){0.f, 0.f, 0.f, 0.f};
    const int cl = m >> 2, bt = m & 3;
    const int dlo = 8 * w - 63;
    int roff = 2 * (SEQ - 128 * dlo - 8 * m + 8 * q), uoff = bt * HY_BSTR + (8 * w + cl + 3) * 272 + 16 * q - 272 * dlo;
    v4u lo = *(const LAS v4u*)(RL + roff - 16), hi = *(const LAS v4u*)(RL + roff);
    v4u b0 = *(const LAS v4u*)(UL + uoff), b1 = *(const LAS v4u*)(UL + uoff + 4 * 272);
#pragma unroll 1
    for (int it = 0; it < 284; ++it) {
        const int d = dlo + (it >> 2);
        const bool v0 = d <= 8 * w + 3, v1 = d >= 8 * w + 4 - 63;
        const bool wrap = (it & 3) == 3;
        const int roff_n = (it == 283) ? roff : roff + (wrap ? (-256 - 192) : 64), uoff_n = (it == 283) ? uoff : uoff + (wrap ? (-272 - 192) : 64);
        const v4u lo_n = *(const LAS v4u*)(RL + roff_n - 16), hi_n = *(const LAS v4u*)(RL + roff_n);
        const v4u b0_n = *(const LAS v4u*)(UL + uoff_n), b1_n = *(const LAS v4u*)(UL + uoff_n + 4 * 272);
        const unsigned wd[8] = {lo.x, lo.y, lo.z, lo.w, hi.x, hi.y, hi.z, hi.w};
        bf16x8 af[8];
#pragma unroll
        for (int p = 0; p < 4; ++p) {
            const v4u ev = (v4u){wd[4 - p], wd[5 - p], wd[6 - p], wd[7 - p]};
            const v4u od = (v4u){alignbit16(wd[4 - p], wd[3 - p]), alignbit16(wd[5 - p], wd[4 - p]), alignbit16(wd[6 - p], wd[5 - p]), alignbit16(wd[7 - p], wd[6 - p])};
            af[2 * p] = __builtin_bit_cast(bf16x8, ev); af[2 * p + 1] = __builtin_bit_cast(bf16x8, od);
        }
        if (v0) {
            const bf16x8 bfr = __builtin_bit_cast(bf16x8, b0);
#pragma unroll
            for (int a = 0; a < 8; ++a) acc[0][a] = __builtin_amdgcn_mfma_f32_16x16x32_bf16(af[a], bfr, acc[0][a], 0, 0, 0);
        }
        if (v1) {
            const bf16x8 bfr = __builtin_bit_cast(bf16x8, b1);
#pragma unroll
            for (int a = 0; a < 8; ++a) acc[1][a] = __builtin_amdgcn_mfma_f32_16x16x32_bf16(af[a], bfr, acc[1][a], 0, 0, 0);
        }
        lo = lo_n; hi = hi_n; b0 = b0_n; b1 = b1_n; roff = roff_n; uoff = uoff_n;
    }
}
__device__ __forceinline__ void hyena_item(Ctx& C, int c) {
    const int lane = C.lane, w = C.wave, tid = C.tid;
    LAS unsigned char* UL = C.lds;
    const bf16* HY = WSP(bf16, WS_HY);
    for (int i = tid; i < 4 * 6 * 17; i += NTHR) { const int bt = i / 102, r = i % 102, sl = r / 17, pc = r % 17; const int slot = sl < 3 ? sl : 64 + sl;
        *(LAS v4u*)(UL + bt * HY_BSTR + slot * 272 + pc * 16) = (v4u){0u, 0u, 0u, 0u}; }
#pragma unroll
    for (int i = 0; i < 8; ++i) { const int p = i * NTHR + tid, bt = p >> 10, r = p & 1023, ch = r >> 4, pc = r & 15;
        *(LAS v4u*)(UL + bt * HY_BSTR + (ch + 3) * 272 + pc * 16) = *(const v4u*)(HY + ((size_t)(bt * 1536 + c) * SEQ) + r * 8); }
    hyena_make_filters(C, c);
    __syncthreads();
    f32x4 acc[2][8];
    const int mcol = lane & 15, q = lane >> 4, cl = mcol >> 2, bt = mcol & 3;
#pragma unroll 1
    for (int o = 0; o < 2; ++o) {
        hyena_conv(C, o, acc);
        __syncthreads();
        const float dsk = INP(21)[o * 512 + c];
#pragma unroll
        for (int g = 0; g < 2; ++g) {
            const int chunk = 8 * w + 4 * g + cl, p0 = 128 * chunk + 32 * q;
            LAS unsigned char* zl = UL + bt * HY_BSTR + (chunk + 3) * 272 + 64 * q;
            const bf16* gate = HY + ((size_t)(bt * 1536 + (o + 1) * 512 + c) * SEQ) + p0;
            unsigned short outv[32];
#pragma unroll
            for (int k = 0; k < 4; ++k) {
                const v4u zz = *(LAS v4u*)(zl + 16 * k), gg = *(const v4u*)(gate + 8 * k);
                const unsigned zw[4] = {zz.x, zz.y, zz.z, zz.w}, gw[4] = {gg.x, gg.y, gg.z, gg.w};
#pragma unroll
                for (int e = 0; e < 8; ++e) {
                    const float zv = (e & 1) ? bfhi(zw[e >> 1]) : bflo(zw[e >> 1]), gv = (e & 1) ? bfhi(gw[e >> 1]) : bflo(gw[e >> 1]);
                    outv[8 * k + e] = (unsigned short)f2bf(gv * (acc[g][e][k] + dsk * zv));
                }
            }
#pragma unroll
            for (int k = 0; k < 4; ++k) {
                const v4u ov = (v4u){(unsigned)outv[8 * k] | ((unsigned)outv[8 * k + 1] << 16), (unsigned)outv[8 * k + 2] | ((unsigned)outv[8 * k + 3] << 16),
                                     (unsigned)outv[8 * k + 4] | ((unsigned)outv[8 * k + 5] << 16), (unsigned)outv[8 * k + 6] | ((unsigned)outv[8 * k + 7] << 16)};
                if (o == 0) *(LAS v4u*)(zl + 16 * k) = ov;
                else *(v4u*)(WSP(bf16, WS_YAT) + ((size_t)(bt * 512 + c) * SEQ) + p0 + 8 * k) = ov;
            }
        }
        __syncthreads();
    }
}

__device__ __forceinline__ void phase_hyena(Ctx& C) {
#pragma unroll 1
    for (int c = C.bx; c < DHY; c += C.G) hyena_item(C, c);
}
__device__ __forceinline__ void phase_attn(Ctx& C) {
    const int v = (C.G % 8 == 0) ? (C.bx % 8) * (C.G / 8) + C.bx / 8 : C.bx;
#pragma unroll 1
    for (int u = v; u < 2048; u += C.G) {
        const int combo = u >> 5, qb = u & 31;
        const int b = combo >> 4, hm = (combo >> 1) & 7, vh = combo & 1, h = hm >> 1, mm = hm & 1;
        const attn_body::bf16* Qp = (const attn_body::bf16*)(WSP(bf16, WS_Q) + ((size_t)(b * SEQ + qb * 256) * 512 + hm * 64));
        const attn_body::bf16* Kp = (const attn_body::bf16*)(WSP(bf16, WS_K) + ((size_t)b * NKV * 512 + hm * 64));
        const attn_body::bf16* Vp = (const attn_body::bf16*)(WSP(bf16, WS_V) + ((size_t)b * NKV * 512 + h * 128 + vh * 64));
        attn_body::bf16* Op = (attn_body::bf16*)(WSP(bf16, WS_O) + ((size_t)(b * SEQ + qb * 256) * 1024 + mm * 512 + h * 128 + vh * 64));
        attn_body::attn_unit<8>(Qp, Kp, Vp, Op, (char*)C.ldsg);
    }
    __syncthreads();
}

__device__ __forceinline__ void phase_combine(Ctx& C, bf16* MIX) {
    const int gw = C.bx * NWAVES + C.wave, NGW = C.G * NWAVES, lane = C.lane;
    const float lam_init = 0.2f;
    const float* dl = INP(22);
    const float lam = __expf(wave_sum(dl[lane] * dl[64 + lane])) - __expf(wave_sum(dl[128 + lane] * dl[192 + lane])) + lam_init;
    const bf16* O = WSP(bf16, WS_O);
    const float* sg = INP(23) + (lane & 15) * 8;
    const f32x4 g0 = *(const f32x4*)sg, g1 = *(const f32x4*)(sg + 4);
    for (int r = gw; r < NTOK; r += NGW) {
        const v4u a = *(const v4u*)(O + (size_t)r * 1024 + 8 * lane), b = *(const v4u*)(O + (size_t)r * 1024 + 512 + 8 * lane);
        const unsigned aw[4] = {a.x, a.y, a.z, a.w}, bw[4] = {b.x, b.y, b.z, b.w};
        float o[8]; float ss = 0.f;
#pragma unroll
        for (int e = 0; e < 4; ++e) { o[2 * e] = bflo(aw[e]) - lam * bflo(bw[e]); o[2 * e + 1] = bfhi(aw[e]) - lam * bfhi(bw[e]); ss += o[2 * e] * o[2 * e] + o[2 * e + 1] * o[2 * e + 1]; }
        ss += __shfl_xor(ss, 1); ss += __shfl_xor(ss, 2); ss += __shfl_xor(ss, 4); ss += __shfl_xor(ss, 8);
        const float rs = (1.0f / sqrtf(ss * (1.0f / 128.0f) + EPS)) * (1.0f - lam_init);
        *(v4u*)(MIX + (size_t)r * DM + 512 + 8 * lane) = (v4u){pk2(o[0] * rs * g0[0], o[1] * rs * g0[1]), pk2(o[2] * rs * g0[2], o[3] * rs * g0[3]), pk2(o[4] * rs * g1[0], o[5] * rs * g1[1]), pk2(o[6] * rs * g1[2], o[7] * rs * g1[3])};
    }
    LAS unsigned* tl = (LAS unsigned*)(C.lds + C.wave * 16384);
    const bf16* YAT = WSP(bf16, WS_YAT);
    for (int it = gw; it < 4 * 128 * 8; it += NGW) {
        const int b = it >> 10, tt = (it >> 3) & 127, ct = it & 7;
#pragma unroll
        for (int r = 0; r < 8; ++r) { const int c = r * 8 + (lane >> 3), tc = lane & 7;
            const v4u v = *(const v4u*)(YAT + ((size_t)(b * 512 + ct * 64 + c) * SEQ) + tt * 64 + tc * 8);
            tl[c * 33 + tc * 4 + 0] = v.x; tl[c * 33 + tc * 4 + 1] = v.y; tl[c * 33 + tc * 4 + 2] = v.z; tl[c * 33 + tc * 4 + 3] = v.w; }
        LDS_WAIT(); asm volatile("" ::: "memory");
#pragma unroll
        for (int r = 0; r < 8; ++r) { const int t = r * 8 + (lane >> 3), cc = lane & 7;
            unsigned short e[8];
#pragma unroll
            for (int k = 0; k < 8; ++k) { const unsigned wv = tl[(cc * 8 + k) * 33 + (t >> 1)]; e[k] = (unsigned short)((t & 1) ? (wv >> 16) : (wv & 0xffffu)); }
            *(v4u*)(MIX + (size_t)(b * SEQ + tt * 64 + t) * DM + ct * 64 + cc * 8) = (v4u){(unsigned)e[0] | ((unsigned)e[1] << 16), (unsigned)e[2] | ((unsigned)e[3] << 16), (unsigned)e[4] | ((unsigned)e[5] << 16), (unsigned)e[6] | ((unsigned)e[7] << 16)}; }
        LDS_WAIT(); asm volatile("" ::: "memory");
    }
}

__device__ __forceinline__ void phase_sgu_spatial(Ctx& C, bf16* GATED) {
    const int lane = C.lane, w = C.wave, tid = C.tid;
    LAS unsigned short* vt = (LAS unsigned short*)C.lds;
    const bf16* SU = WSP(bf16, WS_SU); const bf16* SV = WSP(bf16, WS_SV); const float* stat = WSP(float, WS_STAT); const bf16* WSb = WSP(bf16, WS_WS);
    const float* lng = INP(27); const float* lnb = INP(28); const float* bs = INP(30);
    for (int it = C.bx; it < 4 * 64 * 8; it += C.G) {
        const int g = it & 7, n = (it >> 3) & 63, b = it >> 9, tok0 = b * SEQ + n * 128;
        __syncthreads();
#pragma unroll
        for (int i = 0; i < 4; ++i) {
            const int p = i * NTHR + tid, s = p & 127, cp = p >> 7;
            const v4u v = *(const v4u*)(SV + (size_t)(tok0 + s) * DM + g * 128 + cp * 8);
            const float sm = stat[2 * (tok0 + s)], sq = stat[2 * (tok0 + s) + 1];
            const float mean = sm * (1.0f / 1024.0f), var = sq * (1.0f / 1024.0f) - mean * mean, rstd = 1.0f / sqrtf(var + EPS);
            const unsigned vw[4] = {v.x, v.y, v.z, v.w};
            const f32x4 ga = *(const f32x4*)(lng + g * 128 + cp * 8), gb = *(const f32x4*)(lng + g * 128 + cp * 8 + 4), ba = *(const f32x4*)(lnb + g * 128 + cp * 8), bb = *(const f32x4*)(lnb + g * 128 + cp * 8 + 4);
            const float gg[8] = {ga[0], ga[1], ga[2], ga[3], gb[0], gb[1], gb[2], gb[3]}, bq[8] = {ba[0], ba[1], ba[2], ba[3], bb[0], bb[1], bb[2], bb[3]};
#pragma unroll
            for (int e = 0; e < 8; ++e) { const float x = (e & 1) ? bfhi(vw[e >> 1]) : bflo(vw[e >> 1]); vt[(cp * 8 + e) * 136 + s] = (unsigned short)f2bf((x - mean) * rstd * gg[e] + bq[e]); }
        }
        __syncthreads();
        f32x4 acc[8];
#pragma unroll
        for (int cb = 0; cb < 8; ++cb) acc[cb] = (f32x4){0.f, 0.f, 0.f, 0.f};
        const int fr = lane & 15, fq = lane >> 4;
#pragma unroll
        for (int kb = 0; kb < 4; ++kb) {
            const bf16x8 a = *(const bf16x8*)(WSb + ((size_t)(g * 128 + 16 * w + fr) * 128) + 32 * kb + 8 * fq);
#pragma unroll
            for (int cb = 0; cb < 8; ++cb) { const bf16x8 bfr = *(const LAS bf16x8*)(vt + (16 * cb + fr) * 136 + 32 * kb + 8 * fq); acc[cb] = __builtin_amdgcn_mfma_f32_16x16x32_bf16(a, bfr, acc[cb], 0, 0, 0); }
        }
#pragma unroll
        for (int reg = 0; reg < 4; ++reg) {
            const int t = 16 * w + 4 * fq + reg; const float bias = bs[g * 128 + t];
#pragma unroll
            for (int cb = 0; cb < 8; ++cb) { const size_t off = (size_t)(tok0 + t) * DM + g * 128 + 16 * cb + fr; GATED[off] = (bf16)f2bf(bf2f(SU[off]) * (acc[cb][reg] + bias)); }
        }
    }
    __syncthreads();
}

#ifndef DUP_HY
#define DUP_HY 1
#endif
#ifndef DUP_AT
#define DUP_AT 1
#endif
#ifndef DUP_UP
#define DUP_UP 1
#endif
struct Args { const float* in[33]; float* out; unsigned char* ws; int ph_lo, ph_hi; };
constexpr int N_PHASES = 17;
__global__ void __launch_bounds__(NTHR, 2) fwd_megakernel(Args args) {
    extern __shared__ __attribute__((aligned(16))) unsigned char lds_raw[];
    cg::grid_group grid = cg::this_grid();
    Ctx C;
    C.lds = (LAS unsigned char*)lds_raw; C.ldsg = lds_raw; C.tid = threadIdx.x; C.lane = C.tid & 63; C.wave = __builtin_amdgcn_readfirstlane(C.tid >> 6); C.G = gridDim.x; C.bx = blockIdx.x;
    C.kin = (ktab)__builtin_amdgcn_kernarg_segment_ptr();
    C.out = args.out; C.ws = args.ws;
    const int lo = args.ph_lo, hi = args.ph_hi;
    { volatile LAS unsigned* mz = (volatile LAS unsigned*)(C.lds + MISC_OFF); if (C.tid < 64) mz[C.tid] = 0u; }
    __syncthreads();
    if (C.bx == 0) for (int i = C.tid; i < XCD_BAR_WORDS; i += NTHR) ((unsigned*)(C.ws + WS_CTL) + 4096)[i] = 0u;
    XcdBarrier bar; bar.bar = (unsigned*)(C.ws + WS_CTL) + 4096; bar.x = 0; bar.st = (volatile LAS unsigned*)(C.lds + MISC_OFF) + 8;
#ifndef PHMASK
#define PHMASK 0x1ffff
#endif
#define IN(k) ((((PHMASK) >> (k)) & 1) && lo <= (k) && (k) < hi)
#define SEAM(k) do { if (IN(k) && IN((k) + 1)) xcd_barrier(bar); } while (0)
    bf16* ACT = WSP(bf16, WS_ACT);
    const float* MOD = WSP(float, WS_MOD);

    if (IN(0)) phase_p0(C);
    grid.sync();
    bar = xcd_barrier_post((unsigned*)(C.ws + WS_CTL) + 4096, (volatile LAS unsigned*)(C.lds + MISC_OFF) + 8);
    if (IN(1)) {
        phase_norm_mod(C, INP(0), NTOK, SEQ, INP(6), MOD, MOD + 1024, 6144, ACT + DM);
        phase_norm_mod(C, INP(2), NCTX, NCTX, INP(6), WSP(float, WS_CMOD), WSP(float, WS_CMOD) + 1024, 0, WSP(bf16, WS_HC));
    }
    SEAM(1);
    if (IN(2)) {
#ifndef NO_G1
        { pg8::Gemm g{ACT, WSP(bf16, WS_WIN), SLAB_TILES * 256, NIN, 1024, 1}; pg8::StaticOrder S; S.init(SLAB_TILES * 256, NIN, C.G, C.bx);
          epi::EpiInProj E{WSP(bf16, WS_HY), WSP(bf16, WS_Q), WSP(bf16, WS_K), WSP(bf16, WS_V), INP(13), INP(14), WSP(float, WS_ROPE)};
          pg8::gemm_phase<epi::EpiInProj, pg8::StaticOrder, true, true>(C.lds, g, S, E); }
#endif
#ifndef NO_G2
        { pg8::Gemm g{WSP(bf16, WS_HC), WSP(bf16, WS_WIN) + (size_t)2048 * 1024, NCTX, 1024, 1024, 0}; pg8::StaticOrder S; S.init(NCTX, 1024, C.G, (C.bx + C.G - 64) % C.G);
          epi::EpiCtxKV E{WSP(bf16, WS_K), WSP(bf16, WS_V)};
          pg8::gemm_phase<epi::EpiCtxKV, pg8::StaticOrder, true, true>(C.lds, g, S, E); }
#endif
    }
    SEAM(2);
    if (IN(3)) {
#pragma unroll 1
        for (int r_ = 0; r_ < DUP_HY; ++r_) phase_hyena(C);
#pragma unroll 1
        for (int r_ = 0; r_ < DUP_AT; ++r_) phase_attn(C);
    }
    SEAM(3);
    if (IN(4)) phase_combine(C, ACT + DM);
    SEAM(4);
    if (IN(5)) {
        pg8::Gemm g{ACT + DM, WSP(bf16, WS_WOUT), NTOK, 1024, 1024, 0}; pg8::StaticOrder S; S.init(NTOK, 1024, C.G, C.bx);
        epi::EpiResid E{INP(0), C.out, MOD + 2048};
        pg8::gemm_phase<epi::EpiResid, pg8::StaticOrder, true, true>(C.lds, g, S, E);
    }
    SEAM(5);
    const float* MOD1 = MOD + (size_t)4 * 6144;
#define FFN_BLOCK(l, pb, MODL) \
    if (IN(pb)) phase_norm_mod(C, C.out, NTOK, SEQ, INP(7) + (l) * 1024, (MODL) + 3072, (MODL) + 4096, 6144, ACT + DM); \
    SEAM(pb); \
    if (IN((pb) + 1)) { \
        pg8::Gemm g{ACT, WSP(bf16, (l) ? WS_WUP1 : WS_WUP0), SLAB_TILES * 256, NUP, 1024, 1}; pg8::StaticOrder S; S.init(SLAB_TILES * 256, NUP, C.G, C.bx); \
        epi::EpiFfnUp E{WSP(bf16, WS_HID), INP(9) + (size_t)(l) * 3 * NUP, INP(10) + (size_t)(l) * NUP}; \
        _Pragma("unroll 1") for (int r_ = 0; r_ < ((l) == 0 ? DUP_UP : 1); ++r_) pg8::gemm_phase<epi::EpiFfnUp, pg8::StaticOrder, true, true>(C.lds, g, S, E); \
    } \
    SEAM((pb) + 1); \
    if (IN((pb) + 2)) { \
        pg8::Gemm g{WSP(bf16, WS_HID), WSP(bf16, (l) ? WS_WDN1 : WS_WDN0), NTOK, 1024, DFF, 0}; pg8::StaticOrder S; S.init(NTOK, 1024, C.G, C.bx); \
        epi::EpiResid E{C.out, C.out, (MODL) + 5120}; \
        pg8::gemm_phase<epi::EpiResid, pg8::StaticOrder, true, true>(C.lds, g, S, E); \
    } \
    SEAM((pb) + 2);
    FFN_BLOCK(0, 6, MOD)
    if (IN(9)) phase_norm_mod(C, C.out, NTOK, SEQ, INP(6) + 1024, MOD1, MOD1 + 1024, 6144, ACT + DM);
    SEAM(9);
    if (IN(10)) {
        pg8::Gemm g{ACT + DM, WSP(bf16, WS_WSIN), NTOK, 2048, 1024, 0}; pg8::StaticOrder S; S.init(NTOK, 2048, C.G, C.bx);
        epi::EpiSguIn E{WSP(bf16, WS_SU), WSP(bf16, WS_SV), INP(26), WSP(float, WS_STAT)};
        pg8::gemm_phase<epi::EpiSguIn, pg8::StaticOrder, true, true>(C.lds, g, S, E);
    }
    SEAM(10);
    if (IN(11)) phase_sgu_spatial(C, ACT + DM);
    SEAM(11);
    if (IN(12)) {
        pg8::Gemm g{ACT + DM, WSP(bf16, WS_WSOUT), NTOK, 1024, 1024, 0}; pg8::StaticOrder S; S.init(NTOK, 1024, C.G, C.bx);
        epi::EpiResid E{C.out, C.out, MOD1 + 2048};
        pg8::gemm_phase<epi::EpiResid, pg8::StaticOrder, true, true>(C.lds, g, S, E);
    }
    SEAM(12);
    FFN_BLOCK(1, 13, MOD1)
#undef FFN_BLOCK
    if (IN(16)) phase_final_norm(C, C.out, INP(32));
#undef IN
#undef SEAM
}

extern "C" void kernel_launch(void* const* d_in, const int* in_sizes, int n_in, void* d_out, int out_size, void* d_ws, size_t ws_size, hipStream_t stream) {
    static int grid = 0;
    if (grid == 0) {
        if (n_in != 33 || out_size != NTOK * DM || ws_size < WS_END) { fprintf(stderr, "kernel_launch: unexpected shapes (n_in %d out %d ws %zu)\n", n_in, out_size, ws_size); grid = -1; return; }
        int dev = 0, cus = 0, per_cu = 0;
        hipGetDevice(&dev); hipDeviceGetAttribute(&cus, hipDeviceAttributeMultiprocessorCount, dev);
        hipFuncSetAttribute((const void*)fwd_megakernel, hipFuncAttributeMaxDynamicSharedMemorySize, LDS_BYTES);
        if (hipOccupancyMaxActiveBlocksPerMultiprocessor(&per_cu, (const void*)fwd_megakernel, NTHR, LDS_BYTES) != hipSuccess || per_cu < 1) per_cu = 1;
        (void)hipGetLastError();
        grid = cus * per_cu;
    }
    if (grid < 0) return;
    Args a{};
    for (int i = 0; i < 33; ++i) a.in[i] = (const float*)d_in[i];
    a.out = (float*)d_out; a.ws = (unsigned char*)d_ws;
#ifndef N_LAUNCH_SPLIT
    a.ph_lo = 0; a.ph_hi = N_PHASES;
    void* params[] = {&a};
    hipError_t e = hipLaunchCooperativeKernel((const void*)fwd_megakernel, dim3(grid), dim3(NTHR), params, LDS_BYTES, stream);
    if (e != hipSuccess) fprintf(stderr, "cooperative launch failed: %s (grid %d)\n", hipGetErrorString(e), grid);
#else
    for (int p = 0; p < N_PHASES; ++p) { a.ph_lo = p; a.ph_hi = p + 1; hipLaunchKernelGGL(fwd_megakernel, dim3(grid), dim3(NTHR), LDS_BYTES, stream, a); }
#endif
}
```

```cpp
#include <hip/hip_runtime.h>
#include <hip/hip_cooperative_groups.h>
#include <hip/hip_bf16.h>
#include <cstdio>
#include <cstdint>
#include <cmath>
namespace cg = cooperative_groups;
__device__ __forceinline__ int lane_fresh() { int l; asm volatile("v_mbcnt_lo_u32_b32 %0, -1, 0\n\tv_mbcnt_hi_u32_b32 %0, -1, %0" : "=v"(l)); return l; }
namespace pg8 {
#define PG8_LAS __attribute__((address_space(3)))
typedef unsigned short bf16_t;
typedef short bf16x8 __attribute__((ext_vector_type(8)));
typedef float f32x4 __attribute__((ext_vector_type(4)));
typedef unsigned u32x4 __attribute__((ext_vector_type(4)));
constexpr int BM = 256, BK = 64, HALF = 128, HTB = HALF * BK * 2  , STAGE_BYTES = 8 * HTB, NXCD = 8, WGM = 8;

__host__ __device__ __forceinline__ int lds_byte(int r, int c) { const int st = (r >> 4) * 2 + (c >> 5), rr = r & 15, cc = c & 31, ob = rr * 64 + cc * 2; return st * 1024 + (ob ^ (((ob >> 9) & 1) << 5)); }
__host__ __device__ __forceinline__ void stage_rc(int b, int& R, int& C) { const int st = b / 1024, sb = b % 1024, swz = sb ^ (((sb >> 9) & 1) << 5); R = (st >> 1) * 16 + swz / 64; C = (st & 1) * 32 + (swz % 64) / 2; }
__host__ __device__ __forceinline__ int perm32(int rho) { const int n = rho >> 4, i = rho & 15; return 8 * (i >> 2) + 4 * n + (i & 3); }

struct Unit { int pm, pn; };
struct Gemm { const bf16_t* A; const bf16_t* Bt; int M, N, K; int slab; };

struct StaticOrder {
    int nM, nN, nwg, G, c;
    __host__ __device__ void init(int M, int N, int G_, int c_) { nM = M / BM; nN = N / BM; nwg = nM * nN; G = G_; c = c_; }
    __host__ __device__ bool next(int i, Unit& u) const {
        const long L = (long)i * G + c; if (L >= nwg) return false;
        int wgid = (int)L; { const int q = nwg / NXCD, r = nwg % NXCD, xcd = wgid % NXCD, off = wgid / NXCD; wgid = (xcd < r ? xcd * (q + 1) : r * (q + 1) + (xcd - r) * q) + off; }
        const int nig = WGM * nN, gid = wgid / nig, fm = gid * WGM, gsz = (nM - fm) < WGM ? (nM - fm) : WGM;
        u.pm = fm + ((wgid % nig) % gsz); u.pn = (wgid % nig) / gsz; return true;
    }
    __device__ __forceinline__ void a_ready(const Unit&) const {}
    __device__ __forceinline__ void done(const Unit&) const {}
};

__device__ __forceinline__ unsigned cvt_pk_bf16(float lo, float hi) { unsigned r; asm volatile("v_cvt_pk_bf16_f32 %0, %1, %2" : "=v"(r) : "v"(lo), "v"(hi)); return r; }
typedef float f32x2 __attribute__((ext_vector_type(2)));
__device__ __forceinline__ f32x2 gelu_pk(f32x2 v) {
    const f32x2 av = __builtin_elementwise_abs(v), d = av * 0.2316418882f + 1.0f;
    f32x2 t; t.x = __builtin_amdgcn_rcpf(d.x); t.y = __builtin_amdgcn_rcpf(d.y);
    f32x2 q = t * 0.5307027145f + (-0.7265760135f); q = q * t + 0.7107068705f; q = q * t + (-0.142248368f); q = q * t + 0.127414796f; q = q * t;
    const f32x2 s = (v * v) * (-0.72134752044f);
    f32x2 e; e.x = __builtin_amdgcn_exp2f(s.x); e.y = __builtin_amdgcn_exp2f(s.y);
    const f32x2 m = v * (q * e), r = v - m;
    f32x2 o; o.x = v.x < 0.f ? m.x : r.x; o.y = v.y < 0.f ? m.y : r.y; return o;
}

template <class Epi, class Sched, bool ALIGN_EPI = false, bool SP2 = false>
__device__ __forceinline__ void gemm_phase(PG8_LAS unsigned char* lds, const Gemm g, const Sched& S, const Epi& E, int wave_in) {
    int tid_ = wave_in * 64 + lane_fresh();
    const int tid = tid_, wid = __builtin_amdgcn_readfirstlane(tid >> 6), lane = tid & 63, wr = wid >> 2, wc = wid & 3, fr = lane & 15, fq = lane >> 4;
    const int K = g.K, nt = K / BK;
    unsigned voffA[2], voffB[2];
#pragma unroll
    for (int i = 0; i < 2; ++i) { int R, C; stage_rc(tid * 16 + i * 8192, R, C); const int Rb = Epi::PERM ? ((R & ~31) + perm32(R & 31)) : R;
        const int Ra = g.slab ? ((R >> 6) * 62 + (R & 63)) : R; voffA[i] = (unsigned)(Ra * K + C) * 2u; voffB[i] = (unsigned)(Rb * K + C) * 2u; }
    const size_t kstep = (size_t)(BK * 2);
    const size_t hstep = (size_t)HALF * K * 2;
    const size_t tstep = 2 * hstep;
    const size_t hstepA = g.slab ? (size_t)124 * K * 2 : hstep, tstepA = g.slab ? (size_t)248 * K * 2 : tstep;
    const unsigned ldsw = (unsigned)wid * 1024u;
    const int aoff = lds_byte(wr * 64 + fr, fq * 8), boff = lds_byte(wc * 32 + fr, fq * 8);
#define PG8_SA(b, h) (((b) * 2 + (h)) * HTB)
#define PG8_SB(b, h) ((4 + (b) * 2 + (h)) * HTB)
#define PG8_STAGE(bufoff, gbase, voff) do { _Pragma("unroll") for (int _i = 0; _i < 2; ++_i) \
        __builtin_amdgcn_global_load_lds((const unsigned*)((const char*)(gbase) + (voff)[_i]), (PG8_LAS unsigned*)(lds + (bufoff) + ldsw + _i * 8192), 16, 0, 0); } while (0)
#define PG8_LDA(dst, b, h) do { _Pragma("unroll") for (int m = 0; m < 4; ++m) _Pragma("unroll") for (int k = 0; k < 2; ++k) dst[m][k] = *(const PG8_LAS bf16x8*)(lds + PG8_SA(b, h) + aoff + m * 2048 + k * 1024); } while (0)
#define PG8_LDB(dst, b, h) do { _Pragma("unroll") for (int n = 0; n < 2; ++n) _Pragma("unroll") for (int k = 0; k < 2; ++k) dst[n][k] = *(const PG8_LAS bf16x8*)(lds + PG8_SB(b, h) + boff + n * 2048 + k * 1024); } while (0)
#define PG8_MMA(ai, bj, At, Bt) do { __builtin_amdgcn_s_setprio(1); _Pragma("unroll") for (int m = 0; m < 4; ++m) _Pragma("unroll") for (int n = 0; n < 2; ++n) _Pragma("unroll") for (int k = 0; k < 2; ++k) \
        acc[ai][bj][m][n] = __builtin_amdgcn_mfma_f32_16x16x32_bf16(Bt[n][k], At[m][k], acc[ai][bj][m][n], 0, 0, 0); __builtin_amdgcn_s_setprio(0); } while (0)
#define PG8_WAIT_V(n) asm volatile("s_waitcnt vmcnt(" #n ")" ::: "memory")
#define PG8_WAIT_L(n) asm volatile("s_waitcnt lgkmcnt(" #n ")" ::: "memory")
#define PG8_BAR __builtin_amdgcn_s_barrier()
#define PG8_SCHED __builtin_amdgcn_sched_barrier(0)
    Unit cur, nxt; int ui = 0;
    if (!S.next(0, cur)) return;
    f32x4 acc[2][2][4][2];
#pragma unroll
    for (int a = 0; a < 2; ++a)
#pragma unroll
        for (int b = 0; b < 2; ++b)
#pragma unroll
            for (int m = 0; m < 4; ++m)
#pragma unroll
                for (int n = 0; n < 2; ++n) acc[a][b][m][n] = (f32x4){0.f, 0.f, 0.f, 0.f};
    bf16x8 At[4][2], B0[2][2], B1[2][2];
    const char* cA = (const char*)g.A + (size_t)cur.pm * tstepA; const char* cB = (const char*)g.Bt + (size_t)cur.pn * tstep;
    S.a_ready(cur);
    if constexpr (SP2) {
        PG8_STAGE(PG8_SB(0, 0), cB, voffB); PG8_STAGE(PG8_SB(0, 1), cB + hstep, voffB); PG8_STAGE(PG8_SA(0, 0), cA, voffA); PG8_STAGE(PG8_SA(0, 1), cA + hstepA, voffA);
        if (wr == 1) PG8_BAR;
        PG8_WAIT_V(2); PG8_BAR;
        PG8_STAGE(PG8_SB(1, 0), cB + kstep, voffB); PG8_STAGE(PG8_SA(1, 0), cA + kstep, voffA); PG8_STAGE(PG8_SB(1, 1), cB + hstep + kstep, voffB);
        PG8_WAIT_V(6); PG8_BAR;
    } else {
        PG8_STAGE(PG8_SB(0, 0), cB, voffB); PG8_STAGE(PG8_SA(0, 0), cA, voffA); PG8_STAGE(PG8_SB(0, 1), cB + hstep, voffB); PG8_STAGE(PG8_SA(0, 1), cA + hstepA, voffA);
        if (wr == 1) PG8_BAR;
        PG8_WAIT_V(4); PG8_BAR;
        PG8_STAGE(PG8_SB(1, 0), cB + kstep, voffB); PG8_STAGE(PG8_SA(1, 0), cA + kstep, voffA); PG8_STAGE(PG8_SB(1, 1), cB + hstep + kstep, voffB);
        PG8_WAIT_V(6); PG8_BAR;
    }
    for (;;) {
        const bool has_next = S.next(ui + 1, nxt);
        const char* nA = has_next ? (const char*)g.A + (size_t)nxt.pm * tstepA : cA; const char* nB = has_next ? (const char*)g.Bt + (size_t)nxt.pn * tstep : cB;
        for (int t = 0; t < nt; t += 2) {
            const bool last = (t == nt - 2);
            const char* a1 = cA + (size_t)(t + 1) * kstep;
            const char* a2 = last ? nA : cA + (size_t)(t + 2) * kstep; const char* b2 = last ? nB : cB + (size_t)(t + 2) * kstep;
            const char* a3 = a2 + kstep; const char* b3 = b2 + kstep;
            if (last && has_next) S.a_ready(nxt);
            if constexpr (SP2) {
            PG8_LDB(B0, 0, 0); PG8_LDB(B1, 0, 1); PG8_SCHED; PG8_LDA(At, 0, 0); PG8_STAGE(PG8_SA(1, 1), a1 + hstepA, voffA);
            PG8_WAIT_V(8); PG8_WAIT_L(0); PG8_BAR; PG8_MMA(0, 0, At, B0); PG8_MMA(0, 1, At, B1); PG8_BAR; PG8_SCHED;
            PG8_LDA(At, 0, 1); PG8_STAGE(PG8_SB(0, 0), b2, voffB); PG8_STAGE(PG8_SB(0, 1), b2 + hstep, voffB); PG8_STAGE(PG8_SA(0, 0), a2, voffA);
            PG8_WAIT_V(8); PG8_WAIT_L(0); PG8_BAR; PG8_MMA(1, 0, At, B0); PG8_MMA(1, 1, At, B1); PG8_BAR; PG8_SCHED;
            PG8_LDB(B0, 1, 0); PG8_LDB(B1, 1, 1); PG8_SCHED; PG8_LDA(At, 1, 0); PG8_STAGE(PG8_SA(0, 1), a2 + hstepA, voffA);
            PG8_WAIT_V(8); PG8_WAIT_L(0); PG8_BAR; PG8_MMA(0, 0, At, B0); PG8_MMA(0, 1, At, B1); PG8_BAR; PG8_SCHED;
            PG8_LDA(At, 1, 1); PG8_STAGE(PG8_SB(1, 0), b3, voffB); PG8_STAGE(PG8_SB(1, 1), b3 + hstep, voffB); PG8_STAGE(PG8_SA(1, 0), a3, voffA);
            PG8_WAIT_V(8); PG8_WAIT_L(0); PG8_BAR; PG8_MMA(1, 0, At, B0); PG8_MMA(1, 1, At, B1); PG8_BAR; PG8_SCHED;
            } else {
            PG8_LDB(B0, 0, 0); PG8_SCHED; PG8_LDA(At, 0, 0); PG8_STAGE(PG8_SA(1, 1), a1 + hstepA, voffA);
            PG8_WAIT_L(8); PG8_BAR; PG8_WAIT_L(0); PG8_MMA(0, 0, At, B0); PG8_BAR; PG8_SCHED;
            PG8_LDB(B1, 0, 1); PG8_STAGE(PG8_SB(0, 0), b2, voffB);
            PG8_BAR; PG8_WAIT_L(0); PG8_MMA(0, 1, At, B1); PG8_BAR;
            PG8_LDA(At, 0, 1); PG8_STAGE(PG8_SA(0, 0), a2, voffA);
            PG8_BAR; PG8_WAIT_L(0); PG8_MMA(1, 0, At, B0); PG8_BAR; PG8_SCHED;
            PG8_STAGE(PG8_SB(0, 1), b2 + hstep, voffB);
            PG8_WAIT_V(6); PG8_BAR; PG8_MMA(1, 1, At, B1); PG8_BAR;
            PG8_LDB(B0, 1, 0); PG8_SCHED; PG8_LDA(At, 1, 0); PG8_STAGE(PG8_SA(0, 1), a2 + hstepA, voffA);
            PG8_WAIT_L(8); PG8_BAR; PG8_WAIT_L(0); PG8_MMA(0, 0, At, B0); PG8_BAR; PG8_SCHED;
            PG8_LDB(B1, 1, 1); PG8_STAGE(PG8_SB(1, 0), b3, voffB);
            PG8_BAR; PG8_WAIT_L(0); PG8_MMA(0, 1, At, B1); PG8_BAR;
            PG8_LDA(At, 1, 1); PG8_STAGE(PG8_SA(1, 0), a3, voffA);
            PG8_BAR; PG8_WAIT_L(0); PG8_MMA(1, 0, At, B0); PG8_BAR; PG8_SCHED;
            PG8_STAGE(PG8_SB(1, 1), b3 + hstep, voffB);
            PG8_WAIT_V(6); PG8_BAR; PG8_MMA(1, 1, At, B1); PG8_BAR;
            }
        }
        if constexpr (ALIGN_EPI) { if (wr == 0) PG8_BAR; }
        if constexpr (!Epi::AFTER_DRAIN) { E(acc, cur, wr, wc, fr, fq); S.done(cur); }
        if (!has_next) break;
#pragma unroll
        for (int a = 0; a < 2; ++a)
#pragma unroll
            for (int b = 0; b < 2; ++b)
#pragma unroll
                for (int m = 0; m < 4; ++m)
#pragma unroll
                    for (int n = 0; n < 2; ++n) acc[a][b][m][n] = (f32x4){0.f, 0.f, 0.f, 0.f};
        cur = nxt; cA = nA; cB = nB; ++ui;
        if constexpr (ALIGN_EPI) { if (wr == 1) PG8_BAR; }
    }
    PG8_WAIT_V(0);
    if constexpr (!ALIGN_EPI) { if (wr == 0) PG8_BAR; }
    PG8_BAR;
    if constexpr (Epi::AFTER_DRAIN) { E.fused(acc, cur, wr, wc, fr, fq, lds, wid, lane); S.done(cur); }
#undef PG8_SA
#undef PG8_SB
#undef PG8_STAGE
#undef PG8_LDA
#undef PG8_LDB
#undef PG8_MMA
#undef PG8_WAIT_V
#undef PG8_WAIT_L
#undef PG8_BAR
#undef PG8_SCHED
}
}

namespace attn_body {
using bf16=__hip_bfloat16;
using bf16x8=__attribute__((ext_vector_type(8)))short;
using s16x4=__attribute__((ext_vector_type(4)))short;
using f32x16=__attribute__((ext_vector_type(16)))float;
using u32x4=__attribute__((ext_vector_type(4)))unsigned;
constexpr int D=64,QP=512,KP=512,VP=512,OP=1024,NT_ALL=132;
constexpr int NW=8,QBLK=32,QB=QBLK*NW,KVBLK=64;
__device__ __forceinline__ int crow(int r,int hi){return (r&3)+8*(r>>2)+4*hi;}
#define SBAR() __builtin_amdgcn_sched_barrier(0)
__device__ __forceinline__ void cmask(f32x16&p0,f32x16&p1,int jb,int qrel,int hi){
  const float NEG=-INFINITY; int kb=64*jb+4*hi;
  #pragma unroll
  for(int r=0;r<16;++r){int kv=kb+(r&3)+8*(r>>2); if(kv>qrel)p0[r]=NEG; if(kv+32>qrel)p1[r]=NEG;}
}

constexpr int NSLOT=3, SLOTB=8192;
constexpr int LDS_K=0, LDS_V=NSLOT*SLOTB, LDS_WS=2*NSLOT*SLOTB, LDS_OST=LDS_WS+NW*64*4, LDS_BYTES=LDS_OST+NW*4096;
constexpr float C2=0.125f*1.4426950408889634f;
__device__ __forceinline__ void glds16(const void*gsrc,unsigned lds_dst){unsigned keep;
  asm volatile("s_mov_b32 %0, m0\n\ts_mov_b32 m0, %2\n\ts_nop 0\n\tglobal_load_lds_dwordx4 %1, off\n\ts_mov_b32 m0, %0":"=&s"(keep):"v"(gsrc),"s"(lds_dst):"memory");}
__device__ __forceinline__ float max3f(float a,float b,float c){float r;asm("v_max3_f32 %0, %1, %2, %3":"=v"(r):"v"(a),"v"(b),"v"(c));return r;}
__device__ __forceinline__ float max2f(float a,float b){float r;asm("v_max_f32_e32 %0, %1, %2":"=v"(r):"v"(a),"v"(b));return r;}
__device__ __forceinline__ float fadd_s(float a,float b){float r;asm("v_add_f32_e32 %0, %1, %2":"=v"(r):"v"(a),"v"(b));return r;}
__device__ __forceinline__ float fsub_s(float a,float b){float r;asm("v_sub_f32_e32 %0, %1, %2":"=v"(r):"v"(a),"v"(b));return r;}
typedef float f32x2_t __attribute__((ext_vector_type(2))); typedef __bf16 bf16x2_t __attribute__((ext_vector_type(2)));
__device__ __forceinline__ unsigned cvtpk_s(float lo,float hi){f32x2_t v={lo,hi};bf16x2_t b=__builtin_convertvector(v,bf16x2_t);return __builtin_bit_cast(unsigned,b);}
#define WAIT_BAR(N) asm volatile("s_waitcnt vmcnt(" #N ") lgkmcnt(0)\n\ts_barrier":::"memory")

__device__ __forceinline__ void qkt(f32x16&p0,f32x16&p1,const char*Kslot,const bf16x8*qr,const f32x16&negm,int r32,int hi){
  const char*kb=Kslot+hi*1024+r32*16;
  #pragma unroll
  for(int d0=0;d0<4;++d0){
    const bf16x8 b0=*reinterpret_cast<const bf16x8*>(kb+d0*2048);
    const bf16x8 b1=*reinterpret_cast<const bf16x8*>(kb+d0*2048+512);
    if(d0==0){p0=__builtin_amdgcn_mfma_f32_32x32x16_bf16(b0,qr[0],negm,0,0,0);p1=__builtin_amdgcn_mfma_f32_32x32x16_bf16(b1,qr[0],negm,0,0,0);}
    else{p0=__builtin_amdgcn_mfma_f32_32x32x16_bf16(b0,qr[d0],p0,0,0,0);p1=__builtin_amdgcn_mfma_f32_32x32x16_bf16(b1,qr[d0],p1,0,0,0);}}
}
typedef __attribute__((address_space(3))) const char* lds_cptr;
typedef short v4i16_t __attribute__((ext_vector_type(4)));
__device__ __forceinline__ void kload8(bf16x8*kf,lds_cptr kp){
  kf[0]=*(const __attribute__((address_space(3))) bf16x8*)(kp);      kf[1]=*(const __attribute__((address_space(3))) bf16x8*)(kp+512);
  kf[2]=*(const __attribute__((address_space(3))) bf16x8*)(kp+2048); kf[3]=*(const __attribute__((address_space(3))) bf16x8*)(kp+2560);
  kf[4]=*(const __attribute__((address_space(3))) bf16x8*)(kp+4096); kf[5]=*(const __attribute__((address_space(3))) bf16x8*)(kp+4608);
  kf[6]=*(const __attribute__((address_space(3))) bf16x8*)(kp+6144); kf[7]=*(const __attribute__((address_space(3))) bf16x8*)(kp+6656);
}
__device__ __forceinline__ void kload2(bf16x8*kf,lds_cptr kp,int j){ kf[2*j]=*(const __attribute__((address_space(3))) bf16x8*)(kp+j*2048); kf[2*j+1]=*(const __attribute__((address_space(3))) bf16x8*)(kp+j*2048+512); }
__device__ __forceinline__ s16x4 vtr(lds_cptr p){ return __builtin_bit_cast(s16x4,__builtin_amdgcn_ds_read_tr16_b64_v4i16((__attribute__((address_space(3))) v4i16_t*)p)); }
__device__ __forceinline__ float rowmax(const f32x16&p0,const f32x16&p1){
  float a=max3f(p0[0],p0[1],p1[0]),b=max3f(p0[2],p0[3],p1[1]);a=max3f(a,p1[2],p1[3]);
  #pragma unroll
  for(int r=4;r<16;r+=4){a=max3f(a,p0[r],p0[r+1]);b=max3f(b,p0[r+2],p0[r+3]);a=max3f(a,p1[r],p1[r+1]);b=max3f(b,p1[r+2],p1[r+3]);}
  const float m=max2f(a,b);
  auto rr=__builtin_amdgcn_permlane32_swap(__float_as_uint(m),__float_as_uint(m),false,false);
  return max2f(__uint_as_float(rr[0]),__uint_as_float(rr[1]));
}
__device__ __forceinline__ void pv(f32x16*o,int vb,bf16x8 pa0,bf16x8 pa1,bf16x8 pa2,bf16x8 pa3){
  #pragma unroll
  for(int d0=0;d0<2;++d0){s16x4 lo[4],hi[4];
    #pragma unroll
    for(int ks=0;ks<4;++ks){
      asm volatile("ds_read_b64_tr_b16 %0,%1 offset:%c2":"=&v"(lo[ks]):"v"(vb),"i"(d0*4096+ks*1024):"memory");
      asm volatile("ds_read_b64_tr_b16 %0,%1 offset:%c2":"=&v"(hi[ks]):"v"(vb),"i"(d0*4096+ks*1024+512):"memory");}
    asm volatile("s_waitcnt lgkmcnt(0)":::"memory");SBAR();
    #define PK(k) (bf16x8){lo[k][0],lo[k][1],lo[k][2],lo[k][3],hi[k][0],hi[k][1],hi[k][2],hi[k][3]}
    o[d0]=__builtin_amdgcn_mfma_f32_32x32x16_bf16(pa0,PK(0),o[d0],0,0,0);
    o[d0]=__builtin_amdgcn_mfma_f32_32x32x16_bf16(pa1,PK(1),o[d0],0,0,0);
    o[d0]=__builtin_amdgcn_mfma_f32_32x32x16_bf16(pa2,PK(2),o[d0],0,0,0);
    o[d0]=__builtin_amdgcn_mfma_f32_32x32x16_bf16(pa3,PK(3),o[d0],0,0,0);
    #undef PK
  }
}

#ifndef ATTN_STORE16
#define ATTN_STORE16(p,v) (*(u32x4*)(p)=(v))
#endif
template<int THRL> __device__ __forceinline__ void attn_unit(const bf16*Qblk,const bf16*__restrict__ Kh,const bf16*__restrict__ Vh,bf16*Oblk,char*shm,int wave_in){
  const int tid=wave_in*64+lane_fresh(),lane=tid&63,r32=lane&31,hi=lane>>5; const int wid=__builtin_amdgcn_readfirstlane(tid>>6);
  const bf16*Qw=Qblk+(long)(wid*QBLK)*QP;
  const unsigned lds0=(unsigned)(uintptr_t)shm;
  float*wsf=(float*)(shm+LDS_WS)+wid*64;
  const bf16*ksrc=Kh+(long)lane*KP+wid*8;
  const bf16*vsrc=Vh+(long)(16*(wid&3)+(lane>>2))*VP+(wid>>2)*32+(lane&3)*8;
  const unsigned kdst=lds0+LDS_K+wid*1024, vdst=lds0+LDS_V+wid*1024;
  #define DMA_K(t,slot) glds16(ksrc+(long)(t)*KVBLK*KP,(unsigned)__builtin_amdgcn_readfirstlane(kdst+(slot)))
  #define DMA_V(t,slot) glds16(vsrc+(long)(t)*KVBLK*VP,(unsigned)__builtin_amdgcn_readfirstlane(vdst+(slot)))
  const int vb0=(int)(lds0+LDS_V)+((lane>>4)&1)*32+(lane&3)*8+(4*hi+((lane&15)>>2))*64;
  const char*Kbase=shm+LDS_K; bf16x8 kf[8];
  const lds_cptr shm3=(lds_cptr)shm; const lds_cptr kp0=shm3+LDS_K+hi*1024+r32*16; const lds_cptr vp0=shm3+LDS_V+((lane>>4)&1)*32+(lane&3)*8+(4*hi+((lane&15)>>2))*64;
  const int NT=NT_ALL;
  DMA_K(0,0);DMA_V(0,0);DMA_K(1,SLOTB);
  bf16x8 qr[4];
  #pragma unroll
  for(int d0=0;d0<4;++d0)qr[d0]=*reinterpret_cast<const bf16x8*>(&Qw[(long)r32*QP+d0*16+hi*8]);
  float mhat=0.f,l_reg=0.f;f32x16 o[2];o[0]=f32x16{};o[1]=f32x16{};f32x16 negm=f32x16{};asm volatile("":"+v"(negm));
  #define CMASK(P0,P1,t) do{}while(0)
  bool resc=false;
  #define START(P0,P1) do{ const float rm=rowmax(P0,P1); resc=false; \
    { const float dl=rm; mhat=fadd_s(mhat,dl); \
      _Pragma("unroll") for(int r=0;r<16;++r){P0[r]=fsub_s(P0[r],dl);P1[r]=fsub_s(P1[r],dl);} \
      _Pragma("unroll") for(int r=0;r<16;++r)negm[r]=-mhat; asm volatile("":"+v"(negm)); } \
    _Pragma("unroll") for(int r=0;r<16;++r)P0[r]=__builtin_amdgcn_exp2f(P0[r]); }while(0)
  #define RESC() do{ if(resc){ asm volatile("s_waitcnt lgkmcnt(0)":::"memory"); \
      _Pragma("unroll") for(int d_=0;d_<2;++d_) _Pragma("unroll") for(int r=0;r<16;++r)o[d_][r]*=wsf[crow(r,hi)]; } }while(0)
  f32x16 pA0,pA1,pB0,pB1;
  int sl_prev=0,sl_cur=0,sl_next=SLOTB;
  #define ROT() do{sl_prev=sl_cur;sl_cur=sl_next;sl_next=(sl_next==(NSLOT-1)*SLOTB)?0:sl_next+SLOTB;}while(0)
  DMA_K(2,2*SLOTB);
  WAIT_BAR(3);
  qkt(pA0,pA1,Kbase,qr,negm,r32,hi);asm volatile("s_nop 15\n\ts_nop 7":"+v"(pA0),"+v"(pA1));CMASK(pA0,pA1,0);
  START(pA0,pA1);
  _Pragma("unroll") for(int r=0;r<16;++r)pA1[r]=__builtin_amdgcn_exp2f(pA1[r]);
  WAIT_BAR(0);
  DMA_K(3,0);DMA_V(1,SLOTB);
  ROT();
  kload8(kf,kp0+sl_cur);
  WAIT_BAR(2);
  s16x4 vlo[8],vhi[8]; u32x4 pw0,pw1,pw2,pw3;
  #define PKW(P,B) cvtpk_s(P[B],P[B+1])
  #define PAF(k) __builtin_bit_cast(bf16x8,pw##k)
  #define VFR(i) (bf16x8){vlo[i][0],vlo[i][1],vlo[i][2],vlo[i][3],vhi[i][0],vhi[i][1],vhi[i][2],vhi[i][3]}
  #define PIN(x) asm volatile("":"+v"(x))
  #define MX3(a,b,c) __builtin_fmaxf(__builtin_fmaxf((a),(b)),(c))
  #define GAPA(MF,A0,A1,A2,A3,W0,W1,PW) do{ MF; sacc+=A0; sacc+=A1; sacc+=A2; sacc+=A3; PIN(sacc); W0; W1; PIN(PW); SBAR(); }while(0)
  #define EX(v) __builtin_amdgcn_exp2f(v)
  #define GAPB(MF,X,B) do{ MF; X[B]=EX(X[B]); X[B+1]=EX(X[B+1]); X[B+2]=EX(X[B+2]); X[B+3]=EX(X[B+3]); PIN(X); SBAR(); }while(0)
  #define VRD(i) do{ vlo[i]=vtr(vp_+(((i)>>2)*4096+((i)&3)*1024)); vhi[i]=vtr(vp_+(((i)>>2)*4096+((i)&3)*1024+512)); }while(0)
  #define KRD(G,j) do{ if(G){ kload2(kf,kp0+sl_next,j); SBAR(); } }while(0)
  #define STEP(C0,C1,P0,P1,t,GK,GV,GL) do{ SBAR(); \
    const lds_cptr vp_=vp0+sl_prev; \
    VRD(0); SBAR(); float sacc=(P0[0]+P0[1]); \
    GAPA(C0=__builtin_amdgcn_mfma_f32_32x32x16_bf16(kf[0],qr[0],negm,0,0,0), P0[2],P0[3],P0[4],P0[5],     pw0[0]=PKW(P0,0), pw0[1]=PKW(P0,2), pw0); \
    VRD(4); SBAR(); GAPA(C1=__builtin_amdgcn_mfma_f32_32x32x16_bf16(kf[1],qr[0],negm,0,0,0), P0[6],P0[7],P0[8],P0[9],     pw0[2]=PKW(P0,4), pw0[3]=PKW(P0,6), pw0); \
    VRD(1); SBAR(); GAPA(C0=__builtin_amdgcn_mfma_f32_32x32x16_bf16(kf[2],qr[1],C0,0,0,0),   P0[10],P0[11],P0[12],P0[13], pw1[0]=PKW(P0,8), pw1[1]=PKW(P0,10), pw1); \
    VRD(5); SBAR(); GAPA(C1=__builtin_amdgcn_mfma_f32_32x32x16_bf16(kf[3],qr[1],C1,0,0,0),   P0[14],P0[15],P1[0],P1[1],   pw1[2]=PKW(P0,12),pw1[3]=PKW(P0,14), pw1); \
    VRD(2); SBAR(); GAPA(C0=__builtin_amdgcn_mfma_f32_32x32x16_bf16(kf[4],qr[2],C0,0,0,0),   P1[2],P1[3],P1[4],P1[5],     pw2[0]=PKW(P1,0), pw2[1]=PKW(P1,2), pw2); \
    VRD(6); SBAR(); GAPA(C1=__builtin_amdgcn_mfma_f32_32x32x16_bf16(kf[5],qr[2],C1,0,0,0),   P1[6],P1[7],P1[8],P1[9],     pw2[2]=PKW(P1,4), pw2[3]=PKW(P1,6), pw2); \
    VRD(3); SBAR(); GAPA(C0=__builtin_amdgcn_mfma_f32_32x32x16_bf16(kf[6],qr[3],C0,0,0,0),   P1[10],P1[11],P1[12],P1[13], pw3[0]=PKW(P1,8), pw3[1]=PKW(P1,10), pw3); \
    VRD(7); SBAR(); GAPA(C1=__builtin_amdgcn_mfma_f32_32x32x16_bf16(kf[7],qr[3],C1,0,0,0),   P1[14],P1[15],0.f,0.f,       pw3[2]=PKW(P1,12),pw3[3]=PKW(P1,14), pw3); \
    l_reg+=sacc; \
    if(GK){DMA_K((t)+3,sl_cur);} if(GV){DMA_V((t)+1,sl_next);} \
    CMASK(C0,C1,t); \
    { float a=MX3(C0[0],C0[1],C1[0]),b=MX3(C0[2],C0[3],C1[1]); a=MX3(a,C1[2],C1[3]); \
      _Pragma("unroll") for(int r=4;r<16;r+=4){a=MX3(a,C0[r],C0[r+1]);b=MX3(b,C0[r+2],C0[r+3]);a=MX3(a,C1[r],C1[r+1]);b=MX3(b,C1[r+2],C1[r+3]);} \
      float rm=__builtin_fmaxf(a,b); { auto rr=__builtin_amdgcn_permlane32_swap(__float_as_uint(rm),__float_as_uint(rm),false,false); rm=__builtin_fmaxf(__uint_as_float(rr[0]),__uint_as_float(rr[1])); } \
      resc=false; \
      if(__builtin_expect(__any(rm>(float)THRL),0)){ const float dl=__builtin_fmaxf(rm,0.f); mhat+=dl; \
        _Pragma("unroll") for(int r=0;r<16;++r){C0[r]-=dl;C1[r]-=dl;} \
        _Pragma("unroll") for(int r=0;r<16;++r)negm[r]=-mhat; asm volatile("":"+v"(negm)); \
        const float f=__builtin_amdgcn_exp2f(-dl); l_reg*=f; if(hi==0)wsf[r32]=f; resc=true; } } \
    SBAR(); \
    GAPB(o[0]=__builtin_amdgcn_mfma_f32_32x32x16_bf16(PAF(0),VFR(0),o[0],0,0,0), C0,0); \
    GAPB(o[1]=__builtin_amdgcn_mfma_f32_32x32x16_bf16(PAF(0),VFR(4),o[1],0,0,0), C0,4); \
    KRD(GL,0); GAPB(o[0]=__builtin_amdgcn_mfma_f32_32x32x16_bf16(PAF(1),VFR(1),o[0],0,0,0), C0,8); \
    KRD(GL,1); GAPB(o[1]=__builtin_amdgcn_mfma_f32_32x32x16_bf16(PAF(1),VFR(5),o[1],0,0,0), C0,12); \
    KRD(GL,2); GAPB(o[0]=__builtin_amdgcn_mfma_f32_32x32x16_bf16(PAF(2),VFR(2),o[0],0,0,0), C1,0); \
    KRD(GL,3); GAPB(o[1]=__builtin_amdgcn_mfma_f32_32x32x16_bf16(PAF(2),VFR(6),o[1],0,0,0), C1,4); \
    GAPB(o[0]=__builtin_amdgcn_mfma_f32_32x32x16_bf16(PAF(3),VFR(3),o[0],0,0,0), C1,8); \
    GAPB(o[1]=__builtin_amdgcn_mfma_f32_32x32x16_bf16(PAF(3),VFR(7),o[1],0,0,0), C1,12); \
    }while(0)
  int t=1;
  #undef CMASK
  #define CMASK(P0,P1,t) do{}while(0)
  for(;t+5<NT;t+=2){
    STEP(pB0,pB1,pA0,pA1,t,true,true,true);     WAIT_BAR(2); RESC(); ROT();
    STEP(pA0,pA1,pB0,pB1,t+1,true,true,true);   WAIT_BAR(2); RESC(); ROT();
  }
  #undef CMASK
  #define CMASK(P0,P1,t) do{}while(0)
  #define ENDW(tt) do{ if((tt)+3<NT){WAIT_BAR(2);} else if((tt)+2<NT){WAIT_BAR(1);} else {WAIT_BAR(0);} }while(0)
  for(;t+1<NT;t+=2){
    STEP(pB0,pB1,pA0,pA1,t,(t+3<NT),(t+1<NT),(t+1<NT));       ENDW(t);   RESC(); ROT();
    STEP(pA0,pA1,pB0,pB1,t+1,(t+4<NT),(t+2<NT),(t+2<NT));     ENDW(t+1); RESC(); ROT();
  }
  STEP(pB0,pB1,pA0,pA1,NT-1,false,false,false); RESC();
  { float sacc=pB0[0]+pB0[1]; _Pragma("unroll") for(int r=2;r<16;++r)sacc+=pB0[r]; _Pragma("unroll") for(int r=0;r<16;++r)sacc+=pB1[r]; l_reg+=sacc;
    pw0=(u32x4){PKW(pB0,0),PKW(pB0,2),PKW(pB0,4),PKW(pB0,6)};pw1=(u32x4){PKW(pB0,8),PKW(pB0,10),PKW(pB0,12),PKW(pB0,14)};pw2=(u32x4){PKW(pB1,0),PKW(pB1,2),PKW(pB1,4),PKW(pB1,6)};pw3=(u32x4){PKW(pB1,8),PKW(pB1,10),PKW(pB1,12),PKW(pB1,14)};
    SBAR(); pv(o,vb0+sl_cur,PAF(0),PAF(1),PAF(2),PAF(3)); }
  #undef PKW
  #undef PAF
  #undef VFR
  #undef PIN
  #undef MX3
  #undef GAPA
  #undef GAPB
  #undef EX
  #undef VRD
  #undef KRD
  #undef STEP
  #undef ENDW
  {auto rr=__builtin_amdgcn_permlane32_swap(__float_as_uint(l_reg),__float_as_uint(l_reg),false,false);l_reg=__uint_as_float(rr[0])+__uint_as_float(rr[1]);}
  if(hi==0)wsf[32+r32]=l_reg;asm volatile("s_waitcnt lgkmcnt(0)":::"memory");
  float rli[16];
  #pragma unroll
  for(int r=0;r<16;++r)rli[r]=__builtin_amdgcn_rcpf(wsf[32+crow(r,hi)]);
  bf16*Ow=Oblk+(long)(wid*QBLK)*OP;
  { bf16*stg=(bf16*)(shm+LDS_OST)+wid*2048;
    #pragma unroll
    for(int r=0;r<16;++r){const int orow=crow(r,hi);
      #pragma unroll
      for(int d0=0;d0<2;++d0)stg[orow*64+d0*32+r32]=__float2bfloat16(o[d0][r]*rli[r]);}
    asm volatile("s_waitcnt lgkmcnt(0)":::"memory");
    #pragma unroll
    for(int i=0;i<4;++i){const int row=i*8+(lane>>3),ch=lane&7; const u32x4 v=*(const u32x4*)(stg+row*64+ch*8); ATTN_STORE16(Ow+(long)row*OP+ch*8,v);} }
  asm volatile("s_waitcnt lgkmcnt(0)\n\ts_barrier":::"memory");
  #undef DMA_K
  #undef DMA_V
  #undef CMASK
  #undef START
  #undef RESC
  #undef ROT
}
constexpr int ATTN_LDS_BYTES=LDS_BYTES;
#undef SBAR
#undef WAIT_BAR
}


#define GAS __attribute__((address_space(1)))
#define LAS __attribute__((address_space(3)))
typedef unsigned short bf16;
typedef unsigned v4u __attribute__((ext_vector_type(4)));
typedef unsigned v2u __attribute__((ext_vector_type(2)));
typedef float f32x4 __attribute__((ext_vector_type(4)));
typedef short bf16x8 __attribute__((ext_vector_type(8)));
typedef GAS unsigned gu32;

constexpr int NWAVES = 8, NTHR = 512;
constexpr int DM = 1024, NB = 4, SEQ = 8192, NTOK = NB * SEQ, CTX = 256, NCTX = NB * CTX, DFF = 2816, NKV = SEQ + CTX;
constexpr int DHY = 512, NIN = 3072, NUP = 2 * DFF;
constexpr float EPS = 1e-6f;
constexpr int SLAB_TILES = 133;
constexpr size_t MiB = 1u << 20;
constexpr size_t WS_CTL = 0, WS_STAT = 1 * MiB, WS_MOD = 2 * MiB, WS_CMOD = WS_MOD + 256 * 1024, WS_ROPE = WS_CMOD + 16 * 1024, WS_H2 = 3 * MiB;
constexpr size_t WS_WIN = 8 * MiB, WS_WOUT = 14 * MiB, WS_WUP0 = 16 * MiB, WS_WUP1 = 27 * MiB, WS_WDN0 = 38 * MiB, WS_WDN1 = 44 * MiB, WS_WSIN = 50 * MiB, WS_WSOUT = 54 * MiB, WS_W3 = 56 * MiB, WS_WS = 57 * MiB;
constexpr size_t WS_ACT = 58 * MiB, WS_HC = 124 * MiB, WS_R = 126 * MiB, WS_HY = 158 * MiB, WS_Q = 254 * MiB, WS_K = 286 * MiB, WS_V = 320 * MiB, WS_O = 354 * MiB, WS_YAT = 418 * MiB, WS_END = 450 * MiB;
constexpr size_t WS_HID = 158 * MiB, WS_SU = 158 * MiB, WS_SV = 222 * MiB;
constexpr size_t WS_RS = WS_STAT + 256 * 1024;
constexpr size_t WS_SHW = WS_MOD + 512 * 1024;
constexpr size_t WS_ACT2 = 354 * MiB;
static_assert(WS_ACT + (size_t)(NTOK + 301) * DM * 2 <= WS_HC && WS_HID + (size_t)NTOK * DFF * 2 <= WS_O, "ws map");
constexpr int LDS_BYTES = 147456, RING_BYTES = 131072, MISC_OFF = LDS_BYTES - 256;

#define RLX_AGENT __ATOMIC_RELAXED, __HIP_MEMORY_SCOPE_AGENT
#define LDS_WAIT() asm volatile("s_waitcnt lgkmcnt(0)" ::: "memory")
typedef float f32x2_c __attribute__((ext_vector_type(2))); typedef __bf16 bf16x2_c __attribute__((ext_vector_type(2)));
__device__ __forceinline__ unsigned pk2(float lo, float hi) { f32x2_c v = {lo, hi}; bf16x2_c b = __builtin_convertvector(v, bf16x2_c); return __builtin_bit_cast(unsigned, b); }
__device__ __forceinline__ unsigned f2bf(float f) { return pk2(f, 0.f) & 0xffffu; }
__device__ __forceinline__ float bf2f(unsigned h) { return __builtin_bit_cast(float, h << 16); }
__device__ __forceinline__ float bflo(unsigned w) { return __builtin_bit_cast(float, w << 16); }
__device__ __forceinline__ float bfhi(unsigned w) { return __builtin_bit_cast(float, w & 0xffff0000u); }
__device__ __forceinline__ float wave_sum(float v) {
#pragma unroll
    for (int o = 1; o < 64; o <<= 1) v += __shfl_xor(v, o);
    return v;
}
#ifndef USE_DPP
#define USE_DPP 1
#endif
__device__ __forceinline__ float rot_prev(float v) {
#if USE_DPP
    return __builtin_bit_cast(float, __builtin_amdgcn_update_dpp(0, __builtin_bit_cast(int, v), 0x121, 0xf, 0xf, false));
#else
    const int l = threadIdx.x & 63; return __shfl(v, (l & 48) | ((l - 1) & 15));
#endif
}
__device__ __forceinline__ float rot_next(float v) {
#if USE_DPP
    return __builtin_bit_cast(float, __builtin_amdgcn_update_dpp(0, __builtin_bit_cast(int, v), 0x12F, 0xf, 0xf, false));
#else
    const int l = threadIdx.x & 63; return __shfl(v, (l & 48) | ((l + 1) & 15));
#endif
}
__device__ __forceinline__ f32x4 rot_prev4(f32x4 v) { return (f32x4){rot_prev(v[0]), rot_prev(v[1]), rot_prev(v[2]), rot_prev(v[3])}; }
__device__ __forceinline__ f32x4 rot_next4(f32x4 v) { return (f32x4){rot_next(v[0]), rot_next(v[1]), rot_next(v[2]), rot_next(v[3])}; }

namespace epi {
using pg8::Unit; using pg8::bf16_t;
typedef float f32x4 __attribute__((ext_vector_type(4)));

struct EpiInProj {
    static constexpr bool PERM = false, AFTER_DRAIN = false;
    bf16_t* HY; bf16_t* Q; bf16_t* Kb; bf16_t* Vb; const float* cw; const float* cb; const float* rope;
    __device__ __forceinline__ void operator()(const f32x4 (&acc)[2][2][4][2], const Unit& u, int wr, int wc, int fr_, int fq_) const {
        const int l_ = lane_fresh(), fr = l_ & 15, fq = l_ >> 4; (void)fr_; (void)fq_;
        if (u.pn < 6) {
#pragma unroll
            for (int ai = 0; ai < 2; ++ai) {
                const int gbase = 248 * u.pm + 62 * (2 * ai + wr) - 1;
#pragma unroll
                for (int bj = 0; bj < 2; ++bj)
#pragma unroll
                    for (int n = 0; n < 2; ++n) {
                        const int col = 256 * u.pn + 128 * bj + 32 * wc + 16 * n + 4 * fq;
                        const f32x4 w0 = *(const f32x4*)(cw + col), w1 = *(const f32x4*)(cw + 1536 + col), w2 = *(const f32x4*)(cw + 3072 + col), bb = *(const f32x4*)(cb + col);
                        f32x4 rp_prev = (f32x4){0.f, 0.f, 0.f, 0.f}, rn_cur = rot_next4(acc[ai][bj][0][n]);
#pragma unroll
                        for (int m = 0; m < 4; ++m) {
                            const int j = 16 * m + fr, g = gbase + j, t = g & (SEQ - 1), b = g >> 13;
                            const f32x4 rp_cur = rot_prev4(acc[ai][bj][m][n]);
                            const f32x4 rn_next = (m < 3) ? rot_next4(acc[ai][bj][m < 3 ? m + 1 : 3][n]) : rn_cur;
                            f32x4 p = (fr == 0) ? rp_prev : rp_cur;
                            f32x4 q = (fr == 15) ? rn_next : rn_cur;
                            rp_prev = rp_cur; rn_cur = rn_next;
                            if (t == 0) p = (f32x4){0.f, 0.f, 0.f, 0.f};
                            if (t == SEQ - 1) q = (f32x4){0.f, 0.f, 0.f, 0.f};
                            const f32x4 o = w0 * p + w1 * acc[ai][bj][m][n] + w2 * q + bb;
                            if (j >= 1 && j <= 62 && g < NTOK) {
                                bf16_t* dst = HY + ((size_t)(b * 1536 + col) * SEQ + t);
                                dst[0] = (bf16_t)f2bf(o[0]); dst[SEQ] = (bf16_t)f2bf(o[1]); dst[2 * SEQ] = (bf16_t)f2bf(o[2]); dst[3 * SEQ] = (bf16_t)f2bf(o[3]);
                            }
                        }
                        asm volatile("" ::: "memory");
                    }
            }
        } else if (u.pn < 10) {
            const bool isq = u.pn < 8;
            const float sc = isq ? attn_body::C2 : 1.0f;
#pragma unroll
            for (int ai = 0; ai < 2; ++ai) {
                const int gbase = 248 * u.pm + 62 * (2 * ai + wr) - 1;
#pragma unroll
                for (int m = 0; m < 4; ++m) {
                    const int j = 16 * m + fr, g = gbase + j, t = g & (SEQ - 1), b = g >> 13;
                    const bool ok = (j >= 1 && j <= 62 && g < NTOK);
                    const int pos = (wc & 1) ? (t & 63) : (t >> 6);
                    const float* rp = rope + (size_t)(pos * 16 + 4 * fq) * 2;
                    const f32x4 cs0 = *(const f32x4*)rp, cs1 = *(const f32x4*)(rp + 4);
                    const f32x4 cc = (f32x4){cs0[0], cs0[2], cs1[0], cs1[2]}, ss = (f32x4){cs0[1], cs0[3], cs1[1], cs1[3]};
#pragma unroll
                    for (int bj = 0; bj < 2; ++bj) {
                        const f32x4 x1 = acc[ai][bj][m][0], x2 = acc[ai][bj][m][1];
                        const f32x4 o1 = (x1 * cc - x2 * ss) * sc, o2 = (x1 * ss + x2 * cc) * sc;
                        const int col = 256 * (u.pn - (isq ? 6 : 8)) + 128 * bj + 32 * wc + 4 * fq;
                        if (ok) {
                            bf16_t* dst = isq ? (Q + (size_t)g * 512 + col) : (Kb + ((size_t)b * NKV + CTX + t) * 512 + col);
                            *(v2u*)dst = (v2u){pk2(o1[0], o1[1]), pk2(o1[2], o1[3])};
                            *(v2u*)(dst + 16) = (v2u){pk2(o2[0], o2[1]), pk2(o2[2], o2[3])};
                        }
                    }
                    asm volatile("" ::: "memory");
                }
            }
        } else {
#pragma unroll
            for (int ai = 0; ai < 2; ++ai) {
                const int gbase = 248 * u.pm + 62 * (2 * ai + wr) - 1;
#pragma unroll
                for (int m = 0; m < 4; ++m) {
                    const int j = 16 * m + fr, g = gbase + j, t = g & (SEQ - 1), b = g >> 13;
                    if (j >= 1 && j <= 62 && g < NTOK) {
#pragma unroll
                        for (int bj = 0; bj < 2; ++bj)
#pragma unroll
                            for (int n = 0; n < 2; ++n) {
                                const int col = 256 * (u.pn - 10) + 128 * bj + 32 * wc + 16 * n + 4 * fq;
                                const f32x4 v = acc[ai][bj][m][n];
                                *(v2u*)(Vb + ((size_t)b * NKV + CTX + t) * 512 + col) = (v2u){pk2(v[0], v[1]), pk2(v[2], v[3])};
                            }
                    }
                }
            }
        }
    }
};

struct EpiCtxKV {
    static constexpr bool PERM = false, AFTER_DRAIN = false;
    bf16_t* Kb; bf16_t* Vb;
    __device__ __forceinline__ void operator()(const f32x4 (&acc)[2][2][4][2], const Unit& u, int wr, int wc, int fr_, int fq_) const {
        const int l_ = lane_fresh(), fr = l_ & 15, fq = l_ >> 4; (void)fr_; (void)fq_;
#pragma unroll
        for (int ai = 0; ai < 2; ++ai)
#pragma unroll
            for (int m = 0; m < 4; ++m) {
                const int row = 256 * u.pm + 128 * ai + 64 * wr + 16 * m + fr, b = row >> 8, tc = row & 255;
#pragma unroll
                for (int bj = 0; bj < 2; ++bj)
#pragma unroll
                    for (int n = 0; n < 2; ++n) {
                        const int col = 256 * u.pn + 128 * bj + 32 * wc + 16 * n + 4 * fq;
                        const f32x4 v = acc[ai][bj][m][n];
                        bf16_t* dst = (col < 512) ? (Kb + ((size_t)b * NKV + tc) * 512 + col) : (Vb + ((size_t)b * NKV + tc) * 512 + (col - 512));
                        *(v2u*)dst = (v2u){pk2(v[0], v[1]), pk2(v[2], v[3])};
                    }
            }
    }
};

struct EpiResid {
    static constexpr bool PERM = false, AFTER_DRAIN = false;
    const float* base; float* out; const float* gate;
    bf16_t* nextA; const float* gain; const float* scale; float* rs;
    __device__ __forceinline__ void operator()(const f32x4 (&acc)[2][2][4][2], const Unit& u, int wr, int wc, int fr_, int fq_) const {
        const int l_ = lane_fresh(), fr = l_ & 15, fq = l_ >> 4; (void)fr_; (void)fq_;
        const int b = u.pm >> 5;
#pragma unroll
        for (int ai = 0; ai < 2; ++ai)
#pragma unroll
            for (int m = 0; m < 4; ++m) {
                const int row = 256 * u.pm + 128 * ai + 64 * wr + 16 * m + fr;
                float ss = 0.f;
#pragma unroll
                for (int bj = 0; bj < 2; ++bj)
#pragma unroll
                    for (int n = 0; n < 2; ++n) {
                        const int col = 256 * u.pn + 128 * bj + 32 * wc + 16 * n + 4 * fq;
                        const f32x4 gt = *(const f32x4*)(gate + b * 6144 + col), bs = *(const f32x4*)(base + (size_t)row * DM + col);
                        const f32x4 o = bs + gt * acc[ai][bj][m][n];
                        *(f32x4*)(out + (size_t)row * DM + col) = o;
                        if (nextA) {
                            const f32x4 gv = *(const f32x4*)(gain + col) * (*(const f32x4*)(scale + b * 6144 + col) + 1.0f), a = o * gv;
                            *(v2u*)(nextA + (size_t)row * DM + col) = (v2u){pk2(a[0], a[1]), pk2(a[2], a[3])};
                            ss += (o[0] * o[0] + o[1] * o[1]) + (o[2] * o[2] + o[3] * o[3]);
                        }
                    }
                if (nextA) { ss += __shfl_xor(ss, 16); ss += __shfl_xor(ss, 32); if (fq == 0) atomicAdd(rs + row, ss); }
            }
    }
};

struct EpiFfnUp {
    static constexpr bool PERM = true, AFTER_DRAIN = false;
    bf16_t* H; const float* cw; const float* cb;
    __device__ __forceinline__ void operator()(const f32x4 (&acc)[2][2][4][2], const Unit& u, int wr, int wc, int fr_, int fq_) const {
        const int l_ = lane_fresh(), fr = l_ & 15, fq = l_ >> 4; (void)fr_; (void)fq_;
#pragma unroll
        for (int ai = 0; ai < 2; ++ai) {
            const int gbase = 248 * u.pm + 62 * (2 * ai + wr) - 1;
#pragma unroll
            for (int n = 0; n < 2; ++n) {
                const int ch = 128 * u.pn + 32 * wc + 8 * fq + 4 * n;
                const f32x4 g0 = *(const f32x4*)(cw + ch), g1 = *(const f32x4*)(cw + NUP + ch), g2 = *(const f32x4*)(cw + 2 * NUP + ch), gb = *(const f32x4*)(cb + ch);
                const f32x4 u0 = *(const f32x4*)(cw + DFF + ch), u1 = *(const f32x4*)(cw + NUP + DFF + ch), u2 = *(const f32x4*)(cw + 2 * NUP + DFF + ch), ub = *(const f32x4*)(cb + DFF + ch);
                const f32x4 z = (f32x4){0.f, 0.f, 0.f, 0.f};
                f32x4 gp_prev = z, up_prev = z, gn_cur = rot_next4(acc[ai][0][0][n]), un_cur = rot_next4(acc[ai][1][0][n]);
#pragma unroll
                for (int m = 0; m < 4; ++m) {
                    const int j = 16 * m + fr, g = gbase + j, t = g & (SEQ - 1);
                    const f32x4 gp_cur = rot_prev4(acc[ai][0][m][n]), up_cur = rot_prev4(acc[ai][1][m][n]);
                    const f32x4 gn_next = (m < 3) ? rot_next4(acc[ai][0][m < 3 ? m + 1 : 3][n]) : gn_cur, un_next = (m < 3) ? rot_next4(acc[ai][1][m < 3 ? m + 1 : 3][n]) : un_cur;
                    f32x4 pg = (fr == 0) ? gp_prev : gp_cur, ng = (fr == 15) ? gn_next : gn_cur;
                    f32x4 pu = (fr == 0) ? up_prev : up_cur, nu = (fr == 15) ? un_next : un_cur;
                    gp_prev = gp_cur; up_prev = up_cur; gn_cur = gn_next; un_cur = un_next;
                    if (t == 0) { pg = z; pu = z; }
                    if (t == SEQ - 1) { ng = z; nu = z; }
                    const f32x4 gc = g0 * pg + g1 * acc[ai][0][m][n] + g2 * ng + gb;
                    const f32x4 uc = u0 * pu + u1 * acc[ai][1][m][n] + u2 * nu + ub;
                    f32x4 h;
#pragma unroll
                    for (int e = 0; e < 4; ++e) h[e] = gc[e] * __builtin_amdgcn_rcpf(1.0f + __builtin_amdgcn_exp2f(-1.4426950408889634f * gc[e])) * uc[e];
                    if (j >= 1 && j <= 62 && g < NTOK) *(v2u*)(H + (size_t)g * DFF + ch) = (v2u){pk2(h[0], h[1]), pk2(h[2], h[3])};
                }
                asm volatile("" ::: "memory");
            }
        }
    }
};

struct EpiSguIn {
    static constexpr bool PERM = true, AFTER_DRAIN = false;
    bf16_t* U; bf16_t* V; const float* bias; float* stat; const float* rs; const float* shw;
    __device__ __forceinline__ void operator()(const f32x4 (&acc)[2][2][4][2], const Unit& u, int wr, int wc, int fr_, int fq_) const {
        const int l_ = lane_fresh(), fr = l_ & 15, fq = l_ >> 4; (void)fr_; (void)fq_;
        const bool isv = u.pn >= 4;
#pragma unroll
        for (int ai = 0; ai < 2; ++ai)
#pragma unroll
            for (int m = 0; m < 4; ++m) {
                const int row = 256 * u.pm + 128 * ai + 64 * wr + 16 * m + fr;
                float s = 0.f, s2 = 0.f;
                const float rstd = 1.0f / sqrtf(rs[row] * (1.0f / DM) + EPS); const int b = row >> 13;
#pragma unroll
                for (int bj = 0; bj < 2; ++bj) {
                    const int col = 256 * u.pn + 128 * bj + 32 * wc + 8 * fq;
                    const f32x4 b0 = *(const f32x4*)(bias + col) + *(const f32x4*)(shw + b * NUP + col), b1 = *(const f32x4*)(bias + col + 4) + *(const f32x4*)(shw + b * NUP + col + 4);
                    const f32x4 v0 = acc[ai][bj][m][0] * rstd + b0, v1 = acc[ai][bj][m][1] * rstd + b1;
                    const pg8::f32x2 a = pg8::gelu_pk((pg8::f32x2){v0[0], v0[1]}), b = pg8::gelu_pk((pg8::f32x2){v0[2], v0[3]}), c = pg8::gelu_pk((pg8::f32x2){v1[0], v1[1]}), d = pg8::gelu_pk((pg8::f32x2){v1[2], v1[3]});
                    s += (a.x + a.y) + (b.x + b.y) + (c.x + c.y) + (d.x + d.y);
                    s2 += (a.x * a.x + a.y * a.y) + (b.x * b.x + b.y * b.y) + (c.x * c.x + c.y * c.y) + (d.x * d.x + d.y * d.y);
                    bf16_t* dst = (isv ? V : U) + (size_t)row * DM + (col & 1023);
                    *(v4u*)dst = (v4u){pk2(a.x, a.y), pk2(b.x, b.y), pk2(c.x, c.y), pk2(d.x, d.y)};
                }
                if (isv) {
                    s += __shfl_xor(s, 16); s += __shfl_xor(s, 32); s2 += __shfl_xor(s2, 16); s2 += __shfl_xor(s2, 32);
                    if (fq == 0) { atomicAdd(stat + 2 * row, s); atomicAdd(stat + 2 * row + 1, s2); }
                }
            }
    }
};
}

#define VM_WAIT() asm volatile("s_waitcnt vmcnt(0)" ::: "memory")
#define XB_TMO      128
#define XB_XCNT(j)  (256  + 64 * (j))
#define XB_XSUB(j)  (1280 + 64 * (j))
#define XB_XGEN(j)  (2304 + 64 * (j))
#define XB_TOP      3328
#define XB_TOPGEN   3392
#define XCD_BAR_WORDS 3456
#define XB_SPIN_CAP (1u << 18)

__device__ __forceinline__ unsigned xb_ld(unsigned* p)              { return __hip_atomic_load(p, __ATOMIC_RELAXED, __HIP_MEMORY_SCOPE_AGENT); }
__device__ __forceinline__ unsigned xb_add(unsigned* p, unsigned v) { return __hip_atomic_fetch_add(p, v, __ATOMIC_RELAXED, __HIP_MEMORY_SCOPE_AGENT); }
__device__ __forceinline__ unsigned xb_xcc_id() { return (unsigned)__builtin_amdgcn_s_getreg((3 << 11) | 20) & 0xFu; }
#define XB_SPIN(cond, bar) do { unsigned _sp = 0; while (cond) { __builtin_amdgcn_s_sleep(1); \
    if ((++_sp & 255u) == 0u) { if (xb_ld(&(bar)[XB_TMO])) break; if (_sp > XB_SPIN_CAP) { atomicAdd(&(bar)[XB_TMO], 1u); break; } } } } while (0)

struct XcdBarrier {
    unsigned* bar; unsigned x; int wave;
    volatile LAS unsigned* st;
};

__device__ __forceinline__ XcdBarrier xcd_barrier_post(unsigned* bar, volatile LAS unsigned* st, int wave) {
    XcdBarrier b; b.bar = bar; b.x = xb_xcc_id(); b.st = st; b.wave = wave;
    if (wave == 0 && lane_fresh() == 0) (void)xb_add(&bar[XB_XCNT(b.x)], 1u);
    return b;
}
__device__ __forceinline__ void xcd_barrier_complete(unsigned* bar, unsigned x, unsigned& nloc, unsigned& nx) {
    const unsigned G = gridDim.x * gridDim.y * gridDim.z;
    unsigned sum, cnt, mine, sp = 0u;
    for (;;) {
        sum = 0u; cnt = 0u; mine = 0u;
#pragma unroll
        for (unsigned j = 0; j < 16; ++j) { const unsigned c = xb_ld(&bar[XB_XCNT(j)]); sum += c; cnt += (c > 0u) ? 1u : 0u; mine = (j == x) ? c : mine; }
        if (sum == G) break;
        __builtin_amdgcn_s_sleep(1);
        if ((++sp & 255u) == 0u) { if (xb_ld(&bar[XB_TMO])) break; if (sp > XB_SPIN_CAP) { atomicAdd(&bar[XB_TMO], 1u); break; } }
    }
    nloc = mine > 0u ? mine : 1u; nx = cnt > 0u ? cnt : 1u;
}

__device__ __forceinline__ void xcd_barrier(const XcdBarrier& b) {
    asm volatile("s_waitcnt vmcnt(0)" ::: "memory");
    __syncthreads();
    if (b.wave == 0 && lane_fresh() == 0) {
        unsigned* bar = b.bar;
        __builtin_amdgcn_s_waitcnt(0);
        unsigned nloc = b.st[0], nx = b.st[1];
        if (nloc == 0u) { xcd_barrier_complete(bar, b.x, nloc, nx); b.st[0] = nloc; b.st[1] = nx; }
        const unsigned old = xb_add(&bar[XB_XSUB(b.x)], 1u);
        const unsigned gen = old / nloc;
        if (old + 1u == (gen + 1u) * nloc) {
            __builtin_amdgcn_fence(__ATOMIC_RELEASE, "agent");
            asm volatile("s_waitcnt vmcnt(0)" ::: "memory");
            const unsigned og = xb_add(&bar[XB_TOP], 1u);
            const unsigned tg = og / nx;
            if (og + 1u == (tg + 1u) * nx) xb_add(&bar[XB_TOPGEN], 1u);
            else XB_SPIN(xb_ld(&bar[XB_TOPGEN]) == tg, bar);
            __builtin_amdgcn_fence(__ATOMIC_ACQUIRE, "agent");
            xb_add(&bar[XB_XGEN(b.x)], 1u);
            asm volatile("s_waitcnt vmcnt(0)" ::: "memory");
        } else {
            XB_SPIN(xb_ld(&bar[XB_XGEN(b.x)]) == gen, bar);
            __builtin_amdgcn_fence(__ATOMIC_ACQUIRE, "agent");
            asm volatile("s_waitcnt vmcnt(0)" ::: "memory");
        }
    }
    __syncthreads();
}

typedef const float* fptr_t;
typedef __attribute__((address_space(4))) const fptr_t* ktab;
struct Ctx {
    LAS unsigned char* lds; unsigned char* ldsg; int wave, G, bx;
    ktab kin; float* out; unsigned char* ws;
};
__device__ __forceinline__ const float* ld_in(ktab t, int k) { asm volatile("" : "+s"(t)); return t[k]; }
#define INP(k) ld_in(C.kin, (k))
#define WSP(T, off) ((T*)(C.ws + (off)))

__device__ __forceinline__ void p0_transpose_item(const float* W, int ldw, int k0, int n0, bf16* WT, int ldt, int drow0, LAS float* scr, int lane) {
#pragma unroll 8
    for (int i = 0; i < 32; ++i) { const int kk = 2 * i + (lane >> 5); scr[kk * 33 + (lane & 31)] = W[(size_t)(k0 + kk) * ldw + n0 + (lane & 31)]; }
    LDS_WAIT(); asm volatile("" ::: "memory");
    const int c = lane & 7;
#pragma unroll
    for (int j = 0; j < 4; ++j) { const int n = (lane >> 3) + 8 * j; const LAS float* s = scr + (8 * c) * 33 + n;
        v4u o; o.x = pk2(s[0 * 33], s[1 * 33]); o.y = pk2(s[2 * 33], s[3 * 33]); o.z = pk2(s[4 * 33], s[5 * 33]); o.w = pk2(s[6 * 33], s[7 * 33]);
        *(v4u*)(WT + (size_t)(drow0 + n) * ldt + k0 + 8 * c) = o; }
    LDS_WAIT(); asm volatile("" ::: "memory");
}
__device__ __forceinline__ void p0_mat(const float* W, int K, int N, bf16* WT, int ldt, int item, bool ffn_perm, LAS float* scr, int lane) {
    const int nblk = N / 32, kb = item / nblk, nb = item % nblk, n0 = 32 * nb;
    int drow0 = n0;
    if (ffn_perm) { const int s = n0 / DFF, ch = n0 % DFF; drow0 = 256 * (ch >> 7) + 128 * s + (ch & 127); }
    p0_transpose_item(W, N, 64 * kb, n0, WT, ldt, drow0, scr, lane);
}
__device__ __forceinline__ float silu_f(float v) { return v / (1.0f + __expf(-v)); }

__device__ __forceinline__ void phase_p0(Ctx& C) {
    const int C_lane = lane_fresh(), C_tid = C.wave * 64 + C_lane;
    LAS float* scr = (LAS float*)(C.lds + C.wave * 16384);
    const int gw = C.bx * NWAVES + C.wave, NGW = C.G * NWAVES, lane = C_lane;
    const int gt = C.bx * NTHR + C_tid, NGT = C.G * NTHR;
    constexpr int I_IN = 16 * 96, I_OUT = 16 * 32, I_UP = 16 * 176, I_DN = 44 * 32, I_SIN = 16 * 64, I_SOUT = 16 * 32;
    constexpr int NITEMS = I_IN + I_OUT + 2 * I_UP + 2 * I_DN + I_SIN + I_SOUT;
    for (int it = gw; it < NITEMS; it += NGW) {
        int r = it;
        if (r < I_IN) { p0_mat(INP(12), 1024, NIN, WSP(bf16, WS_WIN), 1024, r, false, scr, lane); continue; } r -= I_IN;
        if (r < I_OUT) { p0_mat(INP(24), 1024, 1024, WSP(bf16, WS_WOUT), 1024, r, false, scr, lane); continue; } r -= I_OUT;
        if (r < I_UP) { p0_mat(INP(8), 1024, NUP, WSP(bf16, WS_WUP0), 1024, r, true, scr, lane); continue; } r -= I_UP;
        if (r < I_UP) { p0_mat(INP(8) + (size_t)1024 * NUP, 1024, NUP, WSP(bf16, WS_WUP1), 1024, r, true, scr, lane); continue; } r -= I_UP;
        if (r < I_DN) { p0_mat(INP(11), DFF, 1024, WSP(bf16, WS_WDN0), DFF, r, false, scr, lane); continue; } r -= I_DN;
        if (r < I_DN) { p0_mat(INP(11) + (size_t)DFF * 1024, DFF, 1024, WSP(bf16, WS_WDN1), DFF, r, false, scr, lane); continue; } r -= I_DN;
        if (r < I_SIN) { p0_mat(INP(25), 1024, 2048, WSP(bf16, WS_WSIN), 1024, r, false, scr, lane); continue; } r -= I_SIN;
        p0_mat(INP(31), 1024, 1024, WSP(bf16, WS_WSOUT), 1024, r, false, scr, lane);
    }
    for (int i = gt; i < 8 * 128 * 128 / 8; i += NGT) { const float* s = INP(29) + (size_t)i * 8; const f32x4 a = *(const f32x4*)s, b = *(const f32x4*)(s + 4);
        *(v4u*)(WSP(bf16, WS_WS) + (size_t)i * 8) = (v4u){pk2(a[0], a[1]), pk2(a[2], a[3]), pk2(b[0], b[1]), pk2(b[2], b[3])}; }
    for (int i = gt; i < NTOK * 5 / 4; i += NGT) *(f32x4*)(WSP(float, WS_STAT) + (size_t)i * 4) = (f32x4){0.f, 0.f, 0.f, 0.f};
    for (int i = gt; i < 128 * 16; i += NGT) { const int pos = i >> 4, k = i & 15; const float inv = powf(10000.0f, -(float)k / 16.0f), ang = (float)pos * inv; float sn, cs; sincosf(ang, &sn, &cs);
        WSP(float, WS_ROPE)[2 * i] = cs; WSP(float, WS_ROPE)[2 * i + 1] = sn; }
    {
        const float* w1 = INP(15); const float* b1 = INP(16); const float* fr = INP(17); const float* w2 = INP(18); const float* b2 = INP(19);
        const float f0 = fr[lane], f1 = fr[64 + lane], bb1 = b1[lane], bb2 = b2[lane];
        for (int t = gw; t < SEQ; t += NGW) {
            float z = 0.f;
            if (lane == 0) z = (float)t * (1.0f / 8191.0f);
            else if (lane <= 32) { const int k = (lane - 1) & 15; const float band = 1e-4f + (float)k * ((15.0f - 1e-4f) / 15.0f);
                const float ang = ((6.283185307179586f / 8192.0f) * (float)t) * band; z = (lane <= 16) ? cosf(ang) : -sinf(ang); }
            float a = bb1;
#pragma unroll
            for (int i = 0; i < 33; ++i) a += __shfl(z, i) * w1[i * 64 + lane];
            const float h1 = sinf(f0 * a);
            float a2 = bb2;
#pragma unroll 16
            for (int i = 0; i < 64; ++i) a2 += __shfl(h1, i) * w2[i * 64 + lane];
            const float h2 = sinf(f1 * a2);
            WSP(bf16, WS_H2)[(size_t)lane * SEQ + t] = (bf16)f2bf(h2);
        }
    }
    __syncthreads();
    {
        LAS float* red = (LAS float*)C.lds;
        for (int it = C.bx; it < 2 * 96; it += C.G) {
            const int l = it / 96, cb = it % 96, col = cb * 64 + lane;
            const float* W = INP(4) + (size_t)l * 1024 * 6144;
            float a0 = 0.f, a1 = 0.f, a2 = 0.f, a3 = 0.f, a4 = 0.f;
            const int kbeg = C.wave * 128;
#pragma unroll 4
            for (int k = kbeg; k < kbeg + 128; ++k) {
                const float w = W[(size_t)k * 6144 + col];
                a0 += silu_f(INP(1)[k]) * w; a1 += silu_f(INP(1)[1024 + k]) * w; a2 += silu_f(INP(1)[2048 + k]) * w; a3 += silu_f(INP(1)[3072 + k]) * w; a4 += silu_f(INP(3)[k]) * w;
            }
            red[(C.wave * 5 + 0) * 64 + lane] = a0; red[(C.wave * 5 + 1) * 64 + lane] = a1; red[(C.wave * 5 + 2) * 64 + lane] = a2; red[(C.wave * 5 + 3) * 64 + lane] = a3; red[(C.wave * 5 + 4) * 64 + lane] = a4;
            __syncthreads();
            if (C_tid < 320) { const int v = C_tid >> 6, cc = C_tid & 63; float s = 0.f;
#pragma unroll
                for (int w = 0; w < 8; ++w) s += red[(w * 5 + v) * 64 + cc];
                const int oc = cb * 64 + cc; s += INP(5)[l * 6144 + oc];
                if (v < 4) WSP(float, WS_MOD)[(size_t)(l * 4 + v) * 6144 + oc] = s;
                else if (l == 0 && oc < 2048) WSP(float, WS_CMOD)[oc] = s; }
            __syncthreads();
        }
    }
}

__device__ __forceinline__ void phase_norm_mod(Ctx& C, const float* src, int rows, int rows_per_batch, const float* g, const float* shift, const float* scale, int bstride, bf16* dst) {
    const int C_lane = lane_fresh(), C_tid = C.wave * 64 + C_lane;
    const int gw = C.bx * NWAVES + C.wave, NGW = C.G * NWAVES, lane = C_lane;
    for (int r = gw; r < rows; r += NGW) {
        const f32x4* xr = (const f32x4*)(src + (size_t)r * DM) + lane;
        const int b = r / rows_per_batch;
        f32x4 v[4]; float s = 0.f;
#pragma unroll
        for (int j = 0; j < 4; ++j) { v[j] = xr[64 * j]; s += (v[j][0] * v[j][0] + v[j][1] * v[j][1]) + (v[j][2] * v[j][2] + v[j][3] * v[j][3]); }
        const float rstd = 1.0f / sqrtf(wave_sum(s) * (1.0f / DM) + EPS);
        v2u* o = (v2u*)(dst + (size_t)r * DM) + lane;
#pragma unroll
        for (int j = 0; j < 4; ++j) {
            const int col = 4 * (lane + 64 * j);
            const f32x4 gg = *(const f32x4*)(g + col), sh = *(const f32x4*)(shift + (size_t)b * bstride + col), sc = *(const f32x4*)(scale + (size_t)b * bstride + col);
            const f32x4 y = (v[j] * rstd) * gg * (sc + 1.0f) + sh;
            o[64 * j] = (v2u){pk2(y[0], y[1]), pk2(y[2], y[3])};
        }
    }
}
__device__ __forceinline__ void phase_shw(Ctx& C) {
    const int C_lane = lane_fresh(), C_tid = C.wave * 64 + C_lane;
    const int gw = C.bx * NWAVES + C.wave, NGW = C.G * NWAVES, lane = C_lane;
    const float* MOD = WSP(float, WS_MOD);
    for (int r = gw; r < NUP + 2048 + NUP; r += NGW) {
        int inst, n; const bf16* WT; const float* sh;
        if (r < NUP) { inst = 0; n = r; WT = WSP(bf16, WS_WUP0); sh = MOD + 3072; }
        else if (r < NUP + 2048) { inst = 1; n = r - NUP; WT = WSP(bf16, WS_WSIN); sh = MOD + 4 * 6144; }
        else { inst = 2; n = r - NUP - 2048; WT = WSP(bf16, WS_WUP1); sh = MOD + 4 * 6144 + 3072; }
        float a[4] = {0.f, 0.f, 0.f, 0.f};
#pragma unroll
        for (int h = 0; h < 2; ++h) {
            const v4u wv = *(const v4u*)(WT + (size_t)n * 1024 + 512 * h + 8 * lane);
            const float wf[8] = {bflo(wv.x), bfhi(wv.x), bflo(wv.y), bfhi(wv.y), bflo(wv.z), bfhi(wv.z), bflo(wv.w), bfhi(wv.w)};
#pragma unroll
            for (int b = 0; b < 4; ++b) {
                const f32x4 s0 = *(const f32x4*)(sh + b * 6144 + 512 * h + 8 * lane), s1 = *(const f32x4*)(sh + b * 6144 + 512 * h + 8 * lane + 4);
                a[b] += (s0[0] * wf[0] + s0[1] * wf[1]) + (s0[2] * wf[2] + s0[3] * wf[3]) + (s1[0] * wf[4] + s1[1] * wf[5]) + (s1[2] * wf[6] + s1[3] * wf[7]);
            }
        }
#pragma unroll
        for (int b = 0; b < 4; ++b) { const float s = wave_sum(a[b]); if (lane == 0) WSP(float, WS_SHW)[(size_t)(inst * 4 + b) * NUP + n] = s; }
    }
}
__device__ __forceinline__ void phase_final_norm(Ctx& C, float* x, const float* g) {
    const int C_lane = lane_fresh(), C_tid = C.wave * 64 + C_lane;
    const int gw = C.bx * NWAVES + C.wave, NGW = C.G * NWAVES, lane = C_lane;
    for (int r = gw; r < NTOK; r += NGW) {
        f32x4* xr = (f32x4*)(x + (size_t)r * DM) + lane;
        f32x4 v[4]; float s = 0.f;
#pragma unroll
        for (int j = 0; j < 4; ++j) { v[j] = xr[64 * j]; s += (v[j][0] * v[j][0] + v[j][1] * v[j][1]) + (v[j][2] * v[j][2] + v[j][3] * v[j][3]); }
        const float rstd = 1.0f / sqrtf(wave_sum(s) * (1.0f / DM) + EPS);
#pragma unroll
        for (int j = 0; j < 4; ++j) { const f32x4 gg = *(const f32x4*)(g + 4 * (lane + 64 * j)); xr[64 * j] = (v[j] * rstd) * gg; }
    }
}

constexpr int HY_BSTR = 19264, HY_UL_BYTES = 4 * HY_BSTR, HY_RL_OFF = HY_UL_BYTES, HY_RL_BYTES = 2 * SEQ * 2;
static_assert(HY_RL_OFF + 2 * HY_RL_BYTES <= MISC_OFF && HY_UL_BYTES % 16 == 0, "hyena LDS");
__device__ __forceinline__ unsigned alignbit16(unsigned hi, unsigned lo) { return __builtin_amdgcn_alignbit(hi, lo, 16); }
__device__ __forceinline__ void hyena_make_filters(Ctx& C, int c) {
    const int C_lane = lane_fresh(), C_tid = C.wave * 64 + C_lane;
    LAS unsigned short* RL0 = (LAS unsigned short*)(C.lds + HY_RL_OFF);
    const bf16* H2T = WSP(bf16, WS_H2); const float* w3 = INP(20) + c;
    const int tid = C_tid;
    f32x4 acc[4][4];
#pragma unroll
    for (int i = 0; i < 4; ++i)
#pragma unroll
        for (int j = 0; j < 4; ++j) acc[i][j] = (f32x4){0.f, 0.f, 0.f, 0.f};
#pragma unroll 4
    for (int k = 0; k < 64; ++k) {
        const float w0 = w3[k * 2048], w1 = w3[k * 2048 + 512], w2 = w3[k * 2048 + 1024], w3v = w3[k * 2048 + 1536];
#pragma unroll
        for (int jj = 0; jj < 2; ++jj) {
            const v4u hv = *(const v4u*)(H2T + (size_t)k * SEQ + 8 * (tid + NTHR * jj));
            const f32x4 ha = (f32x4){bflo(hv.x), bfhi(hv.x), bflo(hv.y), bfhi(hv.y)}, hb = (f32x4){bflo(hv.z), bfhi(hv.z), bflo(hv.w), bfhi(hv.w)};
            acc[0][2 * jj] += ha * w0; acc[0][2 * jj + 1] += hb * w0; acc[1][2 * jj] += ha * w1; acc[1][2 * jj + 1] += hb * w1;
            acc[2][2 * jj] += ha * w2; acc[2][2 * jj + 1] += hb * w2; acc[3][2 * jj] += ha * w3v; acc[3][2 * jj + 1] += hb * w3v;
        }
    }
    const float dsc = (3.0701134573253945f + (float)c * ((15.350567286626973f - 3.0701134573253945f) / 511.0f)) * (1.4426950408889634f / 8191.0f);
#pragma unroll
    for (int j = 0; j < 4; ++j)
#pragma unroll
        for (int e = 0; e < 4; ++e) {
            const int t = 8 * (tid + NTHR * (j >> 1)) + 4 * (j & 1) + e; const float win = __builtin_amdgcn_exp2f(-(float)t * dsc) + 0.05f;
            RL0[SEQ - t] = (unsigned short)f2bf(acc[0][j][e] * win); RL0[2 * SEQ + SEQ - t] = (unsigned short)f2bf(acc[2][j][e] * win);
            if (t > 0) { RL0[SEQ + t] = (unsigned short)f2bf(acc[1][j][e] * win); RL0[2 * SEQ + SEQ + t] = (unsigned short)f2bf(acc[3][j][e] * win); }
        }
    if (tid == 0) { RL0[0] = 0; RL0[2 * SEQ] = 0; }
}
__device__ __forceinline__ void hyena_conv(Ctx& C, int o, f32x4 (&acc)[2][8]) {
    const int C_lane = lane_fresh(), C_tid = C.wave * 64 + C_lane;
    const int lane = C_lane, w = C.wave, m = lane & 15, q = lane >> 4;
    const LAS unsigned char* UL = C.lds; const LAS unsigned char* RL = C.lds + HY_RL_OFF + o * HY_RL_BYTES;
#pragma unroll
    for (int g = 0; g < 2; ++g)
#pragma unroll
        for (int a = 0; a < 8; ++a) acc[g][a] = (f32x4){0.f, 0.f, 0.f, 0.f};
    const int cl = m >> 2, bt = m & 3;
    const int dlo = 8 * w - 63;
    int roff = 2 * (SEQ - 128 * dlo - 8 * m + 8 * q), uoff = bt * HY_BSTR + (8 * w + cl + 3) * 272 + 16 * q - 272 * dlo;
    v4u lo = *(const LAS v4u*)(RL + roff - 16), hi = *(const LAS v4u*)(RL + roff);
    v4u b0 = *(const LAS v4u*)(UL + uoff), b1 = *(const LAS v4u*)(UL + uoff + 4 * 272);
#pragma unroll 1
    for (int it = 0; it < 284; ++it) {
        const int d = dlo + (it >> 2);
        const bool v0 = d <= 8 * w + 3, v1 = d >= 8 * w + 4 - 63;
        const bool wrap = (it & 3) == 3;
        const int roff_n = (it == 283) ? roff : roff + (wrap ? (-256 - 192) : 64), uoff_n = (it == 283) ? uoff : uoff + (wrap ? (-272 - 192) : 64);
        const v4u lo_n = *(const LAS v4u*)(RL + roff_n - 16), hi_n = *(const LAS v4u*)(RL + roff_n);
        const v4u b0_n = *(const LAS v4u*)(UL + uoff_n), b1_n = *(const LAS v4u*)(UL + uoff_n + 4 * 272);
        const unsigned wd[8] = {lo.x, lo.y, lo.z, lo.w, hi.x, hi.y, hi.z, hi.w};
        bf16x8 af[8];
#pragma unroll
        for (int p = 0; p < 4; ++p) {
            const v4u ev = (v4u){wd[4 - p], wd[5 - p], wd[6 - p], wd[7 - p]};
            const v4u od = (v4u){alignbit16(wd[4 - p], wd[3 - p]), alignbit16(wd[5 - p], wd[4 - p]), alignbit16(wd[6 - p], wd[5 - p]), alignbit16(wd[7 - p], wd[6 - p])};
            af[2 * p] = __builtin_bit_cast(bf16x8, ev); af[2 * p + 1] = __builtin_bit_cast(bf16x8, od);
        }
        if (v0) {
            const bf16x8 bfr = __builtin_bit_cast(bf16x8, b0);
#pragma unroll
            for (int a = 0; a < 8; ++a) acc[0][a] = __builtin_amdgcn_mfma_f32_16x16x32_bf16(af[a], bfr, acc[0][a], 0, 0, 0);
        }
        if (v1) {
            const bf16x8 bfr = __builtin_bit_cast(bf16x8, b1);
#pragma unroll
            for (int a = 0; a < 8; ++a) acc[1][a] = __builtin_amdgcn_mfma_f32_16x16x32_bf16(af[a], bfr, acc[1][a], 0, 0, 0);
        }
        lo = lo_n; hi = hi_n; b0 = b0_n; b1 = b1_n; roff = roff_n; uoff = uoff_n;
    }
}
__device__ __forceinline__ void hyena_item(Ctx& C, int c) {
    const int C_lane = lane_fresh(), C_tid = C.wave * 64 + C_lane;
    const int lane = C_lane, w = C.wave, tid = C_tid;
    LAS unsigned char* UL = C.lds;
    const bf16* HY = WSP(bf16, WS_HY);
    for (int i = tid; i < 4 * 6 * 17; i += NTHR) { const int bt = i / 102, r = i % 102, sl = r / 17, pc = r % 17; const int slot = sl < 3 ? sl : 64 + sl;
        *(LAS v4u*)(UL + bt * HY_BSTR + slot * 272 + pc * 16) = (v4u){0u, 0u, 0u, 0u}; }
#pragma unroll
    for (int i = 0; i < 8; ++i) { const int p = i * NTHR + tid, bt = p >> 10, r = p & 1023, ch = r >> 4, pc = r & 15;
        *(LAS v4u*)(UL + bt * HY_BSTR + (ch + 3) * 272 + pc * 16) = *(const v4u*)(HY + ((size_t)(bt * 1536 + c) * SEQ) + r * 8); }
    hyena_make_filters(C, c);
    __syncthreads();
    f32x4 acc[2][8];
    const int mcol = lane & 15, q = lane >> 4, cl = mcol >> 2, bt = mcol & 3;
#pragma unroll 1
    for (int o = 0; o < 2; ++o) {
        hyena_conv(C, o, acc);
        __syncthreads();
        const float dsk = INP(21)[o * 512 + c];
#pragma unroll
        for (int g = 0; g < 2; ++g) {
            const int chunk = 8 * w + 4 * g + cl, p0 = 128 * chunk + 32 * q;
            LAS unsigned char* zl = UL + bt * HY_BSTR + (chunk + 3) * 272 + 64 * q;
            const bf16* gate = HY + ((size_t)(bt * 1536 + (o + 1) * 512 + c) * SEQ) + p0;
            unsigned short outv[32];
#pragma unroll
            for (int k = 0; k < 4; ++k) {
                const v4u zz = *(LAS v4u*)(zl + 16 * k), gg = *(const v4u*)(gate + 8 * k);
                const unsigned zw[4] = {zz.x, zz.y, zz.z, zz.w}, gw[4] = {gg.x, gg.y, gg.z, gg.w};
#pragma unroll
                for (int e = 0; e < 8; ++e) {
                    const float zv = (e & 1) ? bfhi(zw[e >> 1]) : bflo(zw[e >> 1]), gv = (e & 1) ? bfhi(gw[e >> 1]) : bflo(gw[e >> 1]);
                    outv[8 * k + e] = (unsigned short)f2bf(gv * (acc[g][e][k] + dsk * zv));
                }
            }
#pragma unroll
            for (int k = 0; k < 4; ++k) {
                const v4u ov = (v4u){(unsigned)outv[8 * k] | ((unsigned)outv[8 * k + 1] << 16), (unsigned)outv[8 * k + 2] | ((unsigned)outv[8 * k + 3] << 16),
                                     (unsigned)outv[8 * k + 4] | ((unsigned)outv[8 * k + 5] << 16), (unsigned)outv[8 * k + 6] | ((unsigned)outv[8 * k + 7] << 16)};
                if (o == 0) *(LAS v4u*)(zl + 16 * k) = ov;
                else *(v4u*)(WSP(bf16, WS_YAT) + ((size_t)(bt * 512 + c) * SEQ) + p0 + 8 * k) = ov;
            }
        }
        __syncthreads();
    }
}

__device__ __forceinline__ void phase_hyena(Ctx& C) {
    const int C_lane = lane_fresh(), C_tid = C.wave * 64 + C_lane;
#pragma unroll 1
    for (int c = C.bx; c < DHY; c += C.G) hyena_item(C, c);
}
__device__ __forceinline__ void phase_attn(Ctx& C) {
    const int C_lane = lane_fresh(), C_tid = C.wave * 64 + C_lane;
    const int v = (C.G % 8 == 0) ? (C.bx % 8) * (C.G / 8) + C.bx / 8 : C.bx;
#pragma unroll 1
    for (int u = v; u < 2048; u += C.G) {
        const int combo = u >> 5, qb = u & 31;
        const int b = combo >> 4, hm = (combo >> 1) & 7, vh = combo & 1, h = hm >> 1, mm = hm & 1;
        const attn_body::bf16* Qp = (const attn_body::bf16*)(WSP(bf16, WS_Q) + ((size_t)(b * SEQ + qb * 256) * 512 + hm * 64));
        const attn_body::bf16* Kp = (const attn_body::bf16*)(WSP(bf16, WS_K) + ((size_t)b * NKV * 512 + hm * 64));
        const attn_body::bf16* Vp = (const attn_body::bf16*)(WSP(bf16, WS_V) + ((size_t)b * NKV * 512 + h * 128 + vh * 64));
        attn_body::bf16* Op = (attn_body::bf16*)(WSP(bf16, WS_O) + ((size_t)(b * SEQ + qb * 256) * 1024 + mm * 512 + h * 128 + vh * 64));
        attn_body::attn_unit<8>(Qp, Kp, Vp, Op, (char*)C.ldsg, C.wave);
    }
    __syncthreads();
}

__device__ __forceinline__ void phase_combine(Ctx& C, bf16* MIX) {
    const int C_lane = lane_fresh(), C_tid = C.wave * 64 + C_lane;
    const int gw = C.bx * NWAVES + C.wave, NGW = C.G * NWAVES, lane = C_lane;
    const float lam_init = 0.2f;
    const float* dl = INP(22);
    const float lam = __expf(wave_sum(dl[lane] * dl[64 + lane])) - __expf(wave_sum(dl[128 + lane] * dl[192 + lane])) + lam_init;
    const bf16* O = WSP(bf16, WS_O);
    const float* sg = INP(23) + (lane & 15) * 8;
    const f32x4 g0 = *(const f32x4*)sg, g1 = *(const f32x4*)(sg + 4);
    for (int r = gw; r < NTOK; r += NGW) {
        const v4u a = *(const v4u*)(O + (size_t)r * 1024 + 8 * lane), b = *(const v4u*)(O + (size_t)r * 1024 + 512 + 8 * lane);
        const unsigned aw[4] = {a.x, a.y, a.z, a.w}, bw[4] = {b.x, b.y, b.z, b.w};
        float o[8]; float ss = 0.f;
#pragma unroll
        for (int e = 0; e < 4; ++e) { o[2 * e] = bflo(aw[e]) - lam * bflo(bw[e]); o[2 * e + 1] = bfhi(aw[e]) - lam * bfhi(bw[e]); ss += o[2 * e] * o[2 * e] + o[2 * e + 1] * o[2 * e + 1]; }
        ss += __shfl_xor(ss, 1); ss += __shfl_xor(ss, 2); ss += __shfl_xor(ss, 4); ss += __shfl_xor(ss, 8);
        const float rs = (1.0f / sqrtf(ss * (1.0f / 128.0f) + EPS)) * (1.0f - lam_init);
        *(v4u*)(MIX + (size_t)r * DM + 512 + 8 * lane) = (v4u){pk2(o[0] * rs * g0[0], o[1] * rs * g0[1]), pk2(o[2] * rs * g0[2], o[3] * rs * g0[3]), pk2(o[4] * rs * g1[0], o[5] * rs * g1[1]), pk2(o[6] * rs * g1[2], o[7] * rs * g1[3])};
    }
    LAS unsigned* tl = (LAS unsigned*)(C.lds + C.wave * 16384);
    const bf16* YAT = WSP(bf16, WS_YAT);
    for (int it = gw; it < 4 * 128 * 8; it += NGW) {
        const int b = it >> 10, tt = (it >> 3) & 127, ct = it & 7;
#pragma unroll
        for (int r = 0; r < 8; ++r) { const int c = r * 8 + (lane >> 3), tc = lane & 7;
            const v4u v = *(const v4u*)(YAT + ((size_t)(b * 512 + ct * 64 + c) * SEQ) + tt * 64 + tc * 8);
            tl[c * 33 + tc * 4 + 0] = v.x; tl[c * 33 + tc * 4 + 1] = v.y; tl[c * 33 + tc * 4 + 2] = v.z; tl[c * 33 + tc * 4 + 3] = v.w; }
        LDS_WAIT(); asm volatile("" ::: "memory");
#pragma unroll
        for (int r = 0; r < 8; ++r) { const int t = r * 8 + (lane >> 3), cc = lane & 7;
            unsigned short e[8];
#pragma unroll
            for (int k = 0; k < 8; ++k) { const unsigned wv = tl[(cc * 8 + k) * 33 + (t >> 1)]; e[k] = (unsigned short)((t & 1) ? (wv >> 16) : (wv & 0xffffu)); }
            *(v4u*)(MIX + (size_t)(b * SEQ + tt * 64 + t) * DM + ct * 64 + cc * 8) = (v4u){(unsigned)e[0] | ((unsigned)e[1] << 16), (unsigned)e[2] | ((unsigned)e[3] << 16), (unsigned)e[4] | ((unsigned)e[5] << 16), (unsigned)e[6] | ((unsigned)e[7] << 16)}; }
        LDS_WAIT(); asm volatile("" ::: "memory");
    }
}

__device__ __forceinline__ void phase_sgu_spatial(Ctx& C, bf16* GATED) {
    const int C_lane = lane_fresh(), C_tid = C.wave * 64 + C_lane;
    const int lane = C_lane, w = C.wave, tid = C_tid;
    LAS unsigned short* vt = (LAS unsigned short*)C.lds;
    const bf16* SU = WSP(bf16, WS_SU); const bf16* SV = WSP(bf16, WS_SV); const float* stat = WSP(float, WS_STAT); const bf16* WSb = WSP(bf16, WS_WS);
    const float* lng = INP(27); const float* lnb = INP(28); const float* bs = INP(30);
    for (int it = C.bx; it < 4 * 64 * 8; it += C.G) {
        const int g = it & 7, n = (it >> 3) & 63, b = it >> 9, tok0 = b * SEQ + n * 128;
        __syncthreads();
#pragma unroll
        for (int i = 0; i < 4; ++i) {
            const int p = i * NTHR + tid, s = p & 127, cp = p >> 7;
            const v4u v = *(const v4u*)(SV + (size_t)(tok0 + s) * DM + g * 128 + cp * 8);
            const float sm = stat[2 * (tok0 + s)], sq = stat[2 * (tok0 + s) + 1];
            const float mean = sm * (1.0f / 1024.0f), var = sq * (1.0f / 1024.0f) - mean * mean, rstd = 1.0f / sqrtf(var + EPS);
            const unsigned vw[4] = {v.x, v.y, v.z, v.w};
            const f32x4 ga = *(const f32x4*)(lng + g * 128 + cp * 8), gb = *(const f32x4*)(lng + g * 128 + cp * 8 + 4), ba = *(const f32x4*)(lnb + g * 128 + cp * 8), bb = *(const f32x4*)(lnb + g * 128 + cp * 8 + 4);
            const float gg[8] = {ga[0], ga[1], ga[2], ga[3], gb[0], gb[1], gb[2], gb[3]}, bq[8] = {ba[0], ba[1], ba[2], ba[3], bb[0], bb[1], bb[2], bb[3]};
#pragma unroll
            for (int e = 0; e < 8; ++e) { const float x = (e & 1) ? bfhi(vw[e >> 1]) : bflo(vw[e >> 1]); vt[(cp * 8 + e) * 136 + s] = (unsigned short)f2bf((x - mean) * rstd * gg[e] + bq[e]); }
        }
        __syncthreads();
        f32x4 acc[8];
#pragma unroll
        for (int cb = 0; cb < 8; ++cb) acc[cb] = (f32x4){0.f, 0.f, 0.f, 0.f};
        const int fr = lane & 15, fq = lane >> 4;
#pragma unroll
        for (int kb = 0; kb < 4; ++kb) {
            const bf16x8 a = *(const bf16x8*)(WSb + ((size_t)(g * 128 + 16 * w + fr) * 128) + 32 * kb + 8 * fq);
#pragma unroll
            for (int cb = 0; cb < 8; ++cb) { const bf16x8 bfr = *(const LAS bf16x8*)(vt + (16 * cb + fr) * 136 + 32 * kb + 8 * fq); acc[cb] = __builtin_amdgcn_mfma_f32_16x16x32_bf16(a, bfr, acc[cb], 0, 0, 0); }
        }
#pragma unroll
        for (int reg = 0; reg < 4; ++reg) {
            const int t = 16 * w + 4 * fq + reg; const float bias = bs[g * 128 + t];
#pragma unroll
            for (int cb = 0; cb < 8; ++cb) { const size_t off = (size_t)(tok0 + t) * DM + g * 128 + 16 * cb + fr; GATED[off] = (bf16)f2bf(bf2f(SU[off]) * (acc[cb][reg] + bias)); }
        }
    }
    __syncthreads();
}

#ifndef DUP_HY
#define DUP_HY 1
#endif
#ifndef DUP_AT
#define DUP_AT 1
#endif
#ifndef DUP_UP
#define DUP_UP 1
#endif
struct Args { const float* in[33]; float* out; unsigned char* ws; int ph_lo, ph_hi; };
constexpr int N_PHASES = 17;
__global__ void __launch_bounds__(NTHR, 2) fwd_megakernel(Args args) {
    extern __shared__ __attribute__((aligned(16))) unsigned char lds_raw[];
    cg::grid_group grid = cg::this_grid();
    Ctx C;
    C.lds = (LAS unsigned char*)lds_raw; C.ldsg = lds_raw; C.wave = __builtin_amdgcn_readfirstlane(threadIdx.x >> 6); C.G = gridDim.x; C.bx = blockIdx.x;
    C.kin = (ktab)__builtin_amdgcn_kernarg_segment_ptr();
    C.out = args.out; C.ws = args.ws;
    const int lo = args.ph_lo, hi = args.ph_hi;
    { const int C_lane = lane_fresh(), C_tid = C.wave * 64 + C_lane;
    { volatile LAS unsigned* mz = (volatile LAS unsigned*)(C.lds + MISC_OFF); if (C_tid < 64) mz[C_tid] = 0u; }
    __syncthreads();
    if (C.bx == 0) for (int i = C_tid; i < XCD_BAR_WORDS; i += NTHR) ((unsigned*)(C.ws + WS_CTL) + 4096)[i] = 0u;
    }
    XcdBarrier bar; bar.bar = (unsigned*)(C.ws + WS_CTL) + 4096; bar.x = 0; bar.wave = C.wave; bar.st = (volatile LAS unsigned*)(C.lds + MISC_OFF) + 8;
#ifndef PHMASK
#define PHMASK 0x1ffff
#endif
#define IN(k) ((((PHMASK) >> (k)) & 1) && lo <= (k) && (k) < hi)
#define SEAM(k) do { if (IN(k) && (k) + 1 < hi) xcd_barrier(bar); } while (0)
    bf16* ACT = WSP(bf16, WS_ACT);
    const float* MOD = WSP(float, WS_MOD);

    if (IN(0)) phase_p0(C);
    grid.sync();
    bar = xcd_barrier_post((unsigned*)(C.ws + WS_CTL) + 4096, (volatile LAS unsigned*)(C.lds + MISC_OFF) + 8, C.wave);
    bf16* ACT2 = WSP(bf16, WS_ACT2);
    float* RS = WSP(float, WS_RS);
    const float* SHW = WSP(float, WS_SHW);
    const float* MOD1 = MOD + (size_t)4 * 6144;
    if (IN(1)) {
        phase_norm_mod(C, INP(0), NTOK, SEQ, INP(6), MOD, MOD + 1024, 6144, ACT + DM);
        phase_norm_mod(C, INP(2), NCTX, NCTX, INP(6), WSP(float, WS_CMOD), WSP(float, WS_CMOD) + 1024, 0, WSP(bf16, WS_HC));
        phase_shw(C);
    }
    SEAM(1);
    if (IN(2)) {
        { pg8::Gemm g{ACT, WSP(bf16, WS_WIN), SLAB_TILES * 256, NIN, 1024, 1}; pg8::StaticOrder S; S.init(SLAB_TILES * 256, NIN, C.G, C.bx);
          epi::EpiInProj E{WSP(bf16, WS_HY), WSP(bf16, WS_Q), WSP(bf16, WS_K), WSP(bf16, WS_V), INP(13), INP(14), WSP(float, WS_ROPE)};
          pg8::gemm_phase<epi::EpiInProj, pg8::StaticOrder, true, true>(C.lds, g, S, E, C.wave); }
        { pg8::Gemm g{WSP(bf16, WS_HC), WSP(bf16, WS_WIN) + (size_t)2048 * 1024, NCTX, 1024, 1024, 0}; pg8::StaticOrder S; S.init(NCTX, 1024, C.G, (C.bx + C.G - 64) % C.G);
          epi::EpiCtxKV E{WSP(bf16, WS_K), WSP(bf16, WS_V)};
          pg8::gemm_phase<epi::EpiCtxKV, pg8::StaticOrder, true, true>(C.lds, g, S, E, C.wave); }
    }
    SEAM(2);
    if (IN(3)) { phase_hyena(C); phase_attn(C); }
    SEAM(3);
    if (IN(4)) phase_combine(C, ACT + DM);
    SEAM(4);
    if (IN(5)) {
        pg8::Gemm g{ACT + DM, WSP(bf16, WS_WOUT), NTOK, 1024, 1024, 0}; pg8::StaticOrder S; S.init(NTOK, 1024, C.G, C.bx);
        epi::EpiResid E{INP(0), C.out, MOD + 2048, nullptr, nullptr, nullptr, nullptr};
        pg8::gemm_phase<epi::EpiResid, pg8::StaticOrder, true, true>(C.lds, g, S, E, C.wave);
    }
    SEAM(5);
    if (IN(6)) phase_norm_mod(C, C.out, NTOK, SEQ, INP(7), MOD + 3072, MOD + 4096, 6144, ACT + DM);
    SEAM(6);
    if (IN(7)) {
        pg8::Gemm g{ACT, WSP(bf16, WS_WUP0), SLAB_TILES * 256, NUP, 1024, 1}; pg8::StaticOrder S; S.init(SLAB_TILES * 256, NUP, C.G, C.bx);
        epi::EpiFfnUp E{WSP(bf16, WS_HID), INP(9), INP(10)};
        pg8::gemm_phase<epi::EpiFfnUp, pg8::StaticOrder, true, true>(C.lds, g, S, E, C.wave);
    }
    SEAM(7);
    if (IN(8)) {
        pg8::Gemm g{WSP(bf16, WS_HID), WSP(bf16, WS_WDN0), NTOK, 1024, DFF, 0}; pg8::StaticOrder S; S.init(NTOK, 1024, C.G, C.bx);
        epi::EpiResid E{C.out, C.out, MOD + 5120, ACT + DM, INP(6) + 1024, MOD1 + 1024, RS + NTOK};
        pg8::gemm_phase<epi::EpiResid, pg8::StaticOrder, true, true>(C.lds, g, S, E, C.wave);
    }
    SEAM(8);
    if (IN(10)) {
        pg8::Gemm g{ACT + DM, WSP(bf16, WS_WSIN), NTOK, 2048, 1024, 0}; pg8::StaticOrder S; S.init(NTOK, 2048, C.G, C.bx);
        epi::EpiSguIn E{WSP(bf16, WS_SU), WSP(bf16, WS_SV), INP(26), WSP(float, WS_STAT), RS + NTOK, SHW + (size_t)4 * NUP};
        pg8::gemm_phase<epi::EpiSguIn, pg8::StaticOrder, true, true>(C.lds, g, S, E, C.wave);
    }
    SEAM(10);
    if (IN(11)) phase_sgu_spatial(C, ACT2 + DM);
    SEAM(11);
    if (IN(12)) {
        pg8::Gemm g{ACT2 + DM, WSP(bf16, WS_WSOUT), NTOK, 1024, 1024, 0}; pg8::StaticOrder S; S.init(NTOK, 1024, C.G, C.bx);
        epi::EpiResid E{C.out, C.out, MOD1 + 2048, nullptr, nullptr, nullptr, nullptr};
        pg8::gemm_phase<epi::EpiResid, pg8::StaticOrder, true, true>(C.lds, g, S, E, C.wave);
    }
    SEAM(12);
    if (IN(13)) phase_norm_mod(C, C.out, NTOK, SEQ, INP(7) + 1024, MOD1 + 3072, MOD1 + 4096, 6144, ACT + DM);
    SEAM(13);
    if (IN(14)) {
        pg8::Gemm g{ACT, WSP(bf16, WS_WUP1), SLAB_TILES * 256, NUP, 1024, 1}; pg8::StaticOrder S; S.init(SLAB_TILES * 256, NUP, C.G, C.bx);
        epi::EpiFfnUp E{WSP(bf16, WS_HID), INP(9) + (size_t)3 * NUP, INP(10) + NUP};
        pg8::gemm_phase<epi::EpiFfnUp, pg8::StaticOrder, true, true>(C.lds, g, S, E, C.wave);
    }
    SEAM(14);
    if (IN(15)) {
        pg8::Gemm g{WSP(bf16, WS_HID), WSP(bf16, WS_WDN1), NTOK, 1024, DFF, 0}; pg8::StaticOrder S; S.init(NTOK, 1024, C.G, C.bx);
        epi::EpiResid E{C.out, C.out, MOD1 + 5120, nullptr, nullptr, nullptr, nullptr};
        pg8::gemm_phase<epi::EpiResid, pg8::StaticOrder, true, true>(C.lds, g, S, E, C.wave);
    }
    SEAM(15);
    if (IN(16)) phase_final_norm(C, C.out, INP(32));
#undef IN
#undef SEAM
}

extern "C" void kernel_launch(void* const* d_in, const int* in_sizes, int n_in, void* d_out, int out_size, void* d_ws, size_t ws_size, hipStream_t stream) {
    static int grid = 0;
    if (grid == 0) {
        if (n_in != 33 || out_size != NTOK * DM || ws_size < WS_END) { fprintf(stderr, "kernel_launch: unexpected shapes (n_in %d out %d ws %zu)\n", n_in, out_size, ws_size); grid = -1; return; }
        int dev = 0, cus = 0, per_cu = 0;
        hipGetDevice(&dev); hipDeviceGetAttribute(&cus, hipDeviceAttributeMultiprocessorCount, dev);
        hipFuncSetAttribute((const void*)fwd_megakernel, hipFuncAttributeMaxDynamicSharedMemorySize, LDS_BYTES);
        if (hipOccupancyMaxActiveBlocksPerMultiprocessor(&per_cu, (const void*)fwd_megakernel, NTHR, LDS_BYTES) != hipSuccess || per_cu < 1) per_cu = 1;
        (void)hipGetLastError();
        grid = cus * per_cu;
    }
    if (grid < 0) return;
    Args a{};
    for (int i = 0; i < 33; ++i) a.in[i] = (const float*)d_in[i];
    a.out = (float*)d_out; a.ws = (unsigned char*)d_ws;
#ifndef N_LAUNCH_SPLIT
    a.ph_lo = 0; a.ph_hi = N_PHASES;
    void* params[] = {&a};
    hipError_t e = hipLaunchCooperativeKernel((const void*)fwd_megakernel, dim3(grid), dim3(NTHR), params, LDS_BYTES, stream);
    if (e != hipSuccess) fprintf(stderr, "cooperative launch failed: %s (grid %d)\n", hipGetErrorString(e), grid);
#else
    for (int p = 0; p < N_PHASES; ++p) { a.ph_lo = p; a.ph_hi = p + 1; hipLaunchKernelGGL(fwd_megakernel, dim3(grid), dim3(NTHR), LDS_BYTES, stream, a); }
#endif
}
```

```cpp
#include <hip/hip_runtime.h>
#include <hip/hip_cooperative_groups.h>
#include <hip/hip_bf16.h>
#include <cstdio>
#include <cstdint>
#include <cmath>
namespace cg = cooperative_groups;
__device__ __forceinline__ int lane_fresh() { int l; asm volatile("v_mbcnt_lo_u32_b32 %0, -1, 0\n\tv_mbcnt_hi_u32_b32 %0, -1, %0" : "=v"(l)); return l; }
namespace pg8 {
#define PG8_LAS __attribute__((address_space(3)))
typedef unsigned short bf16_t;
typedef short bf16x8 __attribute__((ext_vector_type(8)));
typedef float f32x4 __attribute__((ext_vector_type(4)));
typedef unsigned u32x4 __attribute__((ext_vector_type(4)));
constexpr int BM = 256, BK = 64, HALF = 128, HTB = HALF * BK * 2  , STAGE_BYTES = 8 * HTB, NXCD = 8, WGM = 8;

__host__ __device__ __forceinline__ int lds_byte(int r, int c) { const int st = (r >> 4) * 2 + (c >> 5), rr = r & 15, cc = c & 31, ob = rr * 64 + cc * 2; return st * 1024 + (ob ^ (((ob >> 9) & 1) << 5)); }
__host__ __device__ __forceinline__ void stage_rc(int b, int& R, int& C) { const int st = b / 1024, sb = b % 1024, swz = sb ^ (((sb >> 9) & 1) << 5); R = (st >> 1) * 16 + swz / 64; C = (st & 1) * 32 + (swz % 64) / 2; }
__host__ __device__ __forceinline__ int perm32(int rho) { const int n = rho >> 4, i = rho & 15; return 8 * (i >> 2) + 4 * n + (i & 3); }

struct Unit { int pm, pn; };
struct Gemm { const bf16_t* A; const bf16_t* Bt; int M, N, K; int slab; };

struct StaticOrder {
    int nM, nN, nwg, G, c;
    __host__ __device__ void init(int M, int N, int G_, int c_) { nM = M / BM; nN = N / BM; nwg = nM * nN; G = G_; c = c_; }
    __host__ __device__ bool next(int i, Unit& u) const {
        const long L = (long)i * G + c; if (L >= nwg) return false;
        int wgid = (int)L; { const int q = nwg / NXCD, r = nwg % NXCD, xcd = wgid % NXCD, off = wgid / NXCD; wgid = (xcd < r ? xcd * (q + 1) : r * (q + 1) + (xcd - r) * q) + off; }
        const int nig = WGM * nN, gid = wgid / nig, fm = gid * WGM, gsz = (nM - fm) < WGM ? (nM - fm) : WGM;
        u.pm = fm + ((wgid % nig) % gsz); u.pn = (wgid % nig) / gsz; return true;
    }
    __device__ __forceinline__ void a_ready(const Unit&) const {}
    __device__ __forceinline__ void done(const Unit&) const {}
};

__device__ __forceinline__ unsigned cvt_pk_bf16(float lo, float hi) { unsigned r; asm volatile("v_cvt_pk_bf16_f32 %0, %1, %2" : "=v"(r) : "v"(lo), "v"(hi)); return r; }
typedef float f32x2 __attribute__((ext_vector_type(2)));
__device__ __forceinline__ f32x2 gelu_pk(f32x2 v) {
    const f32x2 av = __builtin_elementwise_abs(v), d = av * 0.2316418882f + 1.0f;
    f32x2 t; t.x = __builtin_amdgcn_rcpf(d.x); t.y = __builtin_amdgcn_rcpf(d.y);
    f32x2 q = t * 0.5307027145f + (-0.7265760135f); q = q * t + 0.7107068705f; q = q * t + (-0.142248368f); q = q * t + 0.127414796f; q = q * t;
    const f32x2 s = (v * v) * (-0.72134752044f);
    f32x2 e; e.x = __builtin_amdgcn_exp2f(s.x); e.y = __builtin_amdgcn_exp2f(s.y);
    const f32x2 m = v * (q * e), r = v - m;
    f32x2 o; o.x = v.x < 0.f ? m.x : r.x; o.y = v.y < 0.f ? m.y : r.y; return o;
}

template <class Epi, class Sched, bool ALIGN_EPI = false, bool SP2 = false>
__device__ __forceinline__ void gemm_phase(PG8_LAS unsigned char* lds, const Gemm g, const Sched& S, const Epi& E, int wave_in) {
    int tid_ = wave_in * 64 + lane_fresh();
    const int tid = tid_, wid = __builtin_amdgcn_readfirstlane(tid >> 6), lane = tid & 63, wr = wid >> 2, wc = wid & 3, fr = lane & 15, fq = lane >> 4;
    const int K = g.K, nt = K / BK;
    unsigned voffA[2], voffB[2];
#pragma unroll
    for (int i = 0; i < 2; ++i) { int R, C; stage_rc(tid * 16 + i * 8192, R, C); const int Rb = Epi::PERM ? ((R & ~31) + perm32(R & 31)) : R;
        const int Ra = g.slab ? ((R >> 6) * 62 + (R & 63)) : R; voffA[i] = (unsigned)(Ra * K + C) * 2u; voffB[i] = (unsigned)(Rb * K + C) * 2u; }
    const size_t kstep = (size_t)(BK * 2);
    const size_t hstep = (size_t)HALF * K * 2;
    const size_t tstep = 2 * hstep;
    const size_t hstepA = g.slab ? (size_t)124 * K * 2 : hstep, tstepA = g.slab ? (size_t)248 * K * 2 : tstep;
    const unsigned ldsw = (unsigned)wid * 1024u;
    const int aoff = lds_byte(wr * 64 + fr, fq * 8), boff = lds_byte(wc * 32 + fr, fq * 8);
#define PG8_SA(b, h) (((b) * 2 + (h)) * HTB)
#define PG8_SB(b, h) ((4 + (b) * 2 + (h)) * HTB)
#define PG8_STAGE(bufoff, gbase, voff) do { _Pragma("unroll") for (int _i = 0; _i < 2; ++_i) \
        __builtin_amdgcn_global_load_lds((const unsigned*)((const char*)(gbase) + (voff)[_i]), (PG8_LAS unsigned*)(lds + (bufoff) + ldsw + _i * 8192), 16, 0, 0); } while (0)
#define PG8_LDA(dst, b, h) do { _Pragma("unroll") for (int m = 0; m < 4; ++m) _Pragma("unroll") for (int k = 0; k < 2; ++k) dst[m][k] = *(const PG8_LAS bf16x8*)(lds + PG8_SA(b, h) + aoff + m * 2048 + k * 1024); } while (0)
#define PG8_LDB(dst, b, h) do { _Pragma("unroll") for (int n = 0; n < 2; ++n) _Pragma("unroll") for (int k = 0; k < 2; ++k) dst[n][k] = *(const PG8_LAS bf16x8*)(lds + PG8_SB(b, h) + boff + n * 2048 + k * 1024); } while (0)
#define PG8_MMA(ai, bj, At, Bt) do { __builtin_amdgcn_s_setprio(1); _Pragma("unroll") for (int m = 0; m < 4; ++m) _Pragma("unroll") for (int n = 0; n < 2; ++n) _Pragma("unroll") for (int k = 0; k < 2; ++k) \
        acc[ai][bj][m][n] = __builtin_amdgcn_mfma_f32_16x16x32_bf16(Bt[n][k], At[m][k], acc[ai][bj][m][n], 0, 0, 0); __builtin_amdgcn_s_setprio(0); } while (0)
#define PG8_WAIT_V(n) asm volatile("s_waitcnt vmcnt(" #n ")" ::: "memory")
#define PG8_WAIT_L(n) asm volatile("s_waitcnt lgkmcnt(" #n ")" ::: "memory")
#define PG8_BAR __builtin_amdgcn_s_barrier()
#define PG8_SCHED __builtin_amdgcn_sched_barrier(0)
    Unit cur, nxt; int ui = 0;
    if (!S.next(0, cur)) return;
    f32x4 acc[2][2][4][2];
#pragma unroll
    for (int a = 0; a < 2; ++a)
#pragma unroll
        for (int b = 0; b < 2; ++b)
#pragma unroll
            for (int m = 0; m < 4; ++m)
#pragma unroll
                for (int n = 0; n < 2; ++n) acc[a][b][m][n] = (f32x4){0.f, 0.f, 0.f, 0.f};
    bf16x8 At[4][2], B0[2][2], B1[2][2];
    const char* cA = (const char*)g.A + (size_t)cur.pm * tstepA; const char* cB = (const char*)g.Bt + (size_t)cur.pn * tstep;
    S.a_ready(cur);
    if constexpr (SP2) {
        PG8_STAGE(PG8_SB(0, 0), cB, voffB); PG8_STAGE(PG8_SB(0, 1), cB + hstep, voffB); PG8_STAGE(PG8_SA(0, 0), cA, voffA); PG8_STAGE(PG8_SA(0, 1), cA + hstepA, voffA);
        if (wr == 1) PG8_BAR;
        PG8_WAIT_V(2); PG8_BAR;
        PG8_STAGE(PG8_SB(1, 0), cB + kstep, voffB); PG8_STAGE(PG8_SA(1, 0), cA + kstep, voffA); PG8_STAGE(PG8_SB(1, 1), cB + hstep + kstep, voffB);
        PG8_WAIT_V(6); PG8_BAR;
    } else {
        PG8_STAGE(PG8_SB(0, 0), cB, voffB); PG8_STAGE(PG8_SA(0, 0), cA, voffA); PG8_STAGE(PG8_SB(0, 1), cB + hstep, voffB); PG8_STAGE(PG8_SA(0, 1), cA + hstepA, voffA);
        if (wr == 1) PG8_BAR;
        PG8_WAIT_V(4); PG8_BAR;
        PG8_STAGE(PG8_SB(1, 0), cB + kstep, voffB); PG8_STAGE(PG8_SA(1, 0), cA + kstep, voffA); PG8_STAGE(PG8_SB(1, 1), cB + hstep + kstep, voffB);
        PG8_WAIT_V(6); PG8_BAR;
    }
    for (;;) {
        const bool has_next = S.next(ui + 1, nxt);
        const char* nA = has_next ? (const char*)g.A + (size_t)nxt.pm * tstepA : cA; const char* nB = has_next ? (const char*)g.Bt + (size_t)nxt.pn * tstep : cB;
        for (int t = 0; t < nt; t += 2) {
            const bool last = (t == nt - 2);
            const char* a1 = cA + (size_t)(t + 1) * kstep;
            const char* a2 = last ? nA : cA + (size_t)(t + 2) * kstep; const char* b2 = last ? nB : cB + (size_t)(t + 2) * kstep;
            const char* a3 = a2 + kstep; const char* b3 = b2 + kstep;
            if (last && has_next) S.a_ready(nxt);
            if constexpr (SP2) {
            PG8_LDB(B0, 0, 0); PG8_LDB(B1, 0, 1); PG8_SCHED; PG8_LDA(At, 0, 0); PG8_STAGE(PG8_SA(1, 1), a1 + hstepA, voffA);
            PG8_WAIT_V(8); PG8_WAIT_L(0); PG8_BAR; PG8_MMA(0, 0, At, B0); PG8_MMA(0, 1, At, B1); PG8_BAR; PG8_SCHED;
            PG8_LDA(At, 0, 1); PG8_STAGE(PG8_SB(0, 0), b2, voffB); PG8_STAGE(PG8_SB(0, 1), b2 + hstep, voffB); PG8_STAGE(PG8_SA(0, 0), a2, voffA);
            PG8_WAIT_V(8); PG8_WAIT_L(0); PG8_BAR; PG8_MMA(1, 0, At, B0); PG8_MMA(1, 1, At, B1); PG8_BAR; PG8_SCHED;
            PG8_LDB(B0, 1, 0); PG8_LDB(B1, 1, 1); PG8_SCHED; PG8_LDA(At, 1, 0); PG8_STAGE(PG8_SA(0, 1), a2 + hstepA, voffA);
            PG8_WAIT_V(8); PG8_WAIT_L(0); PG8_BAR; PG8_MMA(0, 0, At, B0); PG8_MMA(0, 1, At, B1); PG8_BAR; PG8_SCHED;
            PG8_LDA(At, 1, 1); PG8_STAGE(PG8_SB(1, 0), b3, voffB); PG8_STAGE(PG8_SB(1, 1), b3 + hstep, voffB); PG8_STAGE(PG8_SA(1, 0), a3, voffA);
            PG8_WAIT_V(8); PG8_WAIT_L(0); PG8_BAR; PG8_MMA(1, 0, At, B0); PG8_MMA(1, 1, At, B1); PG8_BAR; PG8_SCHED;
            } else {
            PG8_LDB(B0, 0, 0); PG8_SCHED; PG8_LDA(At, 0, 0); PG8_STAGE(PG8_SA(1, 1), a1 + hstepA, voffA);
            PG8_WAIT_L(8); PG8_BAR; PG8_WAIT_L(0); PG8_MMA(0, 0, At, B0); PG8_BAR; PG8_SCHED;
            PG8_LDB(B1, 0, 1); PG8_STAGE(PG8_SB(0, 0), b2, voffB);
            PG8_BAR; PG8_WAIT_L(0); PG8_MMA(0, 1, At, B1); PG8_BAR;
            PG8_LDA(At, 0, 1); PG8_STAGE(PG8_SA(0, 0), a2, voffA);
            PG8_BAR; PG8_WAIT_L(0); PG8_MMA(1, 0, At, B0); PG8_BAR; PG8_SCHED;
            PG8_STAGE(PG8_SB(0, 1), b2 + hstep, voffB);
            PG8_WAIT_V(6); PG8_BAR; PG8_MMA(1, 1, At, B1); PG8_BAR;
            PG8_LDB(B0, 1, 0); PG8_SCHED; PG8_LDA(At, 1, 0); PG8_STAGE(PG8_SA(0, 1), a2 + hstepA, voffA);
            PG8_WAIT_L(8); PG8_BAR; PG8_WAIT_L(0); PG8_MMA(0, 0, At, B0); PG8_BAR; PG8_SCHED;
            PG8_LDB(B1, 1, 1); PG8_STAGE(PG8_SB(1, 0), b3, voffB);
            PG8_BAR; PG8_WAIT_L(0); PG8_MMA(0, 1, At, B1); PG8_BAR;
            PG8_LDA(At, 1, 1); PG8_STAGE(PG8_SA(1, 0), a3, voffA);
            PG8_BAR; PG8_WAIT_L(0); PG8_MMA(1, 0, At, B0); PG8_BAR; PG8_SCHED;
            PG8_STAGE(PG8_SB(1, 1), b3 + hstep, voffB);
            PG8_WAIT_V(6); PG8_BAR; PG8_MMA(1, 1, At, B1); PG8_BAR;
            }
        }
        if constexpr (ALIGN_EPI) { if (wr == 0) PG8_BAR; }
        if constexpr (!Epi::AFTER_DRAIN) { E(acc, cur, wr, wc, fr, fq); S.done(cur); }
        if (!has_next) break;
#pragma unroll
        for (int a = 0; a < 2; ++a)
#pragma unroll
            for (int b = 0; b < 2; ++b)
#pragma unroll
                for (int m = 0; m < 4; ++m)
#pragma unroll
                    for (int n = 0; n < 2; ++n) acc[a][b][m][n] = (f32x4){0.f, 0.f, 0.f, 0.f};
        cur = nxt; cA = nA; cB = nB; ++ui;
        if constexpr (ALIGN_EPI) { if (wr == 1) PG8_BAR; }
    }
    PG8_WAIT_V(0);
    if constexpr (!ALIGN_EPI) { if (wr == 0) PG8_BAR; }
    PG8_BAR;
    if constexpr (Epi::AFTER_DRAIN) { E.fused(acc, cur, wr, wc, fr, fq, lds, wid, lane); S.done(cur); }
#undef PG8_SA
#undef PG8_SB
#undef PG8_STAGE
#undef PG8_LDA
#undef PG8_LDB
#undef PG8_MMA
#undef PG8_WAIT_V
#undef PG8_WAIT_L
#undef PG8_BAR
#undef PG8_SCHED
}
}

namespace attn_body {
using bf16=__hip_bfloat16;
using bf16x8=__attribute__((ext_vector_type(8)))short;
using s16x4=__attribute__((ext_vector_type(4)))short;
using f32x16=__attribute__((ext_vector_type(16)))float;
using u32x4=__attribute__((ext_vector_type(4)))unsigned;
constexpr int D=64,QP=512,KP=512,VP=512,OP=1024,NT_ALL=132;
constexpr int NW=8,QBLK=32,QB=QBLK*NW,KVBLK=64;
__device__ __forceinline__ int crow(int r,int hi){return (r&3)+8*(r>>2)+4*hi;}
#define SBAR() __builtin_amdgcn_sched_barrier(0)
__device__ __forceinline__ void cmask(f32x16&p0,f32x16&p1,int jb,int qrel,int hi){
  const float NEG=-INFINITY; int kb=64*jb+4*hi;
  #pragma unroll
  for(int r=0;r<16;++r){int kv=kb+(r&3)+8*(r>>2); if(kv>qrel)p0[r]=NEG; if(kv+32>qrel)p1[r]=NEG;}
}

constexpr int NSLOT=3, SLOTB=8192;
constexpr int LDS_K=0, LDS_V=NSLOT*SLOTB, LDS_V1=2*NSLOT*SLOTB, LDS_WS=3*NSLOT*SLOTB, LDS_OST=LDS_WS+NW*64*4, LDS_BYTES=LDS_OST+NW*4096;
constexpr float C2=0.125f*1.4426950408889634f;
__device__ __forceinline__ void glds16(const void*gsrc,unsigned lds_dst){unsigned keep;
  asm volatile("s_mov_b32 %0, m0\n\ts_mov_b32 m0, %2\n\ts_nop 0\n\tglobal_load_lds_dwordx4 %1, off\n\ts_mov_b32 m0, %0":"=&s"(keep):"v"(gsrc),"s"(lds_dst):"memory");}
__device__ __forceinline__ float max3f(float a,float b,float c){float r;asm("v_max3_f32 %0, %1, %2, %3":"=v"(r):"v"(a),"v"(b),"v"(c));return r;}
__device__ __forceinline__ float max2f(float a,float b){float r;asm("v_max_f32_e32 %0, %1, %2":"=v"(r):"v"(a),"v"(b));return r;}
__device__ __forceinline__ float fadd_s(float a,float b){float r;asm("v_add_f32_e32 %0, %1, %2":"=v"(r):"v"(a),"v"(b));return r;}
__device__ __forceinline__ float fsub_s(float a,float b){float r;asm("v_sub_f32_e32 %0, %1, %2":"=v"(r):"v"(a),"v"(b));return r;}
typedef float f32x2_t __attribute__((ext_vector_type(2))); typedef __bf16 bf16x2_t __attribute__((ext_vector_type(2)));
__device__ __forceinline__ unsigned cvtpk_s(float lo,float hi){f32x2_t v={lo,hi};bf16x2_t b=__builtin_convertvector(v,bf16x2_t);return __builtin_bit_cast(unsigned,b);}
#define WAIT_BAR(N) asm volatile("s_waitcnt vmcnt(" #N ") lgkmcnt(0)\n\ts_barrier":::"memory")

__device__ __forceinline__ void qkt(f32x16&p0,f32x16&p1,const char*Kslot,const bf16x8*qr,const f32x16&negm,int r32,int hi){
  const char*kb=Kslot+hi*1024+r32*16;
  #pragma unroll
  for(int d0=0;d0<4;++d0){
    const bf16x8 b0=*reinterpret_cast<const bf16x8*>(kb+d0*2048);
    const bf16x8 b1=*reinterpret_cast<const bf16x8*>(kb+d0*2048+512);
    if(d0==0){p0=__builtin_amdgcn_mfma_f32_32x32x16_bf16(b0,qr[0],negm,0,0,0);p1=__builtin_amdgcn_mfma_f32_32x32x16_bf16(b1,qr[0],negm,0,0,0);}
    else{p0=__builtin_amdgcn_mfma_f32_32x32x16_bf16(b0,qr[d0],p0,0,0,0);p1=__builtin_amdgcn_mfma_f32_32x32x16_bf16(b1,qr[d0],p1,0,0,0);}}
}
typedef __attribute__((address_space(3))) const char* lds_cptr;
typedef short v4i16_t __attribute__((ext_vector_type(4)));
__device__ __forceinline__ void kload8(bf16x8*kf,lds_cptr kp){
  kf[0]=*(const __attribute__((address_space(3))) bf16x8*)(kp);      kf[1]=*(const __attribute__((address_space(3))) bf16x8*)(kp+512);
  kf[2]=*(const __attribute__((address_space(3))) bf16x8*)(kp+2048); kf[3]=*(const __attribute__((address_space(3))) bf16x8*)(kp+2560);
  kf[4]=*(const __attribute__((address_space(3))) bf16x8*)(kp+4096); kf[5]=*(const __attribute__((address_space(3))) bf16x8*)(kp+4608);
  kf[6]=*(const __attribute__((address_space(3))) bf16x8*)(kp+6144); kf[7]=*(const __attribute__((address_space(3))) bf16x8*)(kp+6656);
}
__device__ __forceinline__ void kload2(bf16x8*kf,lds_cptr kp,int j){ kf[2*j]=*(const __attribute__((address_space(3))) bf16x8*)(kp+j*2048); kf[2*j+1]=*(const __attribute__((address_space(3))) bf16x8*)(kp+j*2048+512); }
__device__ __forceinline__ s16x4 vtr(lds_cptr p){ return __builtin_bit_cast(s16x4,__builtin_amdgcn_ds_read_tr16_b64_v4i16((__attribute__((address_space(3))) v4i16_t*)p)); }
__device__ __forceinline__ float rowmax(const f32x16&p0,const f32x16&p1){
  float a=max3f(p0[0],p0[1],p1[0]),b=max3f(p0[2],p0[3],p1[1]);a=max3f(a,p1[2],p1[3]);
  #pragma unroll
  for(int r=4;r<16;r+=4){a=max3f(a,p0[r],p0[r+1]);b=max3f(b,p0[r+2],p0[r+3]);a=max3f(a,p1[r],p1[r+1]);b=max3f(b,p1[r+2],p1[r+3]);}
  const float m=max2f(a,b);
  auto rr=__builtin_amdgcn_permlane32_swap(__float_as_uint(m),__float_as_uint(m),false,false);
  return max2f(__uint_as_float(rr[0]),__uint_as_float(rr[1]));
}
__device__ __forceinline__ void pv(f32x16*o,int vb,bf16x8 pa0,bf16x8 pa1,bf16x8 pa2,bf16x8 pa3){
  #pragma unroll
  for(int d0=0;d0<2;++d0){s16x4 lo[4],hi[4];
    #pragma unroll
    for(int ks=0;ks<4;++ks){
      asm volatile("ds_read_b64_tr_b16 %0,%1 offset:%c2":"=&v"(lo[ks]):"v"(vb),"i"(d0*4096+ks*1024):"memory");
      asm volatile("ds_read_b64_tr_b16 %0,%1 offset:%c2":"=&v"(hi[ks]):"v"(vb),"i"(d0*4096+ks*1024+512):"memory");}
    asm volatile("s_waitcnt lgkmcnt(0)":::"memory");SBAR();
    #define PK(k) (bf16x8){lo[k][0],lo[k][1],lo[k][2],lo[k][3],hi[k][0],hi[k][1],hi[k][2],hi[k][3]}
    o[d0]=__builtin_amdgcn_mfma_f32_32x32x16_bf16(pa0,PK(0),o[d0],0,0,0);
    o[d0]=__builtin_amdgcn_mfma_f32_32x32x16_bf16(pa1,PK(1),o[d0],0,0,0);
    o[d0]=__builtin_amdgcn_mfma_f32_32x32x16_bf16(pa2,PK(2),o[d0],0,0,0);
    o[d0]=__builtin_amdgcn_mfma_f32_32x32x16_bf16(pa3,PK(3),o[d0],0,0,0);
    #undef PK
  }
}

#ifndef ATTN_STORE16
#define ATTN_STORE16(p,v) (*(u32x4*)(p)=(v))
#endif
template<int THRL> __device__ __forceinline__ void attn_unit(const bf16*Qblk,const bf16*__restrict__ Kh,const bf16*__restrict__ Vh,bf16*Oblk,char*shm,int wave_in){
  const int tid=wave_in*64+lane_fresh(),lane=tid&63,r32=lane&31,hi=lane>>5; const int wid=__builtin_amdgcn_readfirstlane(tid>>6);
  const bf16*Qw=Qblk+(long)(wid*QBLK)*QP;
  const unsigned lds0=(unsigned)(uintptr_t)shm;
  float*wsf=(float*)(shm+LDS_WS)+wid*64;
  const bf16*ksrc=Kh+(long)lane*KP+wid*8;
  const bf16*vsrc=Vh+(long)(16*(wid&3)+(lane>>2))*VP+(wid>>2)*32+(lane&3)*8;
  const unsigned kdst=lds0+LDS_K+wid*1024, vdst=lds0+LDS_V+wid*1024, vdst1=lds0+LDS_V1+wid*1024;
  #define DMA_K(t,slot) glds16(ksrc+(long)(t)*KVBLK*KP,(unsigned)__builtin_amdgcn_readfirstlane(kdst+(slot)))
  #define DMA_V(t,slot) do{ glds16(vsrc+(long)(t)*KVBLK*VP,(unsigned)__builtin_amdgcn_readfirstlane(vdst+(slot))); glds16(vsrc+64+(long)(t)*KVBLK*VP,(unsigned)__builtin_amdgcn_readfirstlane(vdst1+(slot))); }while(0)
  const int vb0=(int)(lds0+LDS_V)+((lane>>4)&1)*32+(lane&3)*8+(4*hi+((lane&15)>>2))*64;
  const char*Kbase=shm+LDS_K; bf16x8 kf[8];
  const lds_cptr shm3=(lds_cptr)shm; const lds_cptr kp0=shm3+LDS_K+hi*1024+r32*16; const lds_cptr vp0=shm3+LDS_V+((lane>>4)&1)*32+(lane&3)*8+(4*hi+((lane&15)>>2))*64;
  const int NT=NT_ALL;
  DMA_K(0,0);DMA_V(0,0);DMA_K(1,SLOTB);
  bf16x8 qr[4];
  #pragma unroll
  for(int d0=0;d0<4;++d0)qr[d0]=*reinterpret_cast<const bf16x8*>(&Qw[(long)r32*QP+d0*16+hi*8]);
  float mhat=0.f,l_reg=0.f;f32x16 o[4];o[0]=f32x16{};o[1]=f32x16{};o[2]=f32x16{};o[3]=f32x16{};
  #define CMASK(P0,P1,t) do{}while(0)
  bool resc=false;
  #define START(P0,P1) do{ const float rm=rowmax(P0,P1); resc=false; \
    { const float dl=rm; mhat=fadd_s(mhat,dl); \
      _Pragma("unroll") for(int r=0;r<16;++r){P0[r]=fsub_s(P0[r],dl);P1[r]=fsub_s(P1[r],dl);} \
      } \
    _Pragma("unroll") for(int r=0;r<16;++r)P0[r]=__builtin_amdgcn_exp2f(P0[r]); }while(0)
  #define RESC() do{ if(resc){ asm volatile("s_waitcnt lgkmcnt(0)":::"memory"); \
      _Pragma("unroll") for(int d_=0;d_<4;++d_) _Pragma("unroll") for(int r=0;r<16;++r)o[d_][r]*=wsf[crow(r,hi)]; } }while(0)
  f32x16 pA0,pA1,pB0,pB1;
  int sl_prev=0,sl_cur=0,sl_next=SLOTB;
  #define ROT() do{sl_prev=sl_cur;sl_cur=sl_next;sl_next=(sl_next==(NSLOT-1)*SLOTB)?0:sl_next+SLOTB;}while(0)
  DMA_K(2,2*SLOTB);
  WAIT_BAR(3);
  qkt(pA0,pA1,Kbase,qr,f32x16{},r32,hi);asm volatile("s_nop 15\n\ts_nop 7":"+v"(pA0),"+v"(pA1));CMASK(pA0,pA1,0);
  START(pA0,pA1);
  _Pragma("unroll") for(int r=0;r<16;++r)pA1[r]=__builtin_amdgcn_exp2f(pA1[r]);
  WAIT_BAR(0);
  DMA_K(3,0);DMA_V(1,SLOTB);
  ROT();
  kload8(kf,kp0+sl_cur);
  WAIT_BAR(3);
  s16x4 vlo[8],vhi[8]; u32x4 pw0,pw1,pw2,pw3;
  #define PKW(P,B) cvtpk_s(P[B],P[B+1])
  #define PAF(k) __builtin_bit_cast(bf16x8,pw##k)
  #define VFR(i) (bf16x8){vlo[i][0],vlo[i][1],vlo[i][2],vlo[i][3],vhi[i][0],vhi[i][1],vhi[i][2],vhi[i][3]}
  #define PIN(x) asm volatile("":"+v"(x))
  #define MX3(a,b,c) __builtin_fmaxf(__builtin_fmaxf((a),(b)),(c))
  #define GAPA(MF,A0,A1,A2,A3,W0,W1,PW) do{ MF; sacc+=A0; sacc+=A1; sacc+=A2; sacc+=A3; PIN(sacc); W0; W1; PIN(PW); SBAR(); }while(0)
  #define EX(v) __builtin_amdgcn_exp2f(v)
  #define GAPB(MF,X,B) do{ MF; X[B]=EX(X[B]); X[B+1]=EX(X[B+1]); X[B+2]=EX(X[B+2]); X[B+3]=EX(X[B+3]); PIN(X); SBAR(); }while(0)
  #define VRD(i) do{ vlo[i]=vtr(vp_+(((i)>>2)*4096+((i)&3)*1024)); vhi[i]=vtr(vp_+(((i)>>2)*4096+((i)&3)*1024+512)); }while(0)
  #define KRD(G,j) do{ if(G){ kload2(kf,kp0+sl_next,j); SBAR(); } }while(0)
  #define STEP(C0,C1,P0,P1,t,GK,GV,GL) do{ SBAR(); \
    const lds_cptr vp_=vp0+sl_prev; \
    VRD(0); SBAR(); float sacc=(P0[0]+P0[1]); \
    GAPA(C0=__builtin_amdgcn_mfma_f32_32x32x16_bf16(kf[0],qr[0],f32x16{},0,0,0), P0[2],P0[3],P0[4],P0[5],     pw0[0]=PKW(P0,0), pw0[1]=PKW(P0,2), pw0); \
    VRD(4); SBAR(); GAPA(C1=__builtin_amdgcn_mfma_f32_32x32x16_bf16(kf[1],qr[0],f32x16{},0,0,0), P0[6],P0[7],P0[8],P0[9],     pw0[2]=PKW(P0,4), pw0[3]=PKW(P0,6), pw0); \
    VRD(1); SBAR(); GAPA(C0=__builtin_amdgcn_mfma_f32_32x32x16_bf16(kf[2],qr[1],C0,0,0,0),   P0[10],P0[11],P0[12],P0[13], pw1[0]=PKW(P0,8), pw1[1]=PKW(P0,10), pw1); \
    VRD(5); SBAR(); GAPA(C1=__builtin_amdgcn_mfma_f32_32x32x16_bf16(kf[3],qr[1],C1,0,0,0),   P0[14],P0[15],P1[0],P1[1],   pw1[2]=PKW(P0,12),pw1[3]=PKW(P0,14), pw1); \
    VRD(2); SBAR(); GAPA(C0=__builtin_amdgcn_mfma_f32_32x32x16_bf16(kf[4],qr[2],C0,0,0,0),   P1[2],P1[3],P1[4],P1[5],     pw2[0]=PKW(P1,0), pw2[1]=PKW(P1,2), pw2); \
    VRD(6); SBAR(); GAPA(C1=__builtin_amdgcn_mfma_f32_32x32x16_bf16(kf[5],qr[2],C1,0,0,0),   P1[6],P1[7],P1[8],P1[9],     pw2[2]=PKW(P1,4), pw2[3]=PKW(P1,6), pw2); \
    VRD(3); SBAR(); GAPA(C0=__builtin_amdgcn_mfma_f32_32x32x16_bf16(kf[6],qr[3],C0,0,0,0),   P1[10],P1[11],P1[12],P1[13], pw3[0]=PKW(P1,8), pw3[1]=PKW(P1,10), pw3); \
    VRD(7); SBAR(); GAPA(C1=__builtin_amdgcn_mfma_f32_32x32x16_bf16(kf[7],qr[3],C1,0,0,0),   P1[14],P1[15],0.f,0.f,       pw3[2]=PKW(P1,12),pw3[3]=PKW(P1,14), pw3); \
    l_reg+=sacc; \
    if(GK){DMA_K((t)+3,sl_cur);} if(GV){DMA_V((t)+1,sl_next);} \
    CMASK(C0,C1,t); \
    { float a=MX3(C0[0],C0[1],C1[0]),b=MX3(C0[2],C0[3],C1[1]); a=MX3(a,C1[2],C1[3]); \
      _Pragma("unroll") for(int r=4;r<16;r+=4){a=MX3(a,C0[r],C0[r+1]);b=MX3(b,C0[r+2],C0[r+3]);a=MX3(a,C1[r],C1[r+1]);b=MX3(b,C1[r+2],C1[r+3]);} \
      float rm=__builtin_fmaxf(a,b); { auto rr=__builtin_amdgcn_permlane32_swap(__float_as_uint(rm),__float_as_uint(rm),false,false); rm=__builtin_fmaxf(__uint_as_float(rr[0]),__uint_as_float(rr[1])); } \
      rm-=mhat;     \
      resc=false; \
      if(__builtin_expect(__any(rm>(float)THRL),0)){ const float dl=__builtin_fmaxf(rm,0.f); mhat+=dl; \
        const float f=__builtin_amdgcn_exp2f(-dl); l_reg*=f; if(hi==0)wsf[r32]=f; resc=true; } \
      _Pragma("unroll") for(int r=0;r<16;++r){C0[r]-=mhat;C1[r]-=mhat;} } \
    SBAR(); \
    GAPB(o[0]=__builtin_amdgcn_mfma_f32_32x32x16_bf16(PAF(0),VFR(0),o[0],0,0,0), C0,0); \
    GAPB(o[1]=__builtin_amdgcn_mfma_f32_32x32x16_bf16(PAF(0),VFR(4),o[1],0,0,0), C0,4); \
    KRD(GL,0); GAPB(o[0]=__builtin_amdgcn_mfma_f32_32x32x16_bf16(PAF(1),VFR(1),o[0],0,0,0), C0,8); \
    KRD(GL,1); GAPB(o[1]=__builtin_amdgcn_mfma_f32_32x32x16_bf16(PAF(1),VFR(5),o[1],0,0,0), C0,12); \
    KRD(GL,2); GAPB(o[0]=__builtin_amdgcn_mfma_f32_32x32x16_bf16(PAF(2),VFR(2),o[0],0,0,0), C1,0); \
    KRD(GL,3); GAPB(o[1]=__builtin_amdgcn_mfma_f32_32x32x16_bf16(PAF(2),VFR(6),o[1],0,0,0), C1,4); \
    GAPB(o[0]=__builtin_amdgcn_mfma_f32_32x32x16_bf16(PAF(3),VFR(3),o[0],0,0,0), C1,8); \
    GAPB(o[1]=__builtin_amdgcn_mfma_f32_32x32x16_bf16(PAF(3),VFR(7),o[1],0,0,0), C1,12); \
      \
    { const lds_cptr vq_=vp_+(LDS_V1-LDS_V); \
      _Pragma("unroll") for(int i_=0;i_<8;++i_){ vlo[i_]=vtr(vq_+((i_>>2)*4096+(i_&3)*1024)); vhi[i_]=vtr(vq_+((i_>>2)*4096+(i_&3)*1024+512)); } \
      SBAR(); \
      o[2]=__builtin_amdgcn_mfma_f32_32x32x16_bf16(PAF(0),VFR(0),o[2],0,0,0); o[3]=__builtin_amdgcn_mfma_f32_32x32x16_bf16(PAF(0),VFR(4),o[3],0,0,0); \
      o[2]=__builtin_amdgcn_mfma_f32_32x32x16_bf16(PAF(1),VFR(1),o[2],0,0,0); o[3]=__builtin_amdgcn_mfma_f32_32x32x16_bf16(PAF(1),VFR(5),o[3],0,0,0); \
      o[2]=__builtin_amdgcn_mfma_f32_32x32x16_bf16(PAF(2),VFR(2),o[2],0,0,0); o[3]=__builtin_amdgcn_mfma_f32_32x32x16_bf16(PAF(2),VFR(6),o[3],0,0,0); \
      o[2]=__builtin_amdgcn_mfma_f32_32x32x16_bf16(PAF(3),VFR(3),o[2],0,0,0); o[3]=__builtin_amdgcn_mfma_f32_32x32x16_bf16(PAF(3),VFR(7),o[3],0,0,0); SBAR(); } \
    }while(0)
  int t=1;
  #undef CMASK
  #define CMASK(P0,P1,t) do{}while(0)
  for(;t+5<NT;t+=2){
    STEP(pB0,pB1,pA0,pA1,t,true,true,true);     WAIT_BAR(3); RESC(); ROT();
    STEP(pA0,pA1,pB0,pB1,t+1,true,true,true);   WAIT_BAR(3); RESC(); ROT();
  }
  #undef CMASK
  #define CMASK(P0,P1,t) do{}while(0)
  #define ENDW(tt) do{ if((tt)+3<NT){WAIT_BAR(3);} else if((tt)+2<NT){WAIT_BAR(2);} else {WAIT_BAR(0);} }while(0)
  for(;t+1<NT;t+=2){
    STEP(pB0,pB1,pA0,pA1,t,(t+3<NT),(t+1<NT),(t+1<NT));       ENDW(t);   RESC(); ROT();
    STEP(pA0,pA1,pB0,pB1,t+1,(t+4<NT),(t+2<NT),(t+2<NT));     ENDW(t+1); RESC(); ROT();
  }
  STEP(pB0,pB1,pA0,pA1,NT-1,false,false,false); RESC();
  { float sacc=pB0[0]+pB0[1]; _Pragma("unroll") for(int r=2;r<16;++r)sacc+=pB0[r]; _Pragma("unroll") for(int r=0;r<16;++r)sacc+=pB1[r]; l_reg+=sacc;
    pw0=(u32x4){PKW(pB0,0),PKW(pB0,2),PKW(pB0,4),PKW(pB0,6)};pw1=(u32x4){PKW(pB0,8),PKW(pB0,10),PKW(pB0,12),PKW(pB0,14)};pw2=(u32x4){PKW(pB1,0),PKW(pB1,2),PKW(pB1,4),PKW(pB1,6)};pw3=(u32x4){PKW(pB1,8),PKW(pB1,10),PKW(pB1,12),PKW(pB1,14)};
    SBAR(); pv(o,vb0+sl_cur,PAF(0),PAF(1),PAF(2),PAF(3)); pv(o+2,vb0+(LDS_V1-LDS_V)+sl_cur,PAF(0),PAF(1),PAF(2),PAF(3)); }
  #undef PKW
  #undef PAF
  #undef VFR
  #undef PIN
  #undef MX3
  #undef GAPA
  #undef GAPB
  #undef EX
  #undef VRD
  #undef KRD
  #undef STEP
  #undef ENDW
  {auto rr=__builtin_amdgcn_permlane32_swap(__float_as_uint(l_reg),__float_as_uint(l_reg),false,false);l_reg=__uint_as_float(rr[0])+__uint_as_float(rr[1]);}
  if(hi==0)wsf[32+r32]=l_reg;asm volatile("s_waitcnt lgkmcnt(0)":::"memory");
  float rli[16];
  #pragma unroll
  for(int r=0;r<16;++r)rli[r]=__builtin_amdgcn_rcpf(wsf[32+crow(r,hi)]);
  bf16*Ow=Oblk+(long)(wid*QBLK)*OP;
  { bf16*stg=(bf16*)(shm+LDS_OST)+wid*2048;
    #pragma unroll
    for(int half=0;half<2;++half){
      #pragma unroll
      for(int r=0;r<16;++r){const int orow=crow(r,hi);
        #pragma unroll
        for(int d0=0;d0<2;++d0)stg[orow*64+d0*32+r32]=__float2bfloat16(o[2*half+d0][r]*rli[r]);}
      asm volatile("s_waitcnt lgkmcnt(0)":::"memory");
      #pragma unroll
      for(int i=0;i<4;++i){const int row=i*8+(lane>>3),ch=lane&7; const u32x4 v=*(const u32x4*)(stg+row*64+ch*8); ATTN_STORE16(Ow+(long)row*OP+half*64+ch*8,v);}
      asm volatile("s_waitcnt lgkmcnt(0)":::"memory"); } }
  asm volatile("s_waitcnt lgkmcnt(0)\n\ts_barrier":::"memory");
  #undef DMA_K
  #undef DMA_V
  #undef CMASK
  #undef START
  #undef RESC
  #undef ROT
}
constexpr int ATTN_LDS_BYTES=LDS_BYTES;
#undef SBAR
#undef WAIT_BAR
}


#define GAS __attribute__((address_space(1)))
#define LAS __attribute__((address_space(3)))
typedef unsigned short bf16;
typedef unsigned v4u __attribute__((ext_vector_type(4)));
typedef unsigned v2u __attribute__((ext_vector_type(2)));
typedef float f32x4 __attribute__((ext_vector_type(4)));
typedef short bf16x8 __attribute__((ext_vector_type(8)));
typedef GAS unsigned gu32;

constexpr int NWAVES = 8, NTHR = 512;
constexpr int DM = 1024, NB = 4, SEQ = 8192, NTOK = NB * SEQ, CTX = 256, NCTX = NB * CTX, DFF = 2816, NKV = SEQ + CTX;
constexpr int DHY = 512, NIN = 3072, NUP = 2 * DFF;
constexpr float EPS = 1e-6f;
constexpr int SLAB_TILES = 133;
constexpr size_t MiB = 1u << 20;
constexpr size_t WS_CTL = 0, WS_STAT = 1 * MiB, WS_MOD = 2 * MiB, WS_CMOD = WS_MOD + 256 * 1024, WS_ROPE = WS_CMOD + 16 * 1024, WS_H2 = 3 * MiB;
constexpr size_t WS_WIN = 8 * MiB, WS_WOUT = 14 * MiB, WS_WUP0 = 16 * MiB, WS_WUP1 = 27 * MiB, WS_WDN0 = 38 * MiB, WS_WDN1 = 44 * MiB, WS_WSIN = 50 * MiB, WS_WSOUT = 54 * MiB, WS_W3 = 56 * MiB, WS_WS = 57 * MiB;
constexpr size_t WS_ACT = 58 * MiB, WS_HC = 124 * MiB, WS_R = 126 * MiB, WS_HY = 158 * MiB, WS_Q = 254 * MiB, WS_K = 286 * MiB, WS_V = 320 * MiB, WS_O = 354 * MiB, WS_YAT = 418 * MiB, WS_END = 450 * MiB;
constexpr size_t WS_HID = 158 * MiB, WS_SU = 158 * MiB, WS_SV = 222 * MiB;
constexpr size_t WS_RS = WS_STAT + 256 * 1024;
constexpr size_t WS_SHW = WS_MOD + 512 * 1024;
constexpr size_t WS_ACT2 = 354 * MiB;
static_assert(WS_ACT + (size_t)(NTOK + 301) * DM * 2 <= WS_HC && WS_HID + (size_t)NTOK * DFF * 2 <= WS_O, "ws map");
constexpr int LDS_BYTES = 147456, RING_BYTES = 131072, MISC_OFF = LDS_BYTES - 256;

#define RLX_AGENT __ATOMIC_RELAXED, __HIP_MEMORY_SCOPE_AGENT
#define LDS_WAIT() asm volatile("s_waitcnt lgkmcnt(0)" ::: "memory")
typedef float f32x2_c __attribute__((ext_vector_type(2))); typedef __bf16 bf16x2_c __attribute__((ext_vector_type(2)));
__device__ __forceinline__ unsigned pk2(float lo, float hi) { f32x2_c v = {lo, hi}; bf16x2_c b = __builtin_convertvector(v, bf16x2_c); return __builtin_bit_cast(unsigned, b); }
__device__ __forceinline__ unsigned f2bf(float f) { return pk2(f, 0.f) & 0xffffu; }
__device__ __forceinline__ float bf2f(unsigned h) { return __builtin_bit_cast(float, h << 16); }
__device__ __forceinline__ float bflo(unsigned w) { return __builtin_bit_cast(float, w << 16); }
__device__ __forceinline__ float bfhi(unsigned w) { return __builtin_bit_cast(float, w & 0xffff0000u); }
__device__ __forceinline__ float wave_sum(float v) {
#pragma unroll
    for (int o = 1; o < 64; o <<= 1) v += __shfl_xor(v, o);
    return v;
}
#ifndef USE_DPP
#define USE_DPP 1
#endif
__device__ __forceinline__ float rot_prev(float v) {
#if USE_DPP
    return __builtin_bit_cast(float, __builtin_amdgcn_update_dpp(0, __builtin_bit_cast(int, v), 0x121, 0xf, 0xf, false));
#else
    const int l = threadIdx.x & 63; return __shfl(v, (l & 48) | ((l - 1) & 15));
#endif
}
__device__ __forceinline__ float rot_next(float v) {
#if USE_DPP
    return __builtin_bit_cast(float, __builtin_amdgcn_update_dpp(0, __builtin_bit_cast(int, v), 0x12F, 0xf, 0xf, false));
#else
    const int l = threadIdx.x & 63; return __shfl(v, (l & 48) | ((l + 1) & 15));
#endif
}
__device__ __forceinline__ f32x4 rot_prev4(f32x4 v) { return (f32x4){rot_prev(v[0]), rot_prev(v[1]), rot_prev(v[2]), rot_prev(v[3])}; }
__device__ __forceinline__ f32x4 rot_next4(f32x4 v) { return (f32x4){rot_next(v[0]), rot_next(v[1]), rot_next(v[2]), rot_next(v[3])}; }

namespace epi {
using pg8::Unit; using pg8::bf16_t;
typedef float f32x4 __attribute__((ext_vector_type(4)));

struct EpiInProj {
    static constexpr bool PERM = false, AFTER_DRAIN = false;
    bf16_t* HY; bf16_t* Q; bf16_t* Kb; bf16_t* Vb; const float* cw; const float* cb; const float* rope;
    __device__ __forceinline__ void operator()(const f32x4 (&acc)[2][2][4][2], const Unit& u, int wr, int wc, int fr_, int fq_) const {
        const int l_ = lane_fresh(), fr = l_ & 15, fq = l_ >> 4; (void)fr_; (void)fq_;
        if (u.pn < 6) {
#pragma unroll
            for (int ai = 0; ai < 2; ++ai) {
                const int gbase = 248 * u.pm + 62 * (2 * ai + wr) - 1;
#pragma unroll
                for (int bj = 0; bj < 2; ++bj)
#pragma unroll
                    for (int n = 0; n < 2; ++n) {
                        const int col = 256 * u.pn + 128 * bj + 32 * wc + 16 * n + 4 * fq;
                        const f32x4 w0 = *(const f32x4*)(cw + col), w1 = *(const f32x4*)(cw + 1536 + col), w2 = *(const f32x4*)(cw + 3072 + col), bb = *(const f32x4*)(cb + col);
                        f32x4 rp_prev = (f32x4){0.f, 0.f, 0.f, 0.f}, rn_cur = rot_next4(acc[ai][bj][0][n]);
#pragma unroll
                        for (int m = 0; m < 4; ++m) {
                            const int j = 16 * m + fr, g = gbase + j, t = g & (SEQ - 1), b = g >> 13;
                            const f32x4 rp_cur = rot_prev4(acc[ai][bj][m][n]);
                            const f32x4 rn_next = (m < 3) ? rot_next4(acc[ai][bj][m < 3 ? m + 1 : 3][n]) : rn_cur;
                            f32x4 p = (fr == 0) ? rp_prev : rp_cur;
                            f32x4 q = (fr == 15) ? rn_next : rn_cur;
                            rp_prev = rp_cur; rn_cur = rn_next;
                            if (t == 0) p = (f32x4){0.f, 0.f, 0.f, 0.f};
                            if (t == SEQ - 1) q = (f32x4){0.f, 0.f, 0.f, 0.f};
                            const f32x4 o = w0 * p + w1 * acc[ai][bj][m][n] + w2 * q + bb;
                            if (j >= 1 && j <= 62 && g < NTOK) {
                                bf16_t* dst = HY + ((size_t)(b * 1536 + col) * SEQ + t);
                                dst[0] = (bf16_t)f2bf(o[0]); dst[SEQ] = (bf16_t)f2bf(o[1]); dst[2 * SEQ] = (bf16_t)f2bf(o[2]); dst[3 * SEQ] = (bf16_t)f2bf(o[3]);
                            }
                        }
                        asm volatile("" ::: "memory");
                    }
            }
        } else if (u.pn < 10) {
            const bool isq = u.pn < 8;
            const float sc = isq ? attn_body::C2 : 1.0f;
#pragma unroll
            for (int ai = 0; ai < 2; ++ai) {
                const int gbase = 248 * u.pm + 62 * (2 * ai + wr) - 1;
#pragma unroll
                for (int m = 0; m < 4; ++m) {
                    const int j = 16 * m + fr, g = gbase + j, t = g & (SEQ - 1), b = g >> 13;
                    const bool ok = (j >= 1 && j <= 62 && g < NTOK);
                    const int pos = (wc & 1) ? (t & 63) : (t >> 6);
                    const float* rp = rope + (size_t)(pos * 16 + 4 * fq) * 2;
                    const f32x4 cs0 = *(const f32x4*)rp, cs1 = *(const f32x4*)(rp + 4);
                    const f32x4 cc = (f32x4){cs0[0], cs0[2], cs1[0], cs1[2]}, ss = (f32x4){cs0[1], cs0[3], cs1[1], cs1[3]};
#pragma unroll
                    for (int bj = 0; bj < 2; ++bj) {
                        const f32x4 x1 = acc[ai][bj][m][0], x2 = acc[ai][bj][m][1];
                        const f32x4 o1 = (x1 * cc - x2 * ss) * sc, o2 = (x1 * ss + x2 * cc) * sc;
                        const int col = 256 * (u.pn - (isq ? 6 : 8)) + 128 * bj + 32 * wc + 4 * fq;
                        if (ok) {
                            bf16_t* dst = isq ? (Q + (size_t)g * 512 + col) : (Kb + ((size_t)b * NKV + CTX + t) * 512 + col);
                            *(v2u*)dst = (v2u){pk2(o1[0], o1[1]), pk2(o1[2], o1[3])};
                            *(v2u*)(dst + 16) = (v2u){pk2(o2[0], o2[1]), pk2(o2[2], o2[3])};
                        }
                    }
                    asm volatile("" ::: "memory");
                }
            }
        } else {
#pragma unroll
            for (int ai = 0; ai < 2; ++ai) {
                const int gbase = 248 * u.pm + 62 * (2 * ai + wr) - 1;
#pragma unroll
                for (int m = 0; m < 4; ++m) {
                    const int j = 16 * m + fr, g = gbase + j, t = g & (SEQ - 1), b = g >> 13;
                    if (j >= 1 && j <= 62 && g < NTOK) {
#pragma unroll
                        for (int bj = 0; bj < 2; ++bj)
#pragma unroll
                            for (int n = 0; n < 2; ++n) {
                                const int col = 256 * (u.pn - 10) + 128 * bj + 32 * wc + 16 * n + 4 * fq;
                                const f32x4 v = acc[ai][bj][m][n];
                                *(v2u*)(Vb + ((size_t)b * NKV + CTX + t) * 512 + col) = (v2u){pk2(v[0], v[1]), pk2(v[2], v[3])};
                            }
                    }
                }
            }
        }
    }
};

struct EpiCtxKV {
    static constexpr bool PERM = false, AFTER_DRAIN = false;
    bf16_t* Kb; bf16_t* Vb;
    __device__ __forceinline__ void operator()(const f32x4 (&acc)[2][2][4][2], const Unit& u, int wr, int wc, int fr_, int fq_) const {
        const int l_ = lane_fresh(), fr = l_ & 15, fq = l_ >> 4; (void)fr_; (void)fq_;
#pragma unroll
        for (int ai = 0; ai < 2; ++ai)
#pragma unroll
            for (int m = 0; m < 4; ++m) {
                const int row = 256 * u.pm + 128 * ai + 64 * wr + 16 * m + fr, b = row >> 8, tc = row & 255;
#pragma unroll
                for (int bj = 0; bj < 2; ++bj)
#pragma unroll
                    for (int n = 0; n < 2; ++n) {
                        const int col = 256 * u.pn + 128 * bj + 32 * wc + 16 * n + 4 * fq;
                        const f32x4 v = acc[ai][bj][m][n];
                        bf16_t* dst = (col < 512) ? (Kb + ((size_t)b * NKV + tc) * 512 + col) : (Vb + ((size_t)b * NKV + tc) * 512 + (col - 512));
                        *(v2u*)dst = (v2u){pk2(v[0], v[1]), pk2(v[2], v[3])};
                    }
            }
    }
};

struct EpiResid {
    static constexpr bool PERM = false, AFTER_DRAIN = false;
    const float* base; float* out; const float* gate;
    bf16_t* nextA; const float* gain; const float* scale; float* rs;
    __device__ __forceinline__ void operator()(const f32x4 (&acc)[2][2][4][2], const Unit& u, int wr, int wc, int fr_, int fq_) const {
        const int l_ = lane_fresh(), fr = l_ & 15, fq = l_ >> 4; (void)fr_; (void)fq_;
        const int b = u.pm >> 5;
#pragma unroll
        for (int ai = 0; ai < 2; ++ai)
#pragma unroll
            for (int m = 0; m < 4; ++m) {
                const int row = 256 * u.pm + 128 * ai + 64 * wr + 16 * m + fr;
                float ss = 0.f;
#pragma unroll
                for (int bj = 0; bj < 2; ++bj)
#pragma unroll
                    for (int n = 0; n < 2; ++n) {
                        const int col = 256 * u.pn + 128 * bj + 32 * wc + 16 * n + 4 * fq;
                        const f32x4 gt = *(const f32x4*)(gate + b * 6144 + col), bs = *(const f32x4*)(base + (size_t)row * DM + col);
                        const f32x4 o = bs + gt * acc[ai][bj][m][n];
                        *(f32x4*)(out + (size_t)row * DM + col) = o;
                        if (nextA) {
                            const f32x4 gv = *(const f32x4*)(gain + col) * (*(const f32x4*)(scale + b * 6144 + col) + 1.0f), a = o * gv;
                            *(v2u*)(nextA + (size_t)row * DM + col) = (v2u){pk2(a[0], a[1]), pk2(a[2], a[3])};
                            ss += (o[0] * o[0] + o[1] * o[1]) + (o[2] * o[2] + o[3] * o[3]);
                        }
                    }
                if (nextA) { ss += __shfl_xor(ss, 16); ss += __shfl_xor(ss, 32); if (fq == 0) atomicAdd(rs + row, ss); }
            }
    }
};

struct EpiFfnUp {
    static constexpr bool PERM = true, AFTER_DRAIN = false;
    bf16_t* H; const float* cw; const float* cb;
    __device__ __forceinline__ void operator()(const f32x4 (&acc)[2][2][4][2], const Unit& u, int wr, int wc, int fr_, int fq_) const {
        const int l_ = lane_fresh(), fr = l_ & 15, fq = l_ >> 4; (void)fr_; (void)fq_;
#pragma unroll
        for (int ai = 0; ai < 2; ++ai) {
            const int gbase = 248 * u.pm + 62 * (2 * ai + wr) - 1;
#pragma unroll
            for (int n = 0; n < 2; ++n) {
                const int ch = 128 * u.pn + 32 * wc + 8 * fq + 4 * n;
                const f32x4 g0 = *(const f32x4*)(cw + ch), g1 = *(const f32x4*)(cw + NUP + ch), g2 = *(const f32x4*)(cw + 2 * NUP + ch), gb = *(const f32x4*)(cb + ch);
                const f32x4 u0 = *(const f32x4*)(cw + DFF + ch), u1 = *(const f32x4*)(cw + NUP + DFF + ch), u2 = *(const f32x4*)(cw + 2 * NUP + DFF + ch), ub = *(const f32x4*)(cb + DFF + ch);
                const f32x4 z = (f32x4){0.f, 0.f, 0.f, 0.f};
                f32x4 gp_prev = z, up_prev = z, gn_cur = rot_next4(acc[ai][0][0][n]), un_cur = rot_next4(acc[ai][1][0][n]);
#pragma unroll
                for (int m = 0; m < 4; ++m) {
                    const int j = 16 * m + fr, g = gbase + j, t = g & (SEQ - 1);
                    const f32x4 gp_cur = rot_prev4(acc[ai][0][m][n]), up_cur = rot_prev4(acc[ai][1][m][n]);
                    const f32x4 gn_next = (m < 3) ? rot_next4(acc[ai][0][m < 3 ? m + 1 : 3][n]) : gn_cur, un_next = (m < 3) ? rot_next4(acc[ai][1][m < 3 ? m + 1 : 3][n]) : un_cur;
                    f32x4 pg = (fr == 0) ? gp_prev : gp_cur, ng = (fr == 15) ? gn_next : gn_cur;
                    f32x4 pu = (fr == 0) ? up_prev : up_cur, nu = (fr == 15) ? un_next : un_cur;
                    gp_prev = gp_cur; up_prev = up_cur; gn_cur = gn_next; un_cur = un_next;
                    if (t == 0) { pg = z; pu = z; }
                    if (t == SEQ - 1) { ng = z; nu = z; }
                    const f32x4 gc = g0 * pg + g1 * acc[ai][0][m][n] + g2 * ng + gb;
                    const f32x4 uc = u0 * pu + u1 * acc[ai][1][m][n] + u2 * nu + ub;
                    f32x4 h;
#pragma unroll
                    for (int e = 0; e < 4; ++e) h[e] = gc[e] * __builtin_amdgcn_rcpf(1.0f + __builtin_amdgcn_exp2f(-1.4426950408889634f * gc[e])) * uc[e];
                    if (j >= 1 && j <= 62 && g < NTOK) *(v2u*)(H + (size_t)g * DFF + ch) = (v2u){pk2(h[0], h[1]), pk2(h[2], h[3])};
                }
                asm volatile("" ::: "memory");
            }
        }
    }
};

struct EpiSguIn {
    static constexpr bool PERM = true, AFTER_DRAIN = false;
    bf16_t* U; bf16_t* V; const float* bias; float* stat; const float* rs; const float* shw;
    __device__ __forceinline__ void operator()(const f32x4 (&acc)[2][2][4][2], const Unit& u, int wr, int wc, int fr_, int fq_) const {
        const int l_ = lane_fresh(), fr = l_ & 15, fq = l_ >> 4; (void)fr_; (void)fq_;
        const bool isv = u.pn >= 4;
#pragma unroll
        for (int ai = 0; ai < 2; ++ai)
#pragma unroll
            for (int m = 0; m < 4; ++m) {
                const int row = 256 * u.pm + 128 * ai + 64 * wr + 16 * m + fr;
                float s = 0.f, s2 = 0.f;
                const float rstd = 1.0f / sqrtf(rs[row] * (1.0f / DM) + EPS); const int b = row >> 13;
#pragma unroll
                for (int bj = 0; bj < 2; ++bj) {
                    const int col = 256 * u.pn + 128 * bj + 32 * wc + 8 * fq;
                    const f32x4 b0 = *(const f32x4*)(bias + col) + *(const f32x4*)(shw + b * NUP + col), b1 = *(const f32x4*)(bias + col + 4) + *(const f32x4*)(shw + b * NUP + col + 4);
                    const f32x4 v0 = acc[ai][bj][m][0] * rstd + b0, v1 = acc[ai][bj][m][1] * rstd + b1;
                    const pg8::f32x2 a = pg8::gelu_pk((pg8::f32x2){v0[0], v0[1]}), b = pg8::gelu_pk((pg8::f32x2){v0[2], v0[3]}), c = pg8::gelu_pk((pg8::f32x2){v1[0], v1[1]}), d = pg8::gelu_pk((pg8::f32x2){v1[2], v1[3]});
                    s += (a.x + a.y) + (b.x + b.y) + (c.x + c.y) + (d.x + d.y);
                    s2 += (a.x * a.x + a.y * a.y) + (b.x * b.x + b.y * b.y) + (c.x * c.x + c.y * c.y) + (d.x * d.x + d.y * d.y);
                    bf16_t* dst = (isv ? V : U) + (size_t)row * DM + (col & 1023);
                    *(v4u*)dst = (v4u){pk2(a.x, a.y), pk2(b.x, b.y), pk2(c.x, c.y), pk2(d.x, d.y)};
                }
                if (isv) {
                    s += __shfl_xor(s, 16); s += __shfl_xor(s, 32); s2 += __shfl_xor(s2, 16); s2 += __shfl_xor(s2, 32);
                    if (fq == 0) { atomicAdd(stat + 2 * row, s); atomicAdd(stat + 2 * row + 1, s2); }
                }
            }
    }
};
}

#define VM_WAIT() asm volatile("s_waitcnt vmcnt(0)" ::: "memory")
#define XB_TMO      128
#define XB_XCNT(j)  (256  + 64 * (j))
#define XB_XSUB(j)  (1280 + 64 * (j))
#define XB_XGEN(j)  (2304 + 64 * (j))
#define XB_TOP      3328
#define XB_TOPGEN   3392
#define XCD_BAR_WORDS 3456
#define XB_SPIN_CAP (1u << 18)

__device__ __forceinline__ unsigned xb_ld(unsigned* p)              { return __hip_atomic_load(p, __ATOMIC_RELAXED, __HIP_MEMORY_SCOPE_AGENT); }
__device__ __forceinline__ unsigned xb_add(unsigned* p, unsigned v) { return __hip_atomic_fetch_add(p, v, __ATOMIC_RELAXED, __HIP_MEMORY_SCOPE_AGENT); }
__device__ __forceinline__ unsigned xb_xcc_id() { return (unsigned)__builtin_amdgcn_s_getreg((3 << 11) | 20) & 0xFu; }
#define XB_SPIN(cond, bar) do { unsigned _sp = 0; while (cond) { __builtin_amdgcn_s_sleep(1); \
    if ((++_sp & 255u) == 0u) { if (xb_ld(&(bar)[XB_TMO])) break; if (_sp > XB_SPIN_CAP) { atomicAdd(&(bar)[XB_TMO], 1u); break; } } } } while (0)

struct XcdBarrier {
    unsigned* bar; unsigned x; int wave;
    volatile LAS unsigned* st;
};

__device__ __forceinline__ XcdBarrier xcd_barrier_post(unsigned* bar, volatile LAS unsigned* st, int wave) {
    XcdBarrier b; b.bar = bar; b.x = xb_xcc_id(); b.st = st; b.wave = wave;
    if (wave == 0 && lane_fresh() == 0) (void)xb_add(&bar[XB_XCNT(b.x)], 1u);
    return b;
}
__device__ __forceinline__ void xcd_barrier_complete(unsigned* bar, unsigned x, unsigned& nloc, unsigned& nx) {
    const unsigned G = gridDim.x * gridDim.y * gridDim.z;
    unsigned sum, cnt, mine, sp = 0u;
    for (;;) {
        sum = 0u; cnt = 0u; mine = 0u;
#pragma unroll
        for (unsigned j = 0; j < 16; ++j) { const unsigned c = xb_ld(&bar[XB_XCNT(j)]); sum += c; cnt += (c > 0u) ? 1u : 0u; mine = (j == x) ? c : mine; }
        if (sum == G) break;
        __builtin_amdgcn_s_sleep(1);
        if ((++sp & 255u) == 0u) { if (xb_ld(&bar[XB_TMO])) break; if (sp > XB_SPIN_CAP) { atomicAdd(&bar[XB_TMO], 1u); break; } }
    }
    nloc = mine > 0u ? mine : 1u; nx = cnt > 0u ? cnt : 1u;
}

__device__ __forceinline__ void xcd_barrier(const XcdBarrier& b) {
    asm volatile("s_waitcnt vmcnt(0)" ::: "memory");
    __syncthreads();
    if (b.wave == 0 && lane_fresh() == 0) {
        unsigned* bar = b.bar;
        __builtin_amdgcn_s_waitcnt(0);
        unsigned nloc = b.st[0], nx = b.st[1];
        if (nloc == 0u) { xcd_barrier_complete(bar, b.x, nloc, nx); b.st[0] = nloc; b.st[1] = nx; }
        const unsigned old = xb_add(&bar[XB_XSUB(b.x)], 1u);
        const unsigned gen = old / nloc;
        if (old + 1u == (gen + 1u) * nloc) {
            __builtin_amdgcn_fence(__ATOMIC_RELEASE, "agent");
            asm volatile("s_waitcnt vmcnt(0)" ::: "memory");
            const unsigned og = xb_add(&bar[XB_TOP], 1u);
            const unsigned tg = og / nx;
            if (og + 1u == (tg + 1u) * nx) xb_add(&bar[XB_TOPGEN], 1u);
            else XB_SPIN(xb_ld(&bar[XB_TOPGEN]) == tg, bar);
            __builtin_amdgcn_fence(__ATOMIC_ACQUIRE, "agent");
            xb_add(&bar[XB_XGEN(b.x)], 1u);
            asm volatile("s_waitcnt vmcnt(0)" ::: "memory");
        } else {
            XB_SPIN(xb_ld(&bar[XB_XGEN(b.x)]) == gen, bar);
            __builtin_amdgcn_fence(__ATOMIC_ACQUIRE, "agent");
            asm volatile("s_waitcnt vmcnt(0)" ::: "memory");
        }
    }
    __syncthreads();
}

typedef const float* fptr_t;
typedef __attribute__((address_space(4))) const fptr_t* ktab;
struct Ctx {
    LAS unsigned char* lds; unsigned char* ldsg; int wave, G, bx;
    ktab kin; float* out; unsigned char* ws;
};
__device__ __forceinline__ const float* ld_in(ktab t, int k) { asm volatile("" : "+s"(t)); return t[k]; }
#define INP(k) ld_in(C.kin, (k))
#define WSP(T, off) ((T*)(C.ws + (off)))

__device__ __forceinline__ void p0_transpose_item(const float* W, int ldw, int k0, int n0, bf16* WT, int ldt, int drow0, LAS float* scr, int lane) {
#pragma unroll 8
    for (int i = 0; i < 32; ++i) { const int kk = 2 * i + (lane >> 5); scr[kk * 33 + (lane & 31)] = W[(size_t)(k0 + kk) * ldw + n0 + (lane & 31)]; }
    LDS_WAIT(); asm volatile("" ::: "memory");
    const int c = lane & 7;
#pragma unroll
    for (int j = 0; j < 4; ++j) { const int n = (lane >> 3) + 8 * j; const LAS float* s = scr + (8 * c) * 33 + n;
        v4u o; o.x = pk2(s[0 * 33], s[1 * 33]); o.y = pk2(s[2 * 33], s[3 * 33]); o.z = pk2(s[4 * 33], s[5 * 33]); o.w = pk2(s[6 * 33], s[7 * 33]);
        *(v4u*)(WT + (size_t)(drow0 + n) * ldt + k0 + 8 * c) = o; }
    LDS_WAIT(); asm volatile("" ::: "memory");
}
__device__ __forceinline__ void p0_mat(const float* W, int K, int N, bf16* WT, int ldt, int item, bool ffn_perm, LAS float* scr, int lane) {
    const int nblk = N / 32, kb = item / nblk, nb = item % nblk, n0 = 32 * nb;
    int drow0 = n0;
    if (ffn_perm) { const int s = n0 / DFF, ch = n0 % DFF; drow0 = 256 * (ch >> 7) + 128 * s + (ch & 127); }
    p0_transpose_item(W, N, 64 * kb, n0, WT, ldt, drow0, scr, lane);
}
__device__ __forceinline__ float silu_f(float v) { return v / (1.0f + __expf(-v)); }

__device__ __forceinline__ void phase_p0(Ctx& C) {
    const int C_lane = lane_fresh(), C_tid = C.wave * 64 + C_lane;
    LAS float* scr = (LAS float*)(C.lds + C.wave * 16384);
    const int gw = C.bx * NWAVES + C.wave, NGW = C.G * NWAVES, lane = C_lane;
    const int gt = C.bx * NTHR + C_tid, NGT = C.G * NTHR;
    constexpr int I_IN = 16 * 96, I_OUT = 16 * 32, I_UP = 16 * 176, I_DN = 44 * 32, I_SIN = 16 * 64, I_SOUT = 16 * 32;
    constexpr int NITEMS = I_IN + I_OUT + 2 * I_UP + 2 * I_DN + I_SIN + I_SOUT;
    for (int it = gw; it < NITEMS; it += NGW) {
        int r = it;
        if (r < I_IN) { p0_mat(INP(12), 1024, NIN, WSP(bf16, WS_WIN), 1024, r, false, scr, lane); continue; } r -= I_IN;
        if (r < I_OUT) { p0_mat(INP(24), 1024, 1024, WSP(bf16, WS_WOUT), 1024, r, false, scr, lane); continue; } r -= I_OUT;
        if (r < I_UP) { p0_mat(INP(8), 1024, NUP, WSP(bf16, WS_WUP0), 1024, r, true, scr, lane); continue; } r -= I_UP;
        if (r < I_UP) { p0_mat(INP(8) + (size_t)1024 * NUP, 1024, NUP, WSP(bf16, WS_WUP1), 1024, r, true, scr, lane); continue; } r -= I_UP;
        if (r < I_DN) { p0_mat(INP(11), DFF, 1024, WSP(bf16, WS_WDN0), DFF, r, false, scr, lane); continue; } r -= I_DN;
        if (r < I_DN) { p0_mat(INP(11) + (size_t)DFF * 1024, DFF, 1024, WSP(bf16, WS_WDN1), DFF, r, false, scr, lane); continue; } r -= I_DN;
        if (r < I_SIN) { p0_mat(INP(25), 1024, 2048, WSP(bf16, WS_WSIN), 1024, r, false, scr, lane); continue; } r -= I_SIN;
        p0_mat(INP(31), 1024, 1024, WSP(bf16, WS_WSOUT), 1024, r, false, scr, lane);
    }
    for (int i = gt; i < 8 * 128 * 128 / 8; i += NGT) { const float* s = INP(29) + (size_t)i * 8; const f32x4 a = *(const f32x4*)s, b = *(const f32x4*)(s + 4);
        *(v4u*)(WSP(bf16, WS_WS) + (size_t)i * 8) = (v4u){pk2(a[0], a[1]), pk2(a[2], a[3]), pk2(b[0], b[1]), pk2(b[2], b[3])}; }
    for (int i = gt; i < NTOK * 5 / 4; i += NGT) *(f32x4*)(WSP(float, WS_STAT) + (size_t)i * 4) = (f32x4){0.f, 0.f, 0.f, 0.f};
    for (int i = gt; i < 128 * 16; i += NGT) { const int pos = i >> 4, k = i & 15; const float inv = powf(10000.0f, -(float)k / 16.0f), ang = (float)pos * inv; float sn, cs; sincosf(ang, &sn, &cs);
        WSP(float, WS_ROPE)[2 * i] = cs; WSP(float, WS_ROPE)[2 * i + 1] = sn; }
    {
        const float* w1 = INP(15); const float* b1 = INP(16); const float* fr = INP(17); const float* w2 = INP(18); const float* b2 = INP(19);
        const float f0 = fr[lane], f1 = fr[64 + lane], bb1 = b1[lane], bb2 = b2[lane];
        for (int t = gw; t < SEQ; t += NGW) {
            float z = 0.f;
            if (lane == 0) z = (float)t * (1.0f / 8191.0f);
            else if (lane <= 32) { const int k = (lane - 1) & 15; const float band = 1e-4f + (float)k * ((15.0f - 1e-4f) / 15.0f);
                const float ang = ((6.283185307179586f / 8192.0f) * (float)t) * band; z = (lane <= 16) ? cosf(ang) : -sinf(ang); }
            float a = bb1;
#pragma unroll
            for (int i = 0; i < 33; ++i) a += __shfl(z, i) * w1[i * 64 + lane];
            const float h1 = sinf(f0 * a);
            float a2 = bb2;
#pragma unroll 16
            for (int i = 0; i < 64; ++i) a2 += __shfl(h1, i) * w2[i * 64 + lane];
            const float h2 = sinf(f1 * a2);
            WSP(bf16, WS_H2)[(size_t)lane * SEQ + t] = (bf16)f2bf(h2);
        }
    }
    __syncthreads();
    {
        LAS float* red = (LAS float*)C.lds;
        for (int it = C.bx; it < 2 * 96; it += C.G) {
            const int l = it / 96, cb = it % 96, col = cb * 64 + lane;
            const float* W = INP(4) + (size_t)l * 1024 * 6144;
            float a0 = 0.f, a1 = 0.f, a2 = 0.f, a3 = 0.f, a4 = 0.f;
            const int kbeg = C.wave * 128;
#pragma unroll 4
            for (int k = kbeg; k < kbeg + 128; ++k) {
                const float w = W[(size_t)k * 6144 + col];
                a0 += silu_f(INP(1)[k]) * w; a1 += silu_f(INP(1)[1024 + k]) * w; a2 += silu_f(INP(1)[2048 + k]) * w; a3 += silu_f(INP(1)[3072 + k]) * w; a4 += silu_f(INP(3)[k]) * w;
            }
            red[(C.wave * 5 + 0) * 64 + lane] = a0; red[(C.wave * 5 + 1) * 64 + lane] = a1; red[(C.wave * 5 + 2) * 64 + lane] = a2; red[(C.wave * 5 + 3) * 64 + lane] = a3; red[(C.wave * 5 + 4) * 64 + lane] = a4;
            __syncthreads();
            if (C_tid < 320) { const int v = C_tid >> 6, cc = C_tid & 63; float s = 0.f;
#pragma unroll
                for (int w = 0; w < 8; ++w) s += red[(w * 5 + v) * 64 + cc];
                const int oc = cb * 64 + cc; s += INP(5)[l * 6144 + oc];
                if (v < 4) WSP(float, WS_MOD)[(size_t)(l * 4 + v) * 6144 + oc] = s;
                else if (l == 0 && oc < 2048) WSP(float, WS_CMOD)[oc] = s; }
            __syncthreads();
        }
    }
}

__device__ __forceinline__ void phase_norm_mod(Ctx& C, const float* src, int rows, int rows_per_batch, const float* g, const float* shift, const float* scale, int bstride, bf16* dst) {
    const int C_lane = lane_fresh(), C_tid = C.wave * 64 + C_lane;
    const int gw = C.bx * NWAVES + C.wave, NGW = C.G * NWAVES, lane = C_lane;
    for (int r = gw; r < rows; r += NGW) {
        const f32x4* xr = (const f32x4*)(src + (size_t)r * DM) + lane;
        const int b = r / rows_per_batch;
        f32x4 v[4]; float s = 0.f;
#pragma unroll
        for (int j = 0; j < 4; ++j) { v[j] = xr[64 * j]; s += (v[j][0] * v[j][0] + v[j][1] * v[j][1]) + (v[j][2] * v[j][2] + v[j][3] * v[j][3]); }
        const float rstd = 1.0f / sqrtf(wave_sum(s) * (1.0f / DM) + EPS);
        v2u* o = (v2u*)(dst + (size_t)r * DM) + lane;
#pragma unroll
        for (int j = 0; j < 4; ++j) {
            const int col = 4 * (lane + 64 * j);
            const f32x4 gg = *(const f32x4*)(g + col), sh = *(const f32x4*)(shift + (size_t)b * bstride + col), sc = *(const f32x4*)(scale + (size_t)b * bstride + col);
            const f32x4 y = (v[j] * rstd) * gg * (sc + 1.0f) + sh;
            o[64 * j] = (v2u){pk2(y[0], y[1]), pk2(y[2], y[3])};
        }
    }
}
__device__ __forceinline__ void phase_shw(Ctx& C) {
    const int C_lane = lane_fresh(), C_tid = C.wave * 64 + C_lane;
    const int gw = C.bx * NWAVES + C.wave, NGW = C.G * NWAVES, lane = C_lane;
    const float* MOD = WSP(float, WS_MOD);
    for (int r = gw; r < NUP + 2048 + NUP; r += NGW) {
        int inst, n; const bf16* WT; const float* sh;
        if (r < NUP) { inst = 0; n = r; WT = WSP(bf16, WS_WUP0); sh = MOD + 3072; }
        else if (r < NUP + 2048) { inst = 1; n = r - NUP; WT = WSP(bf16, WS_WSIN); sh = MOD + 4 * 6144; }
        else { inst = 2; n = r - NUP - 2048; WT = WSP(bf16, WS_WUP1); sh = MOD + 4 * 6144 + 3072; }
        float a[4] = {0.f, 0.f, 0.f, 0.f};
#pragma unroll
        for (int h = 0; h < 2; ++h) {
            const v4u wv = *(const v4u*)(WT + (size_t)n * 1024 + 512 * h + 8 * lane);
            const float wf[8] = {bflo(wv.x), bfhi(wv.x), bflo(wv.y), bfhi(wv.y), bflo(wv.z), bfhi(wv.z), bflo(wv.w), bfhi(wv.w)};
#pragma unroll
            for (int b = 0; b < 4; ++b) {
                const f32x4 s0 = *(const f32x4*)(sh + b * 6144 + 512 * h + 8 * lane), s1 = *(const f32x4*)(sh + b * 6144 + 512 * h + 8 * lane + 4);
                a[b] += (s0[0] * wf[0] + s0[1] * wf[1]) + (s0[2] * wf[2] + s0[3] * wf[3]) + (s1[0] * wf[4] + s1[1] * wf[5]) + (s1[2] * wf[6] + s1[3] * wf[7]);
            }
        }
#pragma unroll
        for (int b = 0; b < 4; ++b) { const float s = wave_sum(a[b]); if (lane == 0) WSP(float, WS_SHW)[(size_t)(inst * 4 + b) * NUP + n] = s; }
    }
}
__device__ __forceinline__ void phase_final_norm(Ctx& C, float* x, const float* g) {
    const int C_lane = lane_fresh(), C_tid = C.wave * 64 + C_lane;
    const int gw = C.bx * NWAVES + C.wave, NGW = C.G * NWAVES, lane = C_lane;
    for (int r = gw; r < NTOK; r += NGW) {
        f32x4* xr = (f32x4*)(x + (size_t)r * DM) + lane;
        f32x4 v[4]; float s = 0.f;
#pragma unroll
        for (int j = 0; j < 4; ++j) { v[j] = xr[64 * j]; s += (v[j][0] * v[j][0] + v[j][1] * v[j][1]) + (v[j][2] * v[j][2] + v[j][3] * v[j][3]); }
        const float rstd = 1.0f / sqrtf(wave_sum(s) * (1.0f / DM) + EPS);
#pragma unroll
        for (int j = 0; j < 4; ++j) { const f32x4 gg = *(const f32x4*)(g + 4 * (lane + 64 * j)); xr[64 * j] = (v[j] * rstd) * gg; }
    }
}

constexpr int HY_BSTR = 19264, HY_UL_BYTES = 4 * HY_BSTR, HY_RL_OFF = HY_UL_BYTES, HY_RL_BYTES = 2 * SEQ * 2;
static_assert(HY_RL_OFF + 2 * HY_RL_BYTES <= MISC_OFF && HY_UL_BYTES % 16 == 0, "hyena LDS");
__device__ __forceinline__ unsigned alignbit16(unsigned hi, unsigned lo) { return __builtin_amdgcn_alignbit(hi, lo, 16); }
__device__ __forceinline__ void hyena_make_filters(Ctx& C, int c) {
    const int C_lane = lane_fresh(), C_tid = C.wave * 64 + C_lane;
    LAS unsigned short* RL0 = (LAS unsigned short*)(C.lds + HY_RL_OFF);
    const bf16* H2T = WSP(bf16, WS_H2); const float* w3 = INP(20) + c;
    const int tid = C_tid;
    f32x4 acc[4][4];
#pragma unroll
    for (int i = 0; i < 4; ++i)
#pragma unroll
        for (int j = 0; j < 4; ++j) acc[i][j] = (f32x4){0.f, 0.f, 0.f, 0.f};
#pragma unroll 4
    for (int k = 0; k < 64; ++k) {
        const float w0 = w3[k * 2048], w1 = w3[k * 2048 + 512], w2 = w3[k * 2048 + 1024], w3v = w3[k * 2048 + 1536];
#pragma unroll
        for (int jj = 0; jj < 2; ++jj) {
            const v4u hv = *(const v4u*)(H2T + (size_t)k * SEQ + 8 * (tid + NTHR * jj));
            const f32x4 ha = (f32x4){bflo(hv.x), bfhi(hv.x), bflo(hv.y), bfhi(hv.y)}, hb = (f32x4){bflo(hv.z), bfhi(hv.z), bflo(hv.w), bfhi(hv.w)};
            acc[0][2 * jj] += ha * w0; acc[0][2 * jj + 1] += hb * w0; acc[1][2 * jj] += ha * w1; acc[1][2 * jj + 1] += hb * w1;
            acc[2][2 * jj] += ha * w2; acc[2][2 * jj + 1] += hb * w2; acc[3][2 * jj] += ha * w3v; acc[3][2 * jj + 1] += hb * w3v;
        }
    }
    const float dsc = (3.0701134573253945f + (float)c * ((15.350567286626973f - 3.0701134573253945f) / 511.0f)) * (1.4426950408889634f / 8191.0f);
#pragma unroll
    for (int j = 0; j < 4; ++j)
#pragma unroll
        for (int e = 0; e < 4; ++e) {
            const int t = 8 * (tid + NTHR * (j >> 1)) + 4 * (j & 1) + e; const float win = __builtin_amdgcn_exp2f(-(float)t * dsc) + 0.05f;
            RL0[SEQ - t] = (unsigned short)f2bf(acc[0][j][e] * win); RL0[2 * SEQ + SEQ - t] = (unsigned short)f2bf(acc[2][j][e] * win);
            if (t > 0) { RL0[SEQ + t] = (unsigned short)f2bf(acc[1][j][e] * win); RL0[2 * SEQ + SEQ + t] = (unsigned short)f2bf(acc[3][j][e] * win); }
        }
    if (tid == 0) { RL0[0] = 0; RL0[2 * SEQ] = 0; }
}
__device__ __forceinline__ void hyena_conv(Ctx& C, int o, f32x4 (&acc)[2][8]) {
    const int C_lane = lane_fresh(), C_tid = C.wave * 64 + C_lane;
    const int lane = C_lane, w = C.wave, m = lane & 15, q = lane >> 4;
    const LAS unsigned char* UL = C.lds; const LAS unsigned char* RL = C.lds + HY_RL_OFF + o * HY_RL_BYTES;
#pragma unroll
    for (int g = 0; g < 2; ++g)
#pragma unroll
        for (int a = 0; a < 8; ++a) acc[g][a] = (f32x4){0.f, 0.f, 0.f, 0.f};
    const int cl = m >> 2, bt = m & 3;
    const int dlo = 8 * w - 63;
    const int roff0 = 2 * (SEQ - 128 * dlo - 8 * m + 8 * q), uoff0 = bt * HY_BSTR + (8 * w + cl + 3) * 272 + 16 * q - 272 * dlo;
#define HY_ROFF(i) (roff0 + 64 * ((i) & 3) - 256 * ((i) >> 2))
#define HY_UOFF(i) (uoff0 + 64 * ((i) & 3) - 272 * ((i) >> 2))
#define HY_BUILD(af, lo, hi) do { const unsigned wd[8] = {lo.x, lo.y, lo.z, lo.w, hi.x, hi.y, hi.z, hi.w}; \
        _Pragma("unroll") for (int p = 0; p < 4; ++p) { \
            const v4u ev = (v4u){wd[4 - p], wd[5 - p], wd[6 - p], wd[7 - p]}; \
            const v4u od = (v4u){alignbit16(wd[4 - p], wd[3 - p]), alignbit16(wd[5 - p], wd[4 - p]), alignbit16(wd[6 - p], wd[5 - p]), alignbit16(wd[7 - p], wd[6 - p])}; \
            af[2 * p] = __builtin_bit_cast(bf16x8, ev); af[2 * p + 1] = __builtin_bit_cast(bf16x8, od); } } while (0)
    v4u lo = *(const LAS v4u*)(RL + HY_ROFF(0) - 16), hi = *(const LAS v4u*)(RL + HY_ROFF(0));
    v4u b0 = *(const LAS v4u*)(UL + HY_UOFF(0)), b1 = *(const LAS v4u*)(UL + HY_UOFF(0) + 4 * 272);
    bf16x8 afc[8];
    HY_BUILD(afc, lo, hi);
    lo = *(const LAS v4u*)(RL + HY_ROFF(1) - 16); hi = *(const LAS v4u*)(RL + HY_ROFF(1));
#pragma unroll 1
    for (int it = 0; it < 284; ++it) {
        const int d = dlo + (it >> 2);
        const bool v0 = d <= 8 * w + 3, v1 = d >= 8 * w + 4 - 63;
        const int i1 = it + 1 < 284 ? it + 1 : 283, i2 = it + 2 < 284 ? it + 2 : 283;
        const v4u lo2 = *(const LAS v4u*)(RL + HY_ROFF(i2) - 16), hi2 = *(const LAS v4u*)(RL + HY_ROFF(i2));
        const v4u b0n = *(const LAS v4u*)(UL + HY_UOFF(i1)), b1n = *(const LAS v4u*)(UL + HY_UOFF(i1) + 4 * 272);
        bf16x8 afn[8];
        HY_BUILD(afn, lo, hi);
        if (v0) {
            const bf16x8 bfr = __builtin_bit_cast(bf16x8, b0);
#pragma unroll
            for (int a = 0; a < 8; ++a) acc[0][a] = __builtin_amdgcn_mfma_f32_16x16x32_bf16(afc[a], bfr, acc[0][a], 0, 0, 0);
        }
        if (v1) {
            const bf16x8 bfr = __builtin_bit_cast(bf16x8, b1);
#pragma unroll
            for (int a = 0; a < 8; ++a) acc[1][a] = __builtin_amdgcn_mfma_f32_16x16x32_bf16(afc[a], bfr, acc[1][a], 0, 0, 0);
        }
#pragma unroll
        for (int a = 0; a < 8; ++a) afc[a] = afn[a];
        lo = lo2; hi = hi2; b0 = b0n; b1 = b1n;
    }
#undef HY_ROFF
#undef HY_UOFF
#undef HY_BUILD
}
__device__ __forceinline__ void hyena_item(Ctx& C, int c) {
    const int C_lane = lane_fresh(), C_tid = C.wave * 64 + C_lane;
    const int lane = C_lane, w = C.wave, tid = C_tid;
    LAS unsigned char* UL = C.lds;
    const bf16* HY = WSP(bf16, WS_HY);
    for (int i = tid; i < 4 * 6 * 17; i += NTHR) { const int bt = i / 102, r = i % 102, sl = r / 17, pc = r % 17; const int slot = sl < 3 ? sl : 64 + sl;
        *(LAS v4u*)(UL + bt * HY_BSTR + slot * 272 + pc * 16) = (v4u){0u, 0u, 0u, 0u}; }
#pragma unroll
    for (int i = 0; i < 8; ++i) { const int p = i * NTHR + tid, bt = p >> 10, r = p & 1023, ch = r >> 4, pc = r & 15;
        *(LAS v4u*)(UL + bt * HY_BSTR + (ch + 3) * 272 + pc * 16) = *(const v4u*)(HY + ((size_t)(bt * 1536 + c) * SEQ) + r * 8); }
    hyena_make_filters(C, c);
    __syncthreads();
    f32x4 acc[2][8];
    const int mcol = lane & 15, q = lane >> 4, cl = mcol >> 2, bt = mcol & 3;
#pragma unroll 1
    for (int o = 0; o < 2; ++o) {
        hyena_conv(C, o, acc);
        __syncthreads();
        const float dsk = INP(21)[o * 512 + c];
#pragma unroll
        for (int g = 0; g < 2; ++g) {
            const int chunk = 8 * w + 4 * g + cl, p0 = 128 * chunk + 32 * q;
            LAS unsigned char* zl = UL + bt * HY_BSTR + (chunk + 3) * 272 + 64 * q;
            const bf16* gate = HY + ((size_t)(bt * 1536 + (o + 1) * 512 + c) * SEQ) + p0;
            unsigned short outv[32];
#pragma unroll
            for (int k = 0; k < 4; ++k) {
                const v4u zz = *(LAS v4u*)(zl + 16 * k), gg = *(const v4u*)(gate + 8 * k);
                const unsigned zw[4] = {zz.x, zz.y, zz.z, zz.w}, gw[4] = {gg.x, gg.y, gg.z, gg.w};
#pragma unroll
                for (int e = 0; e < 8; ++e) {
                    const float zv = (e & 1) ? bfhi(zw[e >> 1]) : bflo(zw[e >> 1]), gv = (e & 1) ? bfhi(gw[e >> 1]) : bflo(gw[e >> 1]);
                    outv[8 * k + e] = (unsigned short)f2bf(gv * (acc[g][e][k] + dsk * zv));
                }
            }
#pragma unroll
            for (int k = 0; k < 4; ++k) {
                const v4u ov = (v4u){(unsigned)outv[8 * k] | ((unsigned)outv[8 * k + 1] << 16), (unsigned)outv[8 * k + 2] | ((unsigned)outv[8 * k + 3] << 16),
                                     (unsigned)outv[8 * k + 4] | ((unsigned)outv[8 * k + 5] << 16), (unsigned)outv[8 * k + 6] | ((unsigned)outv[8 * k + 7] << 16)};
                if (o == 0) *(LAS v4u*)(zl + 16 * k) = ov;
                else *(v4u*)(WSP(bf16, WS_YAT) + ((size_t)(bt * 512 + c) * SEQ) + p0 + 8 * k) = ov;
            }
        }
        __syncthreads();
    }
}

__device__ __forceinline__ void phase_hyena(Ctx& C) {
    const int C_lane = lane_fresh(), C_tid = C.wave * 64 + C_lane;
#pragma unroll 1
    for (int c = C.bx; c < DHY; c += C.G) hyena_item(C, c);
}
__device__ __forceinline__ void phase_attn(Ctx& C) {
    const int C_lane = lane_fresh(), C_tid = C.wave * 64 + C_lane;
    const int v = (C.G % 8 == 0) ? (C.bx % 8) * (C.G / 8) + C.bx / 8 : C.bx;
#pragma unroll 1
    for (int u = v; u < 1024; u += C.G) {
        const int combo = u >> 5, qb = u & 31;
        const int b = combo >> 3, hm = combo & 7, h = hm >> 1, mm = hm & 1;
        const attn_body::bf16* Qp = (const attn_body::bf16*)(WSP(bf16, WS_Q) + ((size_t)(b * SEQ + qb * 256) * 512 + hm * 64));
        const attn_body::bf16* Kp = (const attn_body::bf16*)(WSP(bf16, WS_K) + ((size_t)b * NKV * 512 + hm * 64));
        const attn_body::bf16* Vp = (const attn_body::bf16*)(WSP(bf16, WS_V) + ((size_t)b * NKV * 512 + h * 128));
        attn_body::bf16* Op = (attn_body::bf16*)(WSP(bf16, WS_O) + ((size_t)(b * SEQ + qb * 256) * 1024 + mm * 512 + h * 128));
        attn_body::attn_unit<8>(Qp, Kp, Vp, Op, (char*)C.ldsg, C.wave);
    }
    __syncthreads();
}

__device__ __forceinline__ void phase_combine(Ctx& C, bf16* MIX) {
    const int C_lane = lane_fresh(), C_tid = C.wave * 64 + C_lane;
    const int gw = C.bx * NWAVES + C.wave, NGW = C.G * NWAVES, lane = C_lane;
    const float lam_init = 0.2f;
    const float* dl = INP(22);
    const float lam = __expf(wave_sum(dl[lane] * dl[64 + lane])) - __expf(wave_sum(dl[128 + lane] * dl[192 + lane])) + lam_init;
    const bf16* O = WSP(bf16, WS_O);
    const float* sg = INP(23) + (lane & 15) * 8;
    const f32x4 g0 = *(const f32x4*)sg, g1 = *(const f32x4*)(sg + 4);
    for (int r = gw; r < NTOK; r += NGW) {
        const v4u a = *(const v4u*)(O + (size_t)r * 1024 + 8 * lane), b = *(const v4u*)(O + (size_t)r * 1024 + 512 + 8 * lane);
        const unsigned aw[4] = {a.x, a.y, a.z, a.w}, bw[4] = {b.x, b.y, b.z, b.w};
        float o[8]; float ss = 0.f;
#pragma unroll
        for (int e = 0; e < 4; ++e) { o[2 * e] = bflo(aw[e]) - lam * bflo(bw[e]); o[2 * e + 1] = bfhi(aw[e]) - lam * bfhi(bw[e]); ss += o[2 * e] * o[2 * e] + o[2 * e + 1] * o[2 * e + 1]; }
        ss += __shfl_xor(ss, 1); ss += __shfl_xor(ss, 2); ss += __shfl_xor(ss, 4); ss += __shfl_xor(ss, 8);
        const float rs = (1.0f / sqrtf(ss * (1.0f / 128.0f) + EPS)) * (1.0f - lam_init);
        *(v4u*)(MIX + (size_t)r * DM + 512 + 8 * lane) = (v4u){pk2(o[0] * rs * g0[0], o[1] * rs * g0[1]), pk2(o[2] * rs * g0[2], o[3] * rs * g0[3]), pk2(o[4] * rs * g1[0], o[5] * rs * g1[1]), pk2(o[6] * rs * g1[2], o[7] * rs * g1[3])};
    }
    LAS unsigned* tl = (LAS unsigned*)(C.lds + C.wave * 16384);
    const bf16* YAT = WSP(bf16, WS_YAT);
    for (int it = gw; it < 4 * 128 * 8; it += NGW) {
        const int b = it >> 10, tt = (it >> 3) & 127, ct = it & 7;
#pragma unroll
        for (int r = 0; r < 8; ++r) { const int c = r * 8 + (lane >> 3), tc = lane & 7;
            const v4u v = *(const v4u*)(YAT + ((size_t)(b * 512 + ct * 64 + c) * SEQ) + tt * 64 + tc * 8);
            tl[c * 33 + tc * 4 + 0] = v.x; tl[c * 33 + tc * 4 + 1] = v.y; tl[c * 33 + tc * 4 + 2] = v.z; tl[c * 33 + tc * 4 + 3] = v.w; }
        LDS_WAIT(); asm volatile("" ::: "memory");
#pragma unroll
        for (int r = 0; r < 8; ++r) { const int t = r * 8 + (lane >> 3), cc = lane & 7;
            unsigned short e[8];
#pragma unroll
            for (int k = 0; k < 8; ++k) { const unsigned wv = tl[(cc * 8 + k) * 33 + (t >> 1)]; e[k] = (unsigned short)((t & 1) ? (wv >> 16) : (wv & 0xffffu)); }
            *(v4u*)(MIX + (size_t)(b * SEQ + tt * 64 + t) * DM + ct * 64 + cc * 8) = (v4u){(unsigned)e[0] | ((unsigned)e[1] << 16), (unsigned)e[2] | ((unsigned)e[3] << 16), (unsigned)e[4] | ((unsigned)e[5] << 16), (unsigned)e[6] | ((unsigned)e[7] << 16)}; }
        LDS_WAIT(); asm volatile("" ::: "memory");
    }
}

__device__ __forceinline__ void phase_sgu_spatial(Ctx& C, bf16* GATED) {
    const int C_lane = lane_fresh(), C_tid = C.wave * 64 + C_lane;
    const int lane = C_lane, w = C.wave, tid = C_tid;
    LAS unsigned short* vt = (LAS unsigned short*)C.lds;
    const bf16* SU = WSP(bf16, WS_SU); const bf16* SV = WSP(bf16, WS_SV); const float* stat = WSP(float, WS_STAT); const bf16* WSb = WSP(bf16, WS_WS);
    const float* lng = INP(27); const float* lnb = INP(28); const float* bs = INP(30);
    for (int it = C.bx; it < 4 * 64 * 8; it += C.G) {
        const int g = it & 7, n = (it >> 3) & 63, b = it >> 9, tok0 = b * SEQ + n * 128;
        __syncthreads();
#pragma unroll
        for (int i = 0; i < 4; ++i) {
            const int p = i * NTHR + tid, s = p & 127, cp = p >> 7;
            const v4u v = *(const v4u*)(SV + (size_t)(tok0 + s) * DM + g * 128 + cp * 8);
            const float sm = stat[2 * (tok0 + s)], sq = stat[2 * (tok0 + s) + 1];
            const float mean = sm * (1.0f / 1024.0f), var = sq * (1.0f / 1024.0f) - mean * mean, rstd = 1.0f / sqrtf(var + EPS);
            const unsigned vw[4] = {v.x, v.y, v.z, v.w};
            const f32x4 ga = *(const f32x4*)(lng + g * 128 + cp * 8), gb = *(const f32x4*)(lng + g * 128 + cp * 8 + 4), ba = *(const f32x4*)(lnb + g * 128 + cp * 8), bb = *(const f32x4*)(lnb + g * 128 + cp * 8 + 4);
            const float gg[8] = {ga[0], ga[1], ga[2], ga[3], gb[0], gb[1], gb[2], gb[3]}, bq[8] = {ba[0], ba[1], ba[2], ba[3], bb[0], bb[1], bb[2], bb[3]};
#pragma unroll
            for (int e = 0; e < 8; ++e) { const float x = (e & 1) ? bfhi(vw[e >> 1]) : bflo(vw[e >> 1]); vt[(cp * 8 + e) * 136 + s] = (unsigned short)f2bf((x - mean) * rstd * gg[e] + bq[e]); }
        }
        __syncthreads();
        f32x4 acc[8];
#pragma unroll
        for (int cb = 0; cb < 8; ++cb) acc[cb] = (f32x4){0.f, 0.f, 0.f, 0.f};
        const int fr = lane & 15, fq = lane >> 4;
#pragma unroll
        for (int kb = 0; kb < 4; ++kb) {
            const bf16x8 a = *(const bf16x8*)(WSb + ((size_t)(g * 128 + 16 * w + fr) * 128) + 32 * kb + 8 * fq);
#pragma unroll
            for (int cb = 0; cb < 8; ++cb) { const bf16x8 bfr = *(const LAS bf16x8*)(vt + (16 * cb + fr) * 136 + 32 * kb + 8 * fq); acc[cb] = __builtin_amdgcn_mfma_f32_16x16x32_bf16(a, bfr, acc[cb], 0, 0, 0); }
        }
#pragma unroll
        for (int reg = 0; reg < 4; ++reg) {
            const int t = 16 * w + 4 * fq + reg; const float bias = bs[g * 128 + t];
#pragma unroll
            for (int cb = 0; cb < 8; ++cb) { const size_t off = (size_t)(tok0 + t) * DM + g * 128 + 16 * cb + fr; GATED[off] = (bf16)f2bf(bf2f(SU[off]) * (acc[cb][reg] + bias)); }
        }
    }
    __syncthreads();
}

#ifndef DUP_HY
#define DUP_HY 1
#endif
#ifndef DUP_AT
#define DUP_AT 1
#endif
#ifndef DUP_UP
#define DUP_UP 1
#endif
struct Args { const float* in[33]; float* out; unsigned char* ws; int ph_lo, ph_hi; };
constexpr int N_PHASES = 17;
__global__ void __launch_bounds__(NTHR, 2) fwd_megakernel(Args args) {
    extern __shared__ __attribute__((aligned(16))) unsigned char lds_raw[];
    cg::grid_group grid = cg::this_grid();
    Ctx C;
    C.lds = (LAS unsigned char*)lds_raw; C.ldsg = lds_raw; C.wave = __builtin_amdgcn_readfirstlane(threadIdx.x >> 6); C.G = gridDim.x; C.bx = blockIdx.x;
    C.kin = (ktab)__builtin_amdgcn_kernarg_segment_ptr();
    C.out = args.out; C.ws = args.ws;
    const int lo = args.ph_lo, hi = args.ph_hi;
    { const int C_lane = lane_fresh(), C_tid = C.wave * 64 + C_lane;
    { volatile LAS unsigned* mz = (volatile LAS unsigned*)(C.lds + MISC_OFF); if (C_tid < 64) mz[C_tid] = 0u; }
    __syncthreads();
    if (C.bx == 0) for (int i = C_tid; i < XCD_BAR_WORDS; i += NTHR) ((unsigned*)(C.ws + WS_CTL) + 4096)[i] = 0u;
    }
    XcdBarrier bar; bar.bar = (unsigned*)(C.ws + WS_CTL) + 4096; bar.x = 0; bar.wave = C.wave; bar.st = (volatile LAS unsigned*)(C.lds + MISC_OFF) + 8;
#ifndef PHMASK
#define PHMASK 0x1ffff
#endif
#define IN(k) ((((PHMASK) >> (k)) & 1) && lo <= (k) && (k) < hi)
#define SEAM(k) do { if (IN(k) && (k) + 1 < hi) xcd_barrier(bar); } while (0)
    bf16* ACT = WSP(bf16, WS_ACT);
    const float* MOD = WSP(float, WS_MOD);

    if (IN(0)) phase_p0(C);
    grid.sync();
    bar = xcd_barrier_post((unsigned*)(C.ws + WS_CTL) + 4096, (volatile LAS unsigned*)(C.lds + MISC_OFF) + 8, C.wave);
    bf16* ACT2 = WSP(bf16, WS_ACT2);
    float* RS = WSP(float, WS_RS);
    const float* SHW = WSP(float, WS_SHW);
    const float* MOD1 = MOD + (size_t)4 * 6144;
    if (IN(1)) {
        phase_norm_mod(C, INP(0), NTOK, SEQ, INP(6), MOD, MOD + 1024, 6144, ACT + DM);
        phase_norm_mod(C, INP(2), NCTX, NCTX, INP(6), WSP(float, WS_CMOD), WSP(float, WS_CMOD) + 1024, 0, WSP(bf16, WS_HC));
        phase_shw(C);
    }
    SEAM(1);
    if (IN(2)) {
        { pg8::Gemm g{ACT, WSP(bf16, WS_WIN), SLAB_TILES * 256, NIN, 1024, 1}; pg8::StaticOrder S; S.init(SLAB_TILES * 256, NIN, C.G, C.bx);
          epi::EpiInProj E{WSP(bf16, WS_HY), WSP(bf16, WS_Q), WSP(bf16, WS_K), WSP(bf16, WS_V), INP(13), INP(14), WSP(float, WS_ROPE)};
          pg8::gemm_phase<epi::EpiInProj, pg8::StaticOrder, true, true>(C.lds, g, S, E, C.wave); }
        { pg8::Gemm g{WSP(bf16, WS_HC), WSP(bf16, WS_WIN) + (size_t)2048 * 1024, NCTX, 1024, 1024, 0}; pg8::StaticOrder S; S.init(NCTX, 1024, C.G, (C.bx + C.G - 64) % C.G);
          epi::EpiCtxKV E{WSP(bf16, WS_K), WSP(bf16, WS_V)};
          pg8::gemm_phase<epi::EpiCtxKV, pg8::StaticOrder, true, true>(C.lds, g, S, E, C.wave); }
    }
    SEAM(2);
    if (IN(3)) {
#pragma unroll 1
        for (int r_ = 0; r_ < DUP_HY; ++r_) phase_hyena(C);
#pragma unroll 1
        for (int r_ = 0; r_ < DUP_AT; ++r_) phase_attn(C);
    }
    SEAM(3);
    if (IN(4)) phase_combine(C, ACT + DM);
    SEAM(4);
    if (IN(5)) {
        pg8::Gemm g{ACT + DM, WSP(bf16, WS_WOUT), NTOK, 1024, 1024, 0}; pg8::StaticOrder S; S.init(NTOK, 1024, C.G, C.bx);
        epi::EpiResid E{INP(0), C.out, MOD + 2048, nullptr, nullptr, nullptr, nullptr};
        pg8::gemm_phase<epi::EpiResid, pg8::StaticOrder, true, true>(C.lds, g, S, E, C.wave);
    }
    SEAM(5);
    if (IN(6)) phase_norm_mod(C, C.out, NTOK, SEQ, INP(7), MOD + 3072, MOD + 4096, 6144, ACT + DM);
    SEAM(6);
    if (IN(7)) {
        pg8::Gemm g{ACT, WSP(bf16, WS_WUP0), SLAB_TILES * 256, NUP, 1024, 1}; pg8::StaticOrder S; S.init(SLAB_TILES * 256, NUP, C.G, C.bx);
        epi::EpiFfnUp E{WSP(bf16, WS_HID), INP(9), INP(10)};
        pg8::gemm_phase<epi::EpiFfnUp, pg8::StaticOrder, true, true>(C.lds, g, S, E, C.wave);
    }
    SEAM(7);
    if (IN(8)) {
        pg8::Gemm g{WSP(bf16, WS_HID), WSP(bf16, WS_WDN0), NTOK, 1024, DFF, 0}; pg8::StaticOrder S; S.init(NTOK, 1024, C.G, C.bx);
        epi::EpiResid E{C.out, C.out, MOD + 5120, ACT + DM, INP(6) + 1024, MOD1 + 1024, RS + NTOK};
        pg8::gemm_phase<epi::EpiResid, pg8::StaticOrder, true, true>(C.lds, g, S, E, C.wave);
    }
    SEAM(8);
    if (IN(10)) {
        pg8::Gemm g{ACT + DM, WSP(bf16, WS_WSIN), NTOK, 2048, 1024, 0}; pg8::StaticOrder S; S.init(NTOK, 2048, C.G, C.bx);
        epi::EpiSguIn E{WSP(bf16, WS_SU), WSP(bf16, WS_SV), INP(26), WSP(float, WS_STAT), RS + NTOK, SHW + (size_t)4 * NUP};
        pg8::gemm_phase<epi::EpiSguIn, pg8::StaticOrder, true, true>(C.lds, g, S, E, C.wave);
    }
    SEAM(10);
    if (IN(11)) phase_sgu_spatial(C, ACT2 + DM);
    SEAM(11);
    if (IN(12)) {
        pg8::Gemm g{ACT2 + DM, WSP(bf16, WS_WSOUT), NTOK, 1024, 1024, 0}; pg8::StaticOrder S; S.init(NTOK, 1024, C.G, C.bx);
        epi::EpiResid E{C.out, C.out, MOD1 + 2048, nullptr, nullptr, nullptr, nullptr};
        pg8::gemm_phase<epi::EpiResid, pg8::StaticOrder, true, true>(C.lds, g, S, E, C.wave);
    }
    SEAM(12);
    if (IN(13)) phase_norm_mod(C, C.out, NTOK, SEQ, INP(7) + 1024, MOD1 + 3072, MOD1 + 4096, 6144, ACT + DM);
    SEAM(13);
    if (IN(14)) {
        pg8::Gemm g{ACT, WSP(bf16, WS_WUP1), SLAB_TILES * 256, NUP, 1024, 1}; pg8::StaticOrder S; S.init(SLAB_TILES * 256, NUP, C.G, C.bx);
        epi::EpiFfnUp E{WSP(bf16, WS_HID), INP(9) + (size_t)3 * NUP, INP(10) + NUP};
        pg8::gemm_phase<epi::EpiFfnUp, pg8::StaticOrder, true, true>(C.lds, g, S, E, C.wave);
    }
    SEAM(14);
    if (IN(15)) {
        pg8::Gemm g{WSP(bf16, WS_HID), WSP(bf16, WS_WDN1), NTOK, 1024, DFF, 0}; pg8::StaticOrder S; S.init(NTOK, 1024, C.G, C.bx);
        epi::EpiResid E{C.out, C.out, MOD1 + 5120, nullptr, nullptr, nullptr, nullptr};
        pg8::gemm_phase<epi::EpiResid, pg8::StaticOrder, true, true>(C.lds, g, S, E, C.wave);
    }
    SEAM(15);
    if (IN(16)) phase_final_norm(C, C.out, INP(32));
#undef IN
#undef SEAM
}

extern "C" void kernel_launch(void* const* d_in, const int* in_sizes, int n_in, void* d_out, int out_size, void* d_ws, size_t ws_size, hipStream_t stream) {
    static int grid = 0;
    if (grid == 0) {
        if (n_in != 33 || out_size != NTOK * DM || ws_size < WS_END) { fprintf(stderr, "kernel_launch: unexpected shapes (n_in %d out %d ws %zu)\n", n_in, out_size, ws_size); grid = -1; return; }
        int dev = 0, cus = 0, per_cu = 0;
        hipGetDevice(&dev); hipDeviceGetAttribute(&cus, hipDeviceAttributeMultiprocessorCount, dev);
        hipFuncSetAttribute((const void*)fwd_megakernel, hipFuncAttributeMaxDynamicSharedMemorySize, LDS_BYTES);
        if (hipOccupancyMaxActiveBlocksPerMultiprocessor(&per_cu, (const void*)fwd_megakernel, NTHR, LDS_BYTES) != hipSuccess || per_cu < 1) per_cu = 1;
        (void)hipGetLastError();
        grid = cus * per_cu;
    }
    if (grid < 0) return;
    Args a{};
    for (int i = 0; i < 33; ++i) a.in[i] = (const float*)d_in[i];
    a.out = (float*)d_out; a.ws = (unsigned char*)d_ws;
#ifndef N_LAUNCH_SPLIT
    a.ph_lo = 0; a.ph_hi = N_PHASES;
    void* params[] = {&a};
    hipError_t e = hipLaunchCooperativeKernel((const void*)fwd_megakernel, dim3(grid), dim3(NTHR), params, LDS_BYTES, stream);
    if (e != hipSuccess) fprintf(stderr, "cooperative launch failed: %s (grid %d)\n", hipGetErrorString(e), grid);
#else
    for (int p = 0; p < N_PHASES; ++p) { a.ph_lo = p; a.ph_hi = p + 1; hipLaunchKernelGGL(fwd_megakernel, dim3(grid), dim3(NTHR), LDS_BYTES, stream, a); }
#endif
}
```

```cpp
#include <hip/hip_runtime.h>
#include <hip/hip_cooperative_groups.h>
#include <hip/hip_bf16.h>
#include <cstdio>
#include <cstdint>
#include <cmath>
namespace cg = cooperative_groups;
__device__ __forceinline__ int lane_fresh() { int l; asm volatile("v_mbcnt_lo_u32_b32 %0, -1, 0\n\tv_mbcnt_hi_u32_b32 %0, -1, %0" : "=v"(l)); return l; }
namespace pg8 {
#define PG8_LAS __attribute__((address_space(3)))
typedef unsigned short bf16_t;
typedef short bf16x8 __attribute__((ext_vector_type(8)));
typedef float f32x4 __attribute__((ext_vector_type(4)));
typedef unsigned u32x4 __attribute__((ext_vector_type(4)));
constexpr int BM = 256, BK = 64, HALF = 128, HTB = HALF * BK * 2  , STAGE_BYTES = 8 * HTB, NXCD = 8, WGM = 8;

__host__ __device__ __forceinline__ int lds_byte(int r, int c) { const int st = (r >> 4) * 2 + (c >> 5), rr = r & 15, cc = c & 31, ob = rr * 64 + cc * 2; return st * 1024 + (ob ^ (((ob >> 9) & 1) << 5)); }
__host__ __device__ __forceinline__ void stage_rc(int b, int& R, int& C) { const int st = b / 1024, sb = b % 1024, swz = sb ^ (((sb >> 9) & 1) << 5); R = (st >> 1) * 16 + swz / 64; C = (st & 1) * 32 + (swz % 64) / 2; }
__host__ __device__ __forceinline__ int perm32(int rho) { const int n = rho >> 4, i = rho & 15; return 8 * (i >> 2) + 4 * n + (i & 3); }

struct Unit { int pm, pn; };
struct Gemm { const bf16_t* A; const bf16_t* Bt; int M, N, K; int slab; };

struct StaticOrder {
    int nM, nN, nwg, G, c;
    __host__ __device__ void init(int M, int N, int G_, int c_) { nM = M / BM; nN = N / BM; nwg = nM * nN; G = G_; c = c_; }
    __host__ __device__ bool next(int i, Unit& u) const {
        const long L = (long)i * G + c; if (L >= nwg) return false;
        int wgid = (int)L; { const int q = nwg / NXCD, r = nwg % NXCD, xcd = wgid % NXCD, off = wgid / NXCD; wgid = (xcd < r ? xcd * (q + 1) : r * (q + 1) + (xcd - r) * q) + off; }
        const int nig = WGM * nN, gid = wgid / nig, fm = gid * WGM, gsz = (nM - fm) < WGM ? (nM - fm) : WGM;
        u.pm = fm + ((wgid % nig) % gsz); u.pn = (wgid % nig) / gsz; return true;
    }
    __device__ __forceinline__ void a_ready(const Unit&) const {}
    __device__ __forceinline__ void done(const Unit&) const {}
};

__device__ __forceinline__ unsigned cvt_pk_bf16(float lo, float hi) { unsigned r; asm volatile("v_cvt_pk_bf16_f32 %0, %1, %2" : "=v"(r) : "v"(lo), "v"(hi)); return r; }
typedef float f32x2 __attribute__((ext_vector_type(2)));
__device__ __forceinline__ f32x2 gelu_pk(f32x2 v) {
    const f32x2 av = __builtin_elementwise_abs(v), d = av * 0.2316418882f + 1.0f;
    f32x2 t; t.x = __builtin_amdgcn_rcpf(d.x); t.y = __builtin_amdgcn_rcpf(d.y);
    f32x2 q = t * 0.5307027145f + (-0.7265760135f); q = q * t + 0.7107068705f; q = q * t + (-0.142248368f); q = q * t + 0.127414796f; q = q * t;
    const f32x2 s = (v * v) * (-0.72134752044f);
    f32x2 e; e.x = __builtin_amdgcn_exp2f(s.x); e.y = __builtin_amdgcn_exp2f(s.y);
    const f32x2 m = v * (q * e), r = v - m;
    f32x2 o; o.x = v.x < 0.f ? m.x : r.x; o.y = v.y < 0.f ? m.y : r.y; return o;
}

template <class Epi, class Sched, bool ALIGN_EPI = false, bool SP2 = false>
__device__ __forceinline__ void gemm_phase(PG8_LAS unsigned char* lds, const Gemm g, const Sched& S, const Epi& E, int wave_in) {
    int tid_ = wave_in * 64 + lane_fresh();
    const int tid = tid_, wid = __builtin_amdgcn_readfirstlane(tid >> 6), lane = tid & 63, wr = wid >> 2, wc = wid & 3, fr = lane & 15, fq = lane >> 4;
    const int K = g.K, nt = K / BK;
    unsigned voffA[2], voffB[2];
#pragma unroll
    for (int i = 0; i < 2; ++i) { int R, C; stage_rc(tid * 16 + i * 8192, R, C); const int Rb = Epi::PERM ? ((R & ~31) + perm32(R & 31)) : R;
        const int Ra = g.slab ? ((R >> 6) * 62 + (R & 63)) : R; voffA[i] = (unsigned)(Ra * K + C) * 2u; voffB[i] = (unsigned)(Rb * K + C) * 2u; }
    const size_t kstep = (size_t)(BK * 2);
    const size_t hstep = (size_t)HALF * K * 2;
    const size_t tstep = 2 * hstep;
    const size_t hstepA = g.slab ? (size_t)124 * K * 2 : hstep, tstepA = g.slab ? (size_t)248 * K * 2 : tstep;
    const unsigned ldsw = (unsigned)wid * 1024u;
    const int aoff = lds_byte(wr * 64 + fr, fq * 8), boff = lds_byte(wc * 32 + fr, fq * 8);
#define PG8_SA(b, h) (((b) * 2 + (h)) * HTB)
#define PG8_SB(b, h) ((4 + (b) * 2 + (h)) * HTB)
#define PG8_STAGE(bufoff, gbase, voff) do { _Pragma("unroll") for (int _i = 0; _i < 2; ++_i) \
        __builtin_amdgcn_global_load_lds((const unsigned*)((const char*)(gbase) + (voff)[_i]), (PG8_LAS unsigned*)(lds + (bufoff) + ldsw + _i * 8192), 16, 0, 0); } while (0)
#define PG8_LDA(dst, b, h) do { _Pragma("unroll") for (int m = 0; m < 4; ++m) _Pragma("unroll") for (int k = 0; k < 2; ++k) dst[m][k] = *(const PG8_LAS bf16x8*)(lds + PG8_SA(b, h) + aoff + m * 2048 + k * 1024); } while (0)
#define PG8_LDB(dst, b, h) do { _Pragma("unroll") for (int n = 0; n < 2; ++n) _Pragma("unroll") for (int k = 0; k < 2; ++k) dst[n][k] = *(const PG8_LAS bf16x8*)(lds + PG8_SB(b, h) + boff + n * 2048 + k * 1024); } while (0)
#define PG8_MMA(ai, bj, At, Bt) do { __builtin_amdgcn_s_setprio(1); _Pragma("unroll") for (int m = 0; m < 4; ++m) _Pragma("unroll") for (int n = 0; n < 2; ++n) _Pragma("unroll") for (int k = 0; k < 2; ++k) \
        acc[ai][bj][m][n] = __builtin_amdgcn_mfma_f32_16x16x32_bf16(Bt[n][k], At[m][k], acc[ai][bj][m][n], 0, 0, 0); __builtin_amdgcn_s_setprio(0); } while (0)
#define PG8_WAIT_V(n) asm volatile("s_waitcnt vmcnt(" #n ")" ::: "memory")
#define PG8_WAIT_L(n) asm volatile("s_waitcnt lgkmcnt(" #n ")" ::: "memory")
#define PG8_BAR __builtin_amdgcn_s_barrier()
#define PG8_SCHED __builtin_amdgcn_sched_barrier(0)
    Unit cur, nxt; int ui = 0;
    if (!S.next(0, cur)) return;
    f32x4 acc[2][2][4][2];
#pragma unroll
    for (int a = 0; a < 2; ++a)
#pragma unroll
        for (int b = 0; b < 2; ++b)
#pragma unroll
            for (int m = 0; m < 4; ++m)
#pragma unroll
                for (int n = 0; n < 2; ++n) acc[a][b][m][n] = (f32x4){0.f, 0.f, 0.f, 0.f};
    bf16x8 At[4][2], B0[2][2], B1[2][2];
    const char* cA = (const char*)g.A + (size_t)cur.pm * tstepA; const char* cB = (const char*)g.Bt + (size_t)cur.pn * tstep;
    S.a_ready(cur);
    if constexpr (SP2) {
        PG8_STAGE(PG8_SB(0, 0), cB, voffB); PG8_STAGE(PG8_SB(0, 1), cB + hstep, voffB); PG8_STAGE(PG8_SA(0, 0), cA, voffA); PG8_STAGE(PG8_SA(0, 1), cA + hstepA, voffA);
        if (wr == 1) PG8_BAR;
        PG8_WAIT_V(2); PG8_BAR;
        PG8_STAGE(PG8_SB(1, 0), cB + kstep, voffB); PG8_STAGE(PG8_SA(1, 0), cA + kstep, voffA); PG8_STAGE(PG8_SB(1, 1), cB + hstep + kstep, voffB);
        PG8_WAIT_V(6); PG8_BAR;
    } else {
        PG8_STAGE(PG8_SB(0, 0), cB, voffB); PG8_STAGE(PG8_SA(0, 0), cA, voffA); PG8_STAGE(PG8_SB(0, 1), cB + hstep, voffB); PG8_STAGE(PG8_SA(0, 1), cA + hstepA, voffA);
        if (wr == 1) PG8_BAR;
        PG8_WAIT_V(4); PG8_BAR;
        PG8_STAGE(PG8_SB(1, 0), cB + kstep, voffB); PG8_STAGE(PG8_SA(1, 0), cA + kstep, voffA); PG8_STAGE(PG8_SB(1, 1), cB + hstep + kstep, voffB);
        PG8_WAIT_V(6); PG8_BAR;
    }
    for (;;) {
        const bool has_next = S.next(ui + 1, nxt);
        const char* nA = has_next ? (const char*)g.A + (size_t)nxt.pm * tstepA : cA; const char* nB = has_next ? (const char*)g.Bt + (size_t)nxt.pn * tstep : cB;
        for (int t = 0; t < nt; t += 2) {
            const bool last = (t == nt - 2);
            const char* a1 = cA + (size_t)(t + 1) * kstep;
            const char* a2 = last ? nA : cA + (size_t)(t + 2) * kstep; const char* b2 = last ? nB : cB + (size_t)(t + 2) * kstep;
            const char* a3 = a2 + kstep; const char* b3 = b2 + kstep;
            if (last && has_next) S.a_ready(nxt);
            if constexpr (SP2) {
            PG8_LDB(B0, 0, 0); PG8_LDB(B1, 0, 1); PG8_SCHED; PG8_LDA(At, 0, 0); PG8_STAGE(PG8_SA(1, 1), a1 + hstepA, voffA);
            PG8_WAIT_V(8); PG8_WAIT_L(0); PG8_BAR; PG8_MMA(0, 0, At, B0); PG8_MMA(0, 1, At, B1); PG8_BAR; PG8_SCHED;
            PG8_LDA(At, 0, 1); PG8_STAGE(PG8_SB(0, 0), b2, voffB); PG8_STAGE(PG8_SB(0, 1), b2 + hstep, voffB); PG8_STAGE(PG8_SA(0, 0), a2, voffA);
            PG8_WAIT_V(8); PG8_WAIT_L(0); PG8_BAR; PG8_MMA(1, 0, At, B0); PG8_MMA(1, 1, At, B1); PG8_BAR; PG8_SCHED;
            PG8_LDB(B0, 1, 0); PG8_LDB(B1, 1, 1); PG8_SCHED; PG8_LDA(At, 1, 0); PG8_STAGE(PG8_SA(0, 1), a2 + hstepA, voffA);
            PG8_WAIT_V(8); PG8_WAIT_L(0); PG8_BAR; PG8_MMA(0, 0, At, B0); PG8_MMA(0, 1, At, B1); PG8_BAR; PG8_SCHED;
            PG8_LDA(At, 1, 1); PG8_STAGE(PG8_SB(1, 0), b3, voffB); PG8_STAGE(PG8_SB(1, 1), b3 + hstep, voffB); PG8_STAGE(PG8_SA(1, 0), a3, voffA);
            PG8_WAIT_V(8); PG8_WAIT_L(0); PG8_BAR; PG8_MMA(1, 0, At, B0); PG8_MMA(1, 1, At, B1); PG8_BAR; PG8_SCHED;
            } else {
            PG8_LDB(B0, 0, 0); PG8_SCHED; PG8_LDA(At, 0, 0); PG8_STAGE(PG8_SA(1, 1), a1 + hstepA, voffA);
            PG8_WAIT_L(8); PG8_BAR; PG8_WAIT_L(0); PG8_MMA(0, 0, At, B0); PG8_BAR; PG8_SCHED;
            PG8_LDB(B1, 0, 1); PG8_STAGE(PG8_SB(0, 0), b2, voffB);
            PG8_BAR; PG8_WAIT_L(0); PG8_MMA(0, 1, At, B1); PG8_BAR;
            PG8_LDA(At, 0, 1); PG8_STAGE(PG8_SA(0, 0), a2, voffA);
            PG8_BAR; PG8_WAIT_L(0); PG8_MMA(1, 0, At, B0); PG8_BAR; PG8_SCHED;
            PG8_STAGE(PG8_SB(0, 1), b2 + hstep, voffB);
            PG8_WAIT_V(6); PG8_BAR; PG8_MMA(1, 1, At, B1); PG8_BAR;
            PG8_LDB(B0, 1, 0); PG8_SCHED; PG8_LDA(At, 1, 0); PG8_STAGE(PG8_SA(0, 1), a2 + hstepA, voffA);
            PG8_WAIT_L(8); PG8_BAR; PG8_WAIT_L(0); PG8_MMA(0, 0, At, B0); PG8_BAR; PG8_SCHED;
            PG8_LDB(B1, 1, 1); PG8_STAGE(PG8_SB(1, 0), b3, voffB);
            PG8_BAR; PG8_WAIT_L(0); PG8_MMA(0, 1, At, B1); PG8_BAR;
            PG8_LDA(At, 1, 1); PG8_STAGE(PG8_SA(1, 0), a3, voffA);
            PG8_BAR; PG8_WAIT_L(0); PG8_MMA(1, 0, At, B0); PG8_BAR; PG8_SCHED;
            PG8_STAGE(PG8_SB(1, 1), b3 + hstep, voffB);
            PG8_WAIT_V(6); PG8_BAR; PG8_MMA(1, 1, At, B1); PG8_BAR;
            }
        }
        if constexpr (ALIGN_EPI) { if (wr == 0) PG8_BAR; }
        if constexpr (!Epi::AFTER_DRAIN) { E(acc, cur, wr, wc, fr, fq); S.done(cur); }
        if (!has_next) break;
#pragma unroll
        for (int a = 0; a < 2; ++a)
#pragma unroll
            for (int b = 0; b < 2; ++b)
#pragma unroll
                for (int m = 0; m < 4; ++m)
#pragma unroll
                    for (int n = 0; n < 2; ++n) acc[a][b][m][n] = (f32x4){0.f, 0.f, 0.f, 0.f};
        cur = nxt; cA = nA; cB = nB; ++ui;
        if constexpr (ALIGN_EPI) { if (wr == 1) PG8_BAR; }
    }
    PG8_WAIT_V(0);
    if constexpr (!ALIGN_EPI) { if (wr == 0) PG8_BAR; }
    PG8_BAR;
    if constexpr (Epi::AFTER_DRAIN) { E.fused(acc, cur, wr, wc, fr, fq, lds, wid, lane); S.done(cur); }
#undef PG8_SA
#undef PG8_SB
#undef PG8_STAGE
#undef PG8_LDA
#undef PG8_LDB
#undef PG8_MMA
#undef PG8_WAIT_V
#undef PG8_WAIT_L
#undef PG8_BAR
#undef PG8_SCHED
}
}

namespace attn_body {
using bf16=__hip_bfloat16;
using bf16x8=__attribute__((ext_vector_type(8)))short;
using s16x4=__attribute__((ext_vector_type(4)))short;
using f32x16=__attribute__((ext_vector_type(16)))float;
using u32x4=__attribute__((ext_vector_type(4)))unsigned;
constexpr int D=64,QP=512,KP=512,VP=512,OP=1024,NT_ALL=132;
constexpr int NW=8,QBLK=32,QB=QBLK*NW,KVBLK=64;
__device__ __forceinline__ int crow(int r,int hi){return (r&3)+8*(r>>2)+4*hi;}
#define SBAR() __builtin_amdgcn_sched_barrier(0)
__device__ __forceinline__ void cmask(f32x16&p0,f32x16&p1,int jb,int qrel,int hi){
  const float NEG=-INFINITY; int kb=64*jb+4*hi;
  #pragma unroll
  for(int r=0;r<16;++r){int kv=kb+(r&3)+8*(r>>2); if(kv>qrel)p0[r]=NEG; if(kv+32>qrel)p1[r]=NEG;}
}

constexpr int NSLOT=3, SLOTB=8192;
constexpr int LDS_K=0, LDS_V=NSLOT*SLOTB, LDS_V1=2*NSLOT*SLOTB, LDS_WS=3*NSLOT*SLOTB, LDS_OST=LDS_WS+NW*64*4, LDS_BYTES=LDS_OST+NW*4096;
constexpr float C2=0.125f*1.4426950408889634f;
__device__ __forceinline__ void glds16(const void*gsrc,unsigned lds_dst){unsigned keep;
  asm volatile("s_mov_b32 %0, m0\n\ts_mov_b32 m0, %2\n\ts_nop 0\n\tglobal_load_lds_dwordx4 %1, off\n\ts_mov_b32 m0, %0":"=&s"(keep):"v"(gsrc),"s"(lds_dst):"memory");}
__device__ __forceinline__ float max3f(float a,float b,float c){float r;asm("v_max3_f32 %0, %1, %2, %3":"=v"(r):"v"(a),"v"(b),"v"(c));return r;}
__device__ __forceinline__ float max2f(float a,float b){float r;asm("v_max_f32_e32 %0, %1, %2":"=v"(r):"v"(a),"v"(b));return r;}
__device__ __forceinline__ float fadd_s(float a,float b){float r;asm("v_add_f32_e32 %0, %1, %2":"=v"(r):"v"(a),"v"(b));return r;}
__device__ __forceinline__ float fsub_s(float a,float b){float r;asm("v_sub_f32_e32 %0, %1, %2":"=v"(r):"v"(a),"v"(b));return r;}
typedef float f32x2_t __attribute__((ext_vector_type(2))); typedef __bf16 bf16x2_t __attribute__((ext_vector_type(2)));
__device__ __forceinline__ unsigned cvtpk_s(float lo,float hi){f32x2_t v={lo,hi};bf16x2_t b=__builtin_convertvector(v,bf16x2_t);return __builtin_bit_cast(unsigned,b);}
#define WAIT_BAR(N) asm volatile("s_waitcnt vmcnt(" #N ") lgkmcnt(0)\n\ts_barrier":::"memory")

__device__ __forceinline__ void qkt(f32x16&p0,f32x16&p1,const char*Kslot,const bf16x8*qr,const f32x16&negm,int r32,int hi){
  const char*kb=Kslot+hi*1024+r32*16;
  #pragma unroll
  for(int d0=0;d0<4;++d0){
    const bf16x8 b0=*reinterpret_cast<const bf16x8*>(kb+d0*2048);
    const bf16x8 b1=*reinterpret_cast<const bf16x8*>(kb+d0*2048+512);
    if(d0==0){p0=__builtin_amdgcn_mfma_f32_32x32x16_bf16(b0,qr[0],negm,0,0,0);p1=__builtin_amdgcn_mfma_f32_32x32x16_bf16(b1,qr[0],negm,0,0,0);}
    else{p0=__builtin_amdgcn_mfma_f32_32x32x16_bf16(b0,qr[d0],p0,0,0,0);p1=__builtin_amdgcn_mfma_f32_32x32x16_bf16(b1,qr[d0],p1,0,0,0);}}
}
typedef __attribute__((address_space(3))) const char* lds_cptr;
typedef short v4i16_t __attribute__((ext_vector_type(4)));
__device__ __forceinline__ void kload8(bf16x8*kf,lds_cptr kp){
  kf[0]=*(const __attribute__((address_space(3))) bf16x8*)(kp);      kf[1]=*(const __attribute__((address_space(3))) bf16x8*)(kp+512);
  kf[2]=*(const __attribute__((address_space(3))) bf16x8*)(kp+2048); kf[3]=*(const __attribute__((address_space(3))) bf16x8*)(kp+2560);
  kf[4]=*(const __attribute__((address_space(3))) bf16x8*)(kp+4096); kf[5]=*(const __attribute__((address_space(3))) bf16x8*)(kp+4608);
  kf[6]=*(const __attribute__((address_space(3))) bf16x8*)(kp+6144); kf[7]=*(const __attribute__((address_space(3))) bf16x8*)(kp+6656);
}
__device__ __forceinline__ void kload2(bf16x8*kf,lds_cptr kp,int j){ kf[2*j]=*(const __attribute__((address_space(3))) bf16x8*)(kp+j*2048); kf[2*j+1]=*(const __attribute__((address_space(3))) bf16x8*)(kp+j*2048+512); }
__device__ __forceinline__ s16x4 vtr(lds_cptr p){ return __builtin_bit_cast(s16x4,__builtin_amdgcn_ds_read_tr16_b64_v4i16((__attribute__((address_space(3))) v4i16_t*)p)); }
__device__ __forceinline__ float rowmax(const f32x16&p0,const f32x16&p1){
  float a=max3f(p0[0],p0[1],p1[0]),b=max3f(p0[2],p0[3],p1[1]);a=max3f(a,p1[2],p1[3]);
  #pragma unroll
  for(int r=4;r<16;r+=4){a=max3f(a,p0[r],p0[r+1]);b=max3f(b,p0[r+2],p0[r+3]);a=max3f(a,p1[r],p1[r+1]);b=max3f(b,p1[r+2],p1[r+3]);}
  const float m=max2f(a,b);
  auto rr=__builtin_amdgcn_permlane32_swap(__float_as_uint(m),__float_as_uint(m),false,false);
  return max2f(__uint_as_float(rr[0]),__uint_as_float(rr[1]));
}
__device__ __forceinline__ void pv(f32x16*o,int vb,bf16x8 pa0,bf16x8 pa1,bf16x8 pa2,bf16x8 pa3){
  #pragma unroll
  for(int d0=0;d0<2;++d0){s16x4 lo[4],hi[4];
    #pragma unroll
    for(int ks=0;ks<4;++ks){
      asm volatile("ds_read_b64_tr_b16 %0,%1 offset:%c2":"=&v"(lo[ks]):"v"(vb),"i"(d0*4096+ks*1024):"memory");
      asm volatile("ds_read_b64_tr_b16 %0,%1 offset:%c2":"=&v"(hi[ks]):"v"(vb),"i"(d0*4096+ks*1024+512):"memory");}
    asm volatile("s_waitcnt lgkmcnt(0)":::"memory");SBAR();
    #define PK(k) (bf16x8){lo[k][0],lo[k][1],lo[k][2],lo[k][3],hi[k][0],hi[k][1],hi[k][2],hi[k][3]}
    o[d0]=__builtin_amdgcn_mfma_f32_32x32x16_bf16(pa0,PK(0),o[d0],0,0,0);
    o[d0]=__builtin_amdgcn_mfma_f32_32x32x16_bf16(pa1,PK(1),o[d0],0,0,0);
    o[d0]=__builtin_amdgcn_mfma_f32_32x32x16_bf16(pa2,PK(2),o[d0],0,0,0);
    o[d0]=__builtin_amdgcn_mfma_f32_32x32x16_bf16(pa3,PK(3),o[d0],0,0,0);
    #undef PK
  }
}

#ifndef ATTN_STORE16
#define ATTN_STORE16(p,v) (*(u32x4*)(p)=(v))
#endif
template<int THRL> __device__ __forceinline__ void attn_unit(const bf16*Qblk,const bf16*__restrict__ Kh,const bf16*__restrict__ Vh,bf16*Oblk,char*shm,int wave_in){
  const int tid=wave_in*64+lane_fresh(),lane=tid&63,r32=lane&31,hi=lane>>5; const int wid=__builtin_amdgcn_readfirstlane(tid>>6);
  const bf16*Qw=Qblk+(long)(wid*QBLK)*QP;
  const unsigned lds0=(unsigned)(uintptr_t)shm;
  float*wsf=(float*)(shm+LDS_WS)+wid*64;
  const bf16*ksrc=Kh+(long)lane*KP+wid*8;
  const bf16*vsrc=Vh+(long)(16*(wid&3)+(lane>>2))*VP+(wid>>2)*32+(lane&3)*8;
  const unsigned kdst=lds0+LDS_K+wid*1024, vdst=lds0+LDS_V+wid*1024, vdst1=lds0+LDS_V1+wid*1024;
  #define DMA_K(t,slot) glds16(ksrc+(long)(t)*KVBLK*KP,(unsigned)__builtin_amdgcn_readfirstlane(kdst+(slot)))
  #define DMA_V(t,slot) do{ glds16(vsrc+(long)(t)*KVBLK*VP,(unsigned)__builtin_amdgcn_readfirstlane(vdst+(slot))); glds16(vsrc+64+(long)(t)*KVBLK*VP,(unsigned)__builtin_amdgcn_readfirstlane(vdst1+(slot))); }while(0)
  const int vb0=(int)(lds0+LDS_V)+((lane>>4)&1)*32+(lane&3)*8+(4*hi+((lane&15)>>2))*64;
  const char*Kbase=shm+LDS_K; bf16x8 kf[8];
  const lds_cptr shm3=(lds_cptr)shm; const lds_cptr kp0=shm3+LDS_K+hi*1024+r32*16; const lds_cptr vp0=shm3+LDS_V+((lane>>4)&1)*32+(lane&3)*8+(4*hi+((lane&15)>>2))*64;
  const int NT=NT_ALL;
  DMA_K(0,0);DMA_V(0,0);DMA_K(1,SLOTB);
  bf16x8 qr[4];
  #pragma unroll
  for(int d0=0;d0<4;++d0)qr[d0]=*reinterpret_cast<const bf16x8*>(&Qw[(long)r32*QP+d0*16+hi*8]);
  float mhat=0.f,l_reg=0.f;f32x16 o[4];o[0]=f32x16{};o[1]=f32x16{};o[2]=f32x16{};o[3]=f32x16{};
  #define CMASK(P0,P1,t) do{}while(0)
  bool resc=false;
  #define START(P0,P1) do{ const float rm=rowmax(P0,P1); resc=false; \
    { const float dl=rm; mhat=fadd_s(mhat,dl); \
      _Pragma("unroll") for(int r=0;r<16;++r){P0[r]=fsub_s(P0[r],dl);P1[r]=fsub_s(P1[r],dl);} \
      } \
    _Pragma("unroll") for(int r=0;r<16;++r)P0[r]=__builtin_amdgcn_exp2f(P0[r]); }while(0)
  #define RESC() do{ if(resc){ asm volatile("s_waitcnt lgkmcnt(0)":::"memory"); \
      _Pragma("unroll") for(int d_=0;d_<4;++d_) _Pragma("unroll") for(int r=0;r<16;++r)o[d_][r]*=wsf[crow(r,hi)]; } }while(0)
  f32x16 pA0,pA1,pB0,pB1;
  int sl_prev=0,sl_cur=0,sl_next=SLOTB;
  #define ROT() do{sl_prev=sl_cur;sl_cur=sl_next;sl_next=(sl_next==(NSLOT-1)*SLOTB)?0:sl_next+SLOTB;}while(0)
  DMA_K(2,2*SLOTB);
  WAIT_BAR(3);
  qkt(pA0,pA1,Kbase,qr,f32x16{},r32,hi);asm volatile("s_nop 15\n\ts_nop 7":"+v"(pA0),"+v"(pA1));CMASK(pA0,pA1,0);
  START(pA0,pA1);
  _Pragma("unroll") for(int r=0;r<16;++r)pA1[r]=__builtin_amdgcn_exp2f(pA1[r]);
  WAIT_BAR(0);
  DMA_K(3,0);DMA_V(1,SLOTB);
  ROT();
  kload8(kf,kp0+sl_cur);
  WAIT_BAR(3);
  s16x4 vlo[8],vhi[8]; u32x4 pw0,pw1,pw2,pw3;
  #define PKW(P,B) cvtpk_s(P[B],P[B+1])
  #define PAF(k) __builtin_bit_cast(bf16x8,pw##k)
  #define VFR(i) (bf16x8){vlo[i][0],vlo[i][1],vlo[i][2],vlo[i][3],vhi[i][0],vhi[i][1],vhi[i][2],vhi[i][3]}
  #define PIN(x) asm volatile("":"+v"(x))
  #define MX3(a,b,c) __builtin_fmaxf(__builtin_fmaxf((a),(b)),(c))
  #define GAPA(MF,A0,A1,A2,A3,W0,W1,PW) do{ MF; sacc+=A0; sacc+=A1; sacc+=A2; sacc+=A3; PIN(sacc); W0; W1; PIN(PW); SBAR(); }while(0)
  #define EX(v) __builtin_amdgcn_exp2f(v)
  #define GAPB(MF,X,B) do{ MF; X[B]=EX(X[B]); X[B+1]=EX(X[B+1]); X[B+2]=EX(X[B+2]); X[B+3]=EX(X[B+3]); PIN(X); SBAR(); }while(0)
  #define VRD(i) do{ vlo[i]=vtr(vp_+(((i)>>2)*4096+((i)&3)*1024)); vhi[i]=vtr(vp_+(((i)>>2)*4096+((i)&3)*1024+512)); }while(0)
  #define KRD(G,j) do{ if(G){ kload2(kf,kp0+sl_next,j); SBAR(); } }while(0)
  #define STEP(C0,C1,P0,P1,t,GK,GV,GL) do{ SBAR(); \
    const lds_cptr vp_=vp0+sl_prev; \
    VRD(0); SBAR(); float sacc=(P0[0]+P0[1]); \
    GAPA(C0=__builtin_amdgcn_mfma_f32_32x32x16_bf16(kf[0],qr[0],f32x16{},0,0,0), P0[2],P0[3],P0[4],P0[5],     pw0[0]=PKW(P0,0), pw0[1]=PKW(P0,2), pw0); \
    VRD(4); SBAR(); GAPA(C1=__builtin_amdgcn_mfma_f32_32x32x16_bf16(kf[1],qr[0],f32x16{},0,0,0), P0[6],P0[7],P0[8],P0[9],     pw0[2]=PKW(P0,4), pw0[3]=PKW(P0,6), pw0); \
    VRD(1); SBAR(); GAPA(C0=__builtin_amdgcn_mfma_f32_32x32x16_bf16(kf[2],qr[1],C0,0,0,0),   P0[10],P0[11],P0[12],P0[13], pw1[0]=PKW(P0,8), pw1[1]=PKW(P0,10), pw1); \
    VRD(5); SBAR(); GAPA(C1=__builtin_amdgcn_mfma_f32_32x32x16_bf16(kf[3],qr[1],C1,0,0,0),   P0[14],P0[15],P1[0],P1[1],   pw1[2]=PKW(P0,12),pw1[3]=PKW(P0,14), pw1); \
    VRD(2); SBAR(); GAPA(C0=__builtin_amdgcn_mfma_f32_32x32x16_bf16(kf[4],qr[2],C0,0,0,0),   P1[2],P1[3],P1[4],P1[5],     pw2[0]=PKW(P1,0), pw2[1]=PKW(P1,2), pw2); \
    VRD(6); SBAR(); GAPA(C1=__builtin_amdgcn_mfma_f32_32x32x16_bf16(kf[5],qr[2],C1,0,0,0),   P1[6],P1[7],P1[8],P1[9],     pw2[2]=PKW(P1,4), pw2[3]=PKW(P1,6), pw2); \
    VRD(3); SBAR(); GAPA(C0=__builtin_amdgcn_mfma_f32_32x32x16_bf16(kf[6],qr[3],C0,0,0,0),   P1[10],P1[11],P1[12],P1[13], pw3[0]=PKW(P1,8), pw3[1]=PKW(P1,10), pw3); \
    VRD(7); SBAR(); GAPA(C1=__builtin_amdgcn_mfma_f32_32x32x16_bf16(kf[7],qr[3],C1,0,0,0),   P1[14],P1[15],0.f,0.f,       pw3[2]=PKW(P1,12),pw3[3]=PKW(P1,14), pw3); \
    l_reg+=sacc; \
    if(GK){DMA_K((t)+3,sl_cur);} if(GV){DMA_V((t)+1,sl_next);} \
    CMASK(C0,C1,t); \
    { float a=MX3(C0[0],C0[1],C1[0]),b=MX3(C0[2],C0[3],C1[1]); a=MX3(a,C1[2],C1[3]); \
      _Pragma("unroll") for(int r=4;r<16;r+=4){a=MX3(a,C0[r],C0[r+1]);b=MX3(b,C0[r+2],C0[r+3]);a=MX3(a,C1[r],C1[r+1]);b=MX3(b,C1[r+2],C1[r+3]);} \
      float rm=__builtin_fmaxf(a,b); { auto rr=__builtin_amdgcn_permlane32_swap(__float_as_uint(rm),__float_as_uint(rm),false,false); rm=__builtin_fmaxf(__uint_as_float(rr[0]),__uint_as_float(rr[1])); } \
      rm-=mhat;     \
      resc=false; \
      if(__builtin_expect(__any(rm>(float)THRL),0)){ const float dl=__builtin_fmaxf(rm,0.f); mhat+=dl; \
        const float f=__builtin_amdgcn_exp2f(-dl); l_reg*=f; if(hi==0)wsf[r32]=f; resc=true; } \
      _Pragma("unroll") for(int r=0;r<16;++r){C0[r]-=mhat;C1[r]-=mhat;} } \
    SBAR(); \
    GAPB(o[0]=__builtin_amdgcn_mfma_f32_32x32x16_bf16(PAF(0),VFR(0),o[0],0,0,0), C0,0); \
    GAPB(o[1]=__builtin_amdgcn_mfma_f32_32x32x16_bf16(PAF(0),VFR(4),o[1],0,0,0), C0,4); \
    KRD(GL,0); GAPB(o[0]=__builtin_amdgcn_mfma_f32_32x32x16_bf16(PAF(1),VFR(1),o[0],0,0,0), C0,8); \
    KRD(GL,1); GAPB(o[1]=__builtin_amdgcn_mfma_f32_32x32x16_bf16(PAF(1),VFR(5),o[1],0,0,0), C0,12); \
    KRD(GL,2); GAPB(o[0]=__builtin_amdgcn_mfma_f32_32x32x16_bf16(PAF(2),VFR(2),o[0],0,0,0), C1,0); \
    KRD(GL,3); GAPB(o[1]=__builtin_amdgcn_mfma_f32_32x32x16_bf16(PAF(2),VFR(6),o[1],0,0,0), C1,4); \
    GAPB(o[0]=__builtin_amdgcn_mfma_f32_32x32x16_bf16(PAF(3),VFR(3),o[0],0,0,0), C1,8); \
    GAPB(o[1]=__builtin_amdgcn_mfma_f32_32x32x16_bf16(PAF(3),VFR(7),o[1],0,0,0), C1,12); \
      \
    { const lds_cptr vq_=vp_+(LDS_V1-LDS_V); \
      _Pragma("unroll") for(int i_=0;i_<8;++i_){ vlo[i_]=vtr(vq_+((i_>>2)*4096+(i_&3)*1024)); vhi[i_]=vtr(vq_+((i_>>2)*4096+(i_&3)*1024+512)); } \
      SBAR(); \
      o[2]=__builtin_amdgcn_mfma_f32_32x32x16_bf16(PAF(0),VFR(0),o[2],0,0,0); o[3]=__builtin_amdgcn_mfma_f32_32x32x16_bf16(PAF(0),VFR(4),o[3],0,0,0); \
      o[2]=__builtin_amdgcn_mfma_f32_32x32x16_bf16(PAF(1),VFR(1),o[2],0,0,0); o[3]=__builtin_amdgcn_mfma_f32_32x32x16_bf16(PAF(1),VFR(5),o[3],0,0,0); \
      o[2]=__builtin_amdgcn_mfma_f32_32x32x16_bf16(PAF(2),VFR(2),o[2],0,0,0); o[3]=__builtin_amdgcn_mfma_f32_32x32x16_bf16(PAF(2),VFR(6),o[3],0,0,0); \
      o[2]=__builtin_amdgcn_mfma_f32_32x32x16_bf16(PAF(3),VFR(3),o[2],0,0,0); o[3]=__builtin_amdgcn_mfma_f32_32x32x16_bf16(PAF(3),VFR(7),o[3],0,0,0); SBAR(); } \
    }while(0)
  int t=1;
  #undef CMASK
  #define CMASK(P0,P1,t) do{}while(0)
  for(;t+5<NT;t+=2){
    STEP(pB0,pB1,pA0,pA1,t,true,true,true);     WAIT_BAR(3); RESC(); ROT();
    STEP(pA0,pA1,pB0,pB1,t+1,true,true,true);   WAIT_BAR(3); RESC(); ROT();
  }
  #undef CMASK
  #define CMASK(P0,P1,t) do{}while(0)
  #define ENDW(tt) do{ if((tt)+3<NT){WAIT_BAR(3);} else if((tt)+2<NT){WAIT_BAR(2);} else {WAIT_BAR(0);} }while(0)
  for(;t+1<NT;t+=2){
    STEP(pB0,pB1,pA0,pA1,t,(t+3<NT),(t+1<NT),(t+1<NT));       ENDW(t);   RESC(); ROT();
    STEP(pA0,pA1,pB0,pB1,t+1,(t+4<NT),(t+2<NT),(t+2<NT));     ENDW(t+1); RESC(); ROT();
  }
  STEP(pB0,pB1,pA0,pA1,NT-1,false,false,false); RESC();
  { float sacc=pB0[0]+pB0[1]; _Pragma("unroll") for(int r=2;r<16;++r)sacc+=pB0[r]; _Pragma("unroll") for(int r=0;r<16;++r)sacc+=pB1[r]; l_reg+=sacc;
    pw0=(u32x4){PKW(pB0,0),PKW(pB0,2),PKW(pB0,4),PKW(pB0,6)};pw1=(u32x4){PKW(pB0,8),PKW(pB0,10),PKW(pB0,12),PKW(pB0,14)};pw2=(u32x4){PKW(pB1,0),PKW(pB1,2),PKW(pB1,4),PKW(pB1,6)};pw3=(u32x4){PKW(pB1,8),PKW(pB1,10),PKW(pB1,12),PKW(pB1,14)};
    SBAR(); pv(o,vb0+sl_cur,PAF(0),PAF(1),PAF(2),PAF(3)); pv(o+2,vb0+(LDS_V1-LDS_V)+sl_cur,PAF(0),PAF(1),PAF(2),PAF(3)); }
  #undef PKW
  #undef PAF
  #undef VFR
  #undef PIN
  #undef MX3
  #undef GAPA
  #undef GAPB
  #undef EX
  #undef VRD
  #undef KRD
  #undef STEP
  #undef ENDW
  {auto rr=__builtin_amdgcn_permlane32_swap(__float_as_uint(l_reg),__float_as_uint(l_reg),false,false);l_reg=__uint_as_float(rr[0])+__uint_as_float(rr[1]);}
  if(hi==0)wsf[32+r32]=l_reg;asm volatile("s_waitcnt lgkmcnt(0)":::"memory");
  float rli[16];
  #pragma unroll
  for(int r=0;r<16;++r)rli[r]=__builtin_amdgcn_rcpf(wsf[32+crow(r,hi)]);
  bf16*Ow=Oblk+(long)(wid*QBLK)*OP;
  { bf16*stg=(bf16*)(shm+LDS_OST)+wid*2048;
    #pragma unroll
    for(int half=0;half<2;++half){
      #pragma unroll
      for(int r=0;r<16;++r){const int orow=crow(r,hi);
        #pragma unroll
        for(int d0=0;d0<2;++d0)stg[orow*64+d0*32+r32]=__float2bfloat16(o[2*half+d0][r]*rli[r]);}
      asm volatile("s_waitcnt lgkmcnt(0)":::"memory");
      #pragma unroll
      for(int i=0;i<4;++i){const int row=i*8+(lane>>3),ch=lane&7; const u32x4 v=*(const u32x4*)(stg+row*64+ch*8); ATTN_STORE16(Ow+(long)row*OP+half*64+ch*8,v);}
      asm volatile("s_waitcnt lgkmcnt(0)":::"memory"); } }
  asm volatile("s_waitcnt lgkmcnt(0)\n\ts_barrier":::"memory");
  #undef DMA_K
  #undef DMA_V
  #undef CMASK
  #undef START
  #undef RESC
  #undef ROT
}
constexpr int ATTN_LDS_BYTES=LDS_BYTES;
#undef SBAR
#undef WAIT_BAR
}


#define GAS __attribute__((address_space(1)))
#define LAS __attribute__((address_space(3)))
typedef unsigned short bf16;
typedef unsigned v4u __attribute__((ext_vector_type(4)));
typedef unsigned v2u __attribute__((ext_vector_type(2)));
typedef float f32x4 __attribute__((ext_vector_type(4)));
typedef short bf16x8 __attribute__((ext_vector_type(8)));
typedef GAS unsigned gu32;

constexpr int NWAVES = 8, NTHR = 512;
constexpr int DM = 1024, NB = 4, SEQ = 8192, NTOK = NB * SEQ, CTX = 256, NCTX = NB * CTX, DFF = 2816, NKV = SEQ + CTX;
constexpr int DHY = 512, NIN = 3072, NUP = 2 * DFF;
constexpr float EPS = 1e-6f;
constexpr int SLAB_TILES = 133;
constexpr size_t MiB = 1u << 20;
constexpr size_t WS_CTL = 0, WS_STAT = 1 * MiB, WS_MOD = 2 * MiB, WS_CMOD = WS_MOD + 256 * 1024, WS_ROPE = WS_CMOD + 16 * 1024, WS_H2 = 3 * MiB;
constexpr size_t WS_WIN = 8 * MiB, WS_WOUT = 14 * MiB, WS_WUP0 = 16 * MiB, WS_WUP1 = 27 * MiB, WS_WDN0 = 38 * MiB, WS_WDN1 = 44 * MiB, WS_WSIN = 50 * MiB, WS_WSOUT = 54 * MiB, WS_W3 = 56 * MiB, WS_WS = 57 * MiB;
constexpr size_t WS_ACT = 58 * MiB, WS_HC = 124 * MiB, WS_R = 126 * MiB, WS_HY = 158 * MiB, WS_Q = 254 * MiB, WS_K = 286 * MiB, WS_V = 320 * MiB, WS_O = 354 * MiB, WS_YAT = 418 * MiB, WS_END = 450 * MiB;
constexpr size_t WS_HID = 158 * MiB, WS_SU = 158 * MiB, WS_SV = 222 * MiB;
constexpr size_t WS_RS = WS_STAT + 256 * 1024;
constexpr size_t WS_SHW = WS_MOD + 512 * 1024;
constexpr size_t WS_ACT2 = 354 * MiB;
static_assert(WS_ACT + (size_t)(NTOK + 301) * DM * 2 <= WS_HC && WS_HID + (size_t)NTOK * DFF * 2 <= WS_O, "ws map");
constexpr int LDS_BYTES = 147456, RING_BYTES = 131072, MISC_OFF = LDS_BYTES - 256;

#define RLX_AGENT __ATOMIC_RELAXED, __HIP_MEMORY_SCOPE_AGENT
#define LDS_WAIT() asm volatile("s_waitcnt lgkmcnt(0)" ::: "memory")
typedef float f32x2_c __attribute__((ext_vector_type(2))); typedef __bf16 bf16x2_c __attribute__((ext_vector_type(2)));
__device__ __forceinline__ unsigned pk2(float lo, float hi) { f32x2_c v = {lo, hi}; bf16x2_c b = __builtin_convertvector(v, bf16x2_c); return __builtin_bit_cast(unsigned, b); }
__device__ __forceinline__ unsigned f2bf(float f) { return pk2(f, 0.f) & 0xffffu; }
__device__ __forceinline__ float bf2f(unsigned h) { return __builtin_bit_cast(float, h << 16); }
__device__ __forceinline__ float bflo(unsigned w) { return __builtin_bit_cast(float, w << 16); }
__device__ __forceinline__ float bfhi(unsigned w) { return __builtin_bit_cast(float, w & 0xffff0000u); }
__device__ __forceinline__ float wave_sum(float v) {
#pragma unroll
    for (int o = 1; o < 64; o <<= 1) v += __shfl_xor(v, o);
    return v;
}
#ifndef USE_DPP
#define USE_DPP 1
#endif
__device__ __forceinline__ float rot_prev(float v) {
#if USE_DPP
    return __builtin_bit_cast(float, __builtin_amdgcn_mov_dpp(__builtin_bit_cast(int, v), 0x121, 0xf, 0xf, true));
#else
    const int l = threadIdx.x & 63; return __shfl(v, (l & 48) | ((l - 1) & 15));
#endif
}
__device__ __forceinline__ float rot_next(float v) {
#if USE_DPP
    return __builtin_bit_cast(float, __builtin_amdgcn_mov_dpp(__builtin_bit_cast(int, v), 0x12F, 0xf, 0xf, true));
#else
    const int l = threadIdx.x & 63; return __shfl(v, (l & 48) | ((l + 1) & 15));
#endif
}
__device__ __forceinline__ f32x4 rot_prev4(f32x4 v) { return (f32x4){rot_prev(v[0]), rot_prev(v[1]), rot_prev(v[2]), rot_prev(v[3])}; }
__device__ __forceinline__ f32x4 rot_next4(f32x4 v) { return (f32x4){rot_next(v[0]), rot_next(v[1]), rot_next(v[2]), rot_next(v[3])}; }

namespace epi {
using pg8::Unit; using pg8::bf16_t;
typedef float f32x4 __attribute__((ext_vector_type(4)));

struct EpiInProj {
    static constexpr bool PERM = false, AFTER_DRAIN = false;
    bf16_t* HY; bf16_t* Q; bf16_t* Kb; bf16_t* Vb; const float* cw; const float* cb; const float* rope;
    __device__ __forceinline__ void operator()(const f32x4 (&acc)[2][2][4][2], const Unit& u, int wr, int wc, int fr_, int fq_) const {
        const int l_ = lane_fresh(), fr = l_ & 15, fq = l_ >> 4; (void)fr_; (void)fq_;
        if (u.pn < 6) {
#pragma unroll
            for (int ai = 0; ai < 2; ++ai) {
                const int gbase = 248 * u.pm + 62 * (2 * ai + wr) - 1;
                const bool edge = __builtin_amdgcn_readfirstlane(((gbase + SEQ) >> 13) != ((gbase + 64 + SEQ) >> 13)) != 0;
#pragma unroll
                for (int bj = 0; bj < 2; ++bj)
#pragma unroll
                    for (int n = 0; n < 2; ++n) {
                        const int col = 256 * u.pn + 128 * bj + 32 * wc + 16 * n + 4 * fq;
                        const f32x4 w0 = *(const f32x4*)(cw + col), w1 = *(const f32x4*)(cw + 1536 + col), w2 = *(const f32x4*)(cw + 3072 + col), bb = *(const f32x4*)(cb + col);
                        f32x4 rp_prev = (f32x4){0.f, 0.f, 0.f, 0.f}, rn_cur = rot_next4(acc[ai][bj][0][n]);
#pragma unroll
                        for (int m = 0; m < 4; ++m) {
                            const int j = 16 * m + fr, g = gbase + j, t = g & (SEQ - 1), b = g >> 13;
                            const f32x4 rp_cur = rot_prev4(acc[ai][bj][m][n]);
                            const f32x4 rn_next = (m < 3) ? rot_next4(acc[ai][bj][m < 3 ? m + 1 : 3][n]) : rn_cur;
                            f32x4 p = (fr == 0) ? rp_prev : rp_cur;
                            f32x4 q = (fr == 15) ? rn_next : rn_cur;
                            rp_prev = rp_cur; rn_cur = rn_next;
                            if (__builtin_expect(edge, 0)) { asm volatile("");
                                if (t == 0) p = (f32x4){0.f, 0.f, 0.f, 0.f};
                                if (t == SEQ - 1) q = (f32x4){0.f, 0.f, 0.f, 0.f}; }
                            const f32x4 o = w0 * p + w1 * acc[ai][bj][m][n] + w2 * q + bb;
                            if (j >= 1 && j <= 62 && g < NTOK) {
                                bf16_t* dst = HY + ((size_t)(b * 1536 + col) * SEQ + t);
                                dst[0] = (bf16_t)f2bf(o[0]); dst[SEQ] = (bf16_t)f2bf(o[1]); dst[2 * SEQ] = (bf16_t)f2bf(o[2]); dst[3 * SEQ] = (bf16_t)f2bf(o[3]);
                            }
                        }
                        asm volatile("" ::: "memory");
                    }
            }
        } else if (u.pn < 10) {
            const bool isq = u.pn < 8;
            const float sc = isq ? attn_body::C2 : 1.0f;
#pragma unroll
            for (int ai = 0; ai < 2; ++ai) {
                const int gbase = 248 * u.pm + 62 * (2 * ai + wr) - 1;
#pragma unroll
                for (int m = 0; m < 4; ++m) {
                    const int j = 16 * m + fr, g = gbase + j, t = g & (SEQ - 1), b = g >> 13;
                    const bool ok = (j >= 1 && j <= 62 && g < NTOK);
                    const int pos = (wc & 1) ? (t & 63) : (t >> 6);
                    const float* rp = rope + (size_t)(pos * 16 + 4 * fq) * 2;
                    const f32x4 cs0 = *(const f32x4*)rp, cs1 = *(const f32x4*)(rp + 4);
                    const f32x4 cc = (f32x4){cs0[0], cs0[2], cs1[0], cs1[2]}, ss = (f32x4){cs0[1], cs0[3], cs1[1], cs1[3]};
#pragma unroll
                    for (int bj = 0; bj < 2; ++bj) {
                        const f32x4 x1 = acc[ai][bj][m][0], x2 = acc[ai][bj][m][1];
                        const f32x4 o1 = (x1 * cc - x2 * ss) * sc, o2 = (x1 * ss + x2 * cc) * sc;
                        const int col = 256 * (u.pn - (isq ? 6 : 8)) + 128 * bj + 32 * wc + 4 * fq;
                        if (ok) {
                            bf16_t* dst = isq ? (Q + (size_t)g * 512 + col) : (Kb + ((size_t)b * NKV + CTX + t) * 512 + col);
                            *(v2u*)dst = (v2u){pk2(o1[0], o1[1]), pk2(o1[2], o1[3])};
                            *(v2u*)(dst + 16) = (v2u){pk2(o2[0], o2[1]), pk2(o2[2], o2[3])};
                        }
                    }
                    asm volatile("" ::: "memory");
                }
            }
        } else {
#pragma unroll
            for (int ai = 0; ai < 2; ++ai) {
                const int gbase = 248 * u.pm + 62 * (2 * ai + wr) - 1;
#pragma unroll
                for (int m = 0; m < 4; ++m) {
                    const int j = 16 * m + fr, g = gbase + j, t = g & (SEQ - 1), b = g >> 13;
                    if (j >= 1 && j <= 62 && g < NTOK) {
#pragma unroll
                        for (int bj = 0; bj < 2; ++bj)
#pragma unroll
                            for (int n = 0; n < 2; ++n) {
                                const int col = 256 * (u.pn - 10) + 128 * bj + 32 * wc + 16 * n + 4 * fq;
                                const f32x4 v = acc[ai][bj][m][n];
                                *(v2u*)(Vb + ((size_t)b * NKV + CTX + t) * 512 + col) = (v2u){pk2(v[0], v[1]), pk2(v[2], v[3])};
                            }
                    }
                }
            }
        }
    }
};

struct EpiCtxKV {
    static constexpr bool PERM = false, AFTER_DRAIN = false;
    bf16_t* Kb; bf16_t* Vb;
    __device__ __forceinline__ void operator()(const f32x4 (&acc)[2][2][4][2], const Unit& u, int wr, int wc, int fr_, int fq_) const {
        const int l_ = lane_fresh(), fr = l_ & 15, fq = l_ >> 4; (void)fr_; (void)fq_;
#pragma unroll
        for (int ai = 0; ai < 2; ++ai)
#pragma unroll
            for (int m = 0; m < 4; ++m) {
                const int row = 256 * u.pm + 128 * ai + 64 * wr + 16 * m + fr, b = row >> 8, tc = row & 255;
#pragma unroll
                for (int bj = 0; bj < 2; ++bj)
#pragma unroll
                    for (int n = 0; n < 2; ++n) {
                        const int col = 256 * u.pn + 128 * bj + 32 * wc + 16 * n + 4 * fq;
                        const f32x4 v = acc[ai][bj][m][n];
                        bf16_t* dst = (col < 512) ? (Kb + ((size_t)b * NKV + tc) * 512 + col) : (Vb + ((size_t)b * NKV + tc) * 512 + (col - 512));
                        *(v2u*)dst = (v2u){pk2(v[0], v[1]), pk2(v[2], v[3])};
                    }
            }
    }
};

struct EpiResid {
    static constexpr bool PERM = false, AFTER_DRAIN = false;
    const float* base; float* out; const float* gate;
    bf16_t* nextA; const float* gain; const float* scale; float* rs;
    __device__ __forceinline__ void operator()(const f32x4 (&acc)[2][2][4][2], const Unit& u, int wr, int wc, int fr_, int fq_) const {
        const int l_ = lane_fresh(), fr = l_ & 15, fq = l_ >> 4; (void)fr_; (void)fq_;
        const int b = u.pm >> 5;
#pragma unroll
        for (int ai = 0; ai < 2; ++ai)
#pragma unroll
            for (int m = 0; m < 4; ++m) {
                const int row = 256 * u.pm + 128 * ai + 64 * wr + 16 * m + fr;
                float ss = 0.f;
#pragma unroll
                for (int bj = 0; bj < 2; ++bj)
#pragma unroll
                    for (int n = 0; n < 2; ++n) {
                        const int col = 256 * u.pn + 128 * bj + 32 * wc + 16 * n + 4 * fq;
                        const f32x4 gt = *(const f32x4*)(gate + b * 6144 + col), bs = *(const f32x4*)(base + (size_t)row * DM + col);
                        const f32x4 o = bs + gt * acc[ai][bj][m][n];
                        *(f32x4*)(out + (size_t)row * DM + col) = o;
                        if (nextA) {
                            const f32x4 gv = *(const f32x4*)(gain + col) * (*(const f32x4*)(scale + b * 6144 + col) + 1.0f), a = o * gv;
                            *(v2u*)(nextA + (size_t)row * DM + col) = (v2u){pk2(a[0], a[1]), pk2(a[2], a[3])};
                            ss += (o[0] * o[0] + o[1] * o[1]) + (o[2] * o[2] + o[3] * o[3]);
                        }
                    }
                if (nextA) { ss += __shfl_xor(ss, 16); ss += __shfl_xor(ss, 32); if (fq == 0) atomicAdd(rs + row, ss); }
            }
    }
};

struct EpiFfnUp {
    static constexpr bool PERM = true, AFTER_DRAIN = false;
    bf16_t* H; const float* cw; const float* cb;
    __device__ __forceinline__ void operator()(const f32x4 (&acc)[2][2][4][2], const Unit& u, int wr, int wc, int fr_, int fq_) const {
        const int l_ = lane_fresh(), fr = l_ & 15, fq = l_ >> 4; (void)fr_; (void)fq_;
#pragma unroll
        for (int ai = 0; ai < 2; ++ai) {
            const int gbase = 248 * u.pm + 62 * (2 * ai + wr) - 1;
            const bool edge = __builtin_amdgcn_readfirstlane(((gbase + SEQ) >> 13) != ((gbase + 64 + SEQ) >> 13)) != 0;
#pragma unroll
            for (int n = 0; n < 2; ++n) {
                const int ch = 128 * u.pn + 32 * wc + 8 * fq + 4 * n;
                const f32x4 g0 = *(const f32x4*)(cw + ch), g1 = *(const f32x4*)(cw + NUP + ch), g2 = *(const f32x4*)(cw + 2 * NUP + ch), gb = *(const f32x4*)(cb + ch);
                const f32x4 u0 = *(const f32x4*)(cw + DFF + ch), u1 = *(const f32x4*)(cw + NUP + DFF + ch), u2 = *(const f32x4*)(cw + 2 * NUP + DFF + ch), ub = *(const f32x4*)(cb + DFF + ch);
                const f32x4 z = (f32x4){0.f, 0.f, 0.f, 0.f};
                f32x4 gp_prev = z, up_prev = z, gn_cur = rot_next4(acc[ai][0][0][n]), un_cur = rot_next4(acc[ai][1][0][n]);
#pragma unroll
                for (int m = 0; m < 4; ++m) {
                    const int j = 16 * m + fr, g = gbase + j, t = g & (SEQ - 1);
                    const f32x4 gp_cur = rot_prev4(acc[ai][0][m][n]), up_cur = rot_prev4(acc[ai][1][m][n]);
                    const f32x4 gn_next = (m < 3) ? rot_next4(acc[ai][0][m < 3 ? m + 1 : 3][n]) : gn_cur, un_next = (m < 3) ? rot_next4(acc[ai][1][m < 3 ? m + 1 : 3][n]) : un_cur;
                    f32x4 pg = (fr == 0) ? gp_prev : gp_cur, ng = (fr == 15) ? gn_next : gn_cur;
                    f32x4 pu = (fr == 0) ? up_prev : up_cur, nu = (fr == 15) ? un_next : un_cur;
                    gp_prev = gp_cur; up_prev = up_cur; gn_cur = gn_next; un_cur = un_next;
                    if (__builtin_expect(edge, 0)) { asm volatile("");
                        if (t == 0) { pg = z; pu = z; }
                        if (t == SEQ - 1) { ng = z; nu = z; } }
                    const f32x4 gc = g0 * pg + g1 * acc[ai][0][m][n] + g2 * ng + gb;
                    const f32x4 uc = u0 * pu + u1 * acc[ai][1][m][n] + u2 * nu + ub;
                    f32x4 h;
#pragma unroll
                    for (int e = 0; e < 4; ++e) h[e] = gc[e] * __builtin_amdgcn_rcpf(1.0f + __builtin_amdgcn_exp2f(-1.4426950408889634f * gc[e])) * uc[e];
                    if (j >= 1 && j <= 62 && g < NTOK) *(v2u*)(H + (size_t)g * DFF + ch) = (v2u){pk2(h[0], h[1]), pk2(h[2], h[3])};
                }
                asm volatile("" ::: "memory");
            }
        }
    }
};

struct EpiSguIn {
    static constexpr bool PERM = true, AFTER_DRAIN = false;
    bf16_t* U; bf16_t* V; const float* bias; float* stat; const float* rs; const float* shw;
    __device__ __forceinline__ void operator()(const f32x4 (&acc)[2][2][4][2], const Unit& u, int wr, int wc, int fr_, int fq_) const {
        const int l_ = lane_fresh(), fr = l_ & 15, fq = l_ >> 4; (void)fr_; (void)fq_;
        const bool isv = u.pn >= 4;
#pragma unroll
        for (int ai = 0; ai < 2; ++ai)
#pragma unroll
            for (int m = 0; m < 4; ++m) {
                const int row = 256 * u.pm + 128 * ai + 64 * wr + 16 * m + fr;
                float s = 0.f, s2 = 0.f;
                const float rstd = 1.0f / sqrtf(rs[row] * (1.0f / DM) + EPS); const int b = row >> 13;
#pragma unroll
                for (int bj = 0; bj < 2; ++bj) {
                    const int col = 256 * u.pn + 128 * bj + 32 * wc + 8 * fq;
                    const f32x4 b0 = *(const f32x4*)(bias + col) + *(const f32x4*)(shw + b * NUP + col), b1 = *(const f32x4*)(bias + col + 4) + *(const f32x4*)(shw + b * NUP + col + 4);
                    const f32x4 v0 = acc[ai][bj][m][0] * rstd + b0, v1 = acc[ai][bj][m][1] * rstd + b1;
                    const pg8::f32x2 a = pg8::gelu_pk((pg8::f32x2){v0[0], v0[1]}), b = pg8::gelu_pk((pg8::f32x2){v0[2], v0[3]}), c = pg8::gelu_pk((pg8::f32x2){v1[0], v1[1]}), d = pg8::gelu_pk((pg8::f32x2){v1[2], v1[3]});
                    s += (a.x + a.y) + (b.x + b.y) + (c.x + c.y) + (d.x + d.y);
                    s2 += (a.x * a.x + a.y * a.y) + (b.x * b.x + b.y * b.y) + (c.x * c.x + c.y * c.y) + (d.x * d.x + d.y * d.y);
                    bf16_t* dst = (isv ? V : U) + (size_t)row * DM + (col & 1023);
                    *(v4u*)dst = (v4u){pk2(a.x, a.y), pk2(b.x, b.y), pk2(c.x, c.y), pk2(d.x, d.y)};
                }
                if (isv) {
                    s += __shfl_xor(s, 16); s += __shfl_xor(s, 32); s2 += __shfl_xor(s2, 16); s2 += __shfl_xor(s2, 32);
                    if (fq == 0) { atomicAdd(stat + 2 * row, s); atomicAdd(stat + 2 * row + 1, s2); }
                }
            }
    }
};
}

#define VM_WAIT() asm volatile("s_waitcnt vmcnt(0)" ::: "memory")
#define XB_TMO      128
#define XB_XCNT(j)  (256  + 64 * (j))
#define XB_XSUB(j)  (1280 + 64 * (j))
#define XB_XGEN(j)  (2304 + 64 * (j))
#define XB_TOP      3328
#define XB_TOPGEN   3392
#define XCD_BAR_WORDS 3456
#define XB_SPIN_CAP (1u << 18)

__device__ __forceinline__ unsigned xb_ld(unsigned* p)              { return __hip_atomic_load(p, __ATOMIC_RELAXED, __HIP_MEMORY_SCOPE_AGENT); }
__device__ __forceinline__ unsigned xb_add(unsigned* p, unsigned v) { return __hip_atomic_fetch_add(p, v, __ATOMIC_RELAXED, __HIP_MEMORY_SCOPE_AGENT); }
__device__ __forceinline__ unsigned xb_xcc_id() { return (unsigned)__builtin_amdgcn_s_getreg((3 << 11) | 20) & 0xFu; }
#define XB_SPIN(cond, bar) do { unsigned _sp = 0; while (cond) { __builtin_amdgcn_s_sleep(1); \
    if ((++_sp & 255u) == 0u) { if (xb_ld(&(bar)[XB_TMO])) break; if (_sp > XB_SPIN_CAP) { atomicAdd(&(bar)[XB_TMO], 1u); break; } } } } while (0)

struct XcdBarrier {
    unsigned* bar; unsigned x; int wave;
    volatile LAS unsigned* st;
};

__device__ __forceinline__ XcdBarrier xcd_barrier_post(unsigned* bar, volatile LAS unsigned* st, int wave) {
    XcdBarrier b; b.bar = bar; b.x = xb_xcc_id(); b.st = st; b.wave = wave;
    if (wave == 0 && lane_fresh() == 0) (void)xb_add(&bar[XB_XCNT(b.x)], 1u);
    return b;
}
__device__ __forceinline__ void xcd_barrier_complete(unsigned* bar, unsigned x, unsigned& nloc, unsigned& nx) {
    const unsigned G = gridDim.x * gridDim.y * gridDim.z;
    unsigned sum, cnt, mine, sp = 0u;
    for (;;) {
        sum = 0u; cnt = 0u; mine = 0u;
#pragma unroll
        for (unsigned j = 0; j < 16; ++j) { const unsigned c = xb_ld(&bar[XB_XCNT(j)]); sum += c; cnt += (c > 0u) ? 1u : 0u; mine = (j == x) ? c : mine; }
        if (sum == G) break;
        __builtin_amdgcn_s_sleep(1);
        if ((++sp & 255u) == 0u) { if (xb_ld(&bar[XB_TMO])) break; if (sp > XB_SPIN_CAP) { atomicAdd(&bar[XB_TMO], 1u); break; } }
    }
    nloc = mine > 0u ? mine : 1u; nx = cnt > 0u ? cnt : 1u;
}

__device__ __forceinline__ void xcd_barrier(const XcdBarrier& b) {
    asm volatile("s_waitcnt vmcnt(0)" ::: "memory");
    __syncthreads();
    if (b.wave == 0 && lane_fresh() == 0) {
        unsigned* bar = b.bar;
        __builtin_amdgcn_s_waitcnt(0);
        unsigned nloc = b.st[0], nx = b.st[1];
        if (nloc == 0u) { xcd_barrier_complete(bar, b.x, nloc, nx); b.st[0] = nloc; b.st[1] = nx; }
        const unsigned old = xb_add(&bar[XB_XSUB(b.x)], 1u);
        const unsigned gen = old / nloc;
        if (old + 1u == (gen + 1u) * nloc) {
            __builtin_amdgcn_fence(__ATOMIC_RELEASE, "agent");
            asm volatile("s_waitcnt vmcnt(0)" ::: "memory");
            const unsigned og = xb_add(&bar[XB_TOP], 1u);
            const unsigned tg = og / nx;
            if (og + 1u == (tg + 1u) * nx) xb_add(&bar[XB_TOPGEN], 1u);
            else XB_SPIN(xb_ld(&bar[XB_TOPGEN]) == tg, bar);
            __builtin_amdgcn_fence(__ATOMIC_ACQUIRE, "agent");
            xb_add(&bar[XB_XGEN(b.x)], 1u);
            asm volatile("s_waitcnt vmcnt(0)" ::: "memory");
        } else {
            XB_SPIN(xb_ld(&bar[XB_XGEN(b.x)]) == gen, bar);
            __builtin_amdgcn_fence(__ATOMIC_ACQUIRE, "agent");
            asm volatile("s_waitcnt vmcnt(0)" ::: "memory");
        }
    }
    __syncthreads();
}

typedef const float* fptr_t;
typedef __attribute__((address_space(4))) const fptr_t* ktab;
struct Ctx {
    LAS unsigned char* lds; unsigned char* ldsg; int wave, G, bx;
    ktab kin; float* out; unsigned char* ws;
};
__device__ __forceinline__ const float* ld_in(ktab t, int k) { asm volatile("" : "+s"(t)); return t[k]; }
#define INP(k) ld_in(C.kin, (k))
#define WSP(T, off) ((T*)(C.ws + (off)))

__device__ __forceinline__ void p0_transpose_item(const float* W, int ldw, int k0, int n0, bf16* WT, int ldt, int drow0, LAS float* scr, int lane) {
    f32x4 wv[8];
#pragma unroll
    for (int i = 0; i < 8; ++i) wv[i] = *(const f32x4*)(W + (size_t)(k0 + 8 * i + (lane >> 3)) * ldw + n0 + 4 * (lane & 7));
#pragma unroll
    for (int i = 0; i < 8; ++i) { LAS float* d = scr + (8 * i + (lane >> 3)) * 33 + 4 * (lane & 7); d[0] = wv[i][0]; d[1] = wv[i][1]; d[2] = wv[i][2]; d[3] = wv[i][3]; }
    LDS_WAIT(); asm volatile("" ::: "memory");
    const int c = lane & 7;
#pragma unroll
    for (int j = 0; j < 4; ++j) { const int n = (lane >> 3) + 8 * j; const LAS float* s = scr + (8 * c) * 33 + n;
        v4u o; o.x = pk2(s[0 * 33], s[1 * 33]); o.y = pk2(s[2 * 33], s[3 * 33]); o.z = pk2(s[4 * 33], s[5 * 33]); o.w = pk2(s[6 * 33], s[7 * 33]);
        *(v4u*)(WT + (size_t)(drow0 + n) * ldt + k0 + 8 * c) = o; }
    LDS_WAIT(); asm volatile("" ::: "memory");
}
__device__ __forceinline__ void p0_mat(const float* W, int K, int N, bf16* WT, int ldt, int item, bool ffn_perm, LAS float* scr, int lane) {
    const int nblk = N / 32, kb = item / nblk, nb = item % nblk, n0 = 32 * nb;
    int drow0 = n0;
    if (ffn_perm) { const int s = n0 / DFF, ch = n0 % DFF; drow0 = 256 * (ch >> 7) + 128 * s + (ch & 127); }
    p0_transpose_item(W, N, 64 * kb, n0, WT, ldt, drow0, scr, lane);
}
__device__ __forceinline__ float silu_f(float v) { return v / (1.0f + __expf(-v)); }

__device__ __forceinline__ void phase_p0(Ctx& C) {
    const int C_lane = lane_fresh(), C_tid = C.wave * 64 + C_lane;
    LAS float* scr = (LAS float*)(C.lds + C.wave * 16384);
    const int gw = C.bx * NWAVES + C.wave, NGW = C.G * NWAVES, lane = C_lane;
    const int gt = C.bx * NTHR + C_tid, NGT = C.G * NTHR;
    constexpr int I_IN = 16 * 96, I_OUT = 16 * 32, I_UP = 16 * 176, I_DN = 44 * 32, I_SIN = 16 * 64, I_SOUT = 16 * 32;
    constexpr int NITEMS = I_IN + I_OUT + 2 * I_UP + 2 * I_DN + I_SIN + I_SOUT;
    for (int it = gw; it < NITEMS; it += NGW) {
        int r = it;
        if (r < I_IN) { p0_mat(INP(12), 1024, NIN, WSP(bf16, WS_WIN), 1024, r, false, scr, lane); continue; } r -= I_IN;
        if (r < I_OUT) { p0_mat(INP(24), 1024, 1024, WSP(bf16, WS_WOUT), 1024, r, false, scr, lane); continue; } r -= I_OUT;
        if (r < I_UP) { p0_mat(INP(8), 1024, NUP, WSP(bf16, WS_WUP0), 1024, r, true, scr, lane); continue; } r -= I_UP;
        if (r < I_UP) { p0_mat(INP(8) + (size_t)1024 * NUP, 1024, NUP, WSP(bf16, WS_WUP1), 1024, r, true, scr, lane); continue; } r -= I_UP;
        if (r < I_DN) { p0_mat(INP(11), DFF, 1024, WSP(bf16, WS_WDN0), DFF, r, false, scr, lane); continue; } r -= I_DN;
        if (r < I_DN) { p0_mat(INP(11) + (size_t)DFF * 1024, DFF, 1024, WSP(bf16, WS_WDN1), DFF, r, false, scr, lane); continue; } r -= I_DN;
        if (r < I_SIN) { p0_mat(INP(25), 1024, 2048, WSP(bf16, WS_WSIN), 1024, r, false, scr, lane); continue; } r -= I_SIN;
        p0_mat(INP(31), 1024, 1024, WSP(bf16, WS_WSOUT), 1024, r, false, scr, lane);
    }
    for (int i = gt; i < 8 * 128 * 128 / 8; i += NGT) { const float* s = INP(29) + (size_t)i * 8; const f32x4 a = *(const f32x4*)s, b = *(const f32x4*)(s + 4);
        *(v4u*)(WSP(bf16, WS_WS) + (size_t)i * 8) = (v4u){pk2(a[0], a[1]), pk2(a[2], a[3]), pk2(b[0], b[1]), pk2(b[2], b[3])}; }
    for (int i = gt; i < NTOK * 5 / 4; i += NGT) *(f32x4*)(WSP(float, WS_STAT) + (size_t)i * 4) = (f32x4){0.f, 0.f, 0.f, 0.f};
    for (int i = gt; i < 128 * 16; i += NGT) { const int pos = i >> 4, k = i & 15; const float inv = powf(10000.0f, -(float)k / 16.0f), ang = (float)pos * inv; float sn, cs; sincosf(ang, &sn, &cs);
        WSP(float, WS_ROPE)[2 * i] = cs; WSP(float, WS_ROPE)[2 * i + 1] = sn; }
    {
        const float* w1 = INP(15); const float* b1 = INP(16); const float* fr = INP(17); const float* w2 = INP(18); const float* b2 = INP(19);
        const float f0 = fr[lane], f1 = fr[64 + lane], bb1 = b1[lane], bb2 = b2[lane];
        for (int t = gw; t < SEQ; t += NGW) {
            float z = 0.f;
            if (lane == 0) z = (float)t * (1.0f / 8191.0f);
            else if (lane <= 32) { const int k = (lane - 1) & 15; const float band = 1e-4f + (float)k * ((15.0f - 1e-4f) / 15.0f);
                const float ang = ((6.283185307179586f / 8192.0f) * (float)t) * band; z = (lane <= 16) ? cosf(ang) : -sinf(ang); }
            float a = bb1;
#pragma unroll
            for (int i = 0; i < 33; ++i) a += __shfl(z, i) * w1[i * 64 + lane];
            const float h1 = sinf(f0 * a);
            float a2 = bb2;
#pragma unroll 16
            for (int i = 0; i < 64; ++i) a2 += __shfl(h1, i) * w2[i * 64 + lane];
            const float h2 = sinf(f1 * a2);
            WSP(bf16, WS_H2)[(size_t)lane * SEQ + t] = (bf16)f2bf(h2);
        }
    }
    __syncthreads();
    if (C.bx < 2 * 96) {
        LAS float* sl = (LAS float*)(C.lds + 65536);
        LAS float* red = (LAS float*)(C.lds + 98304);
        for (int i = C_tid; i < 5 * 1024; i += NTHR) { const float v = i < 4096 ? INP(1)[i] : INP(3)[i - 4096]; sl[i] = v * __builtin_amdgcn_rcpf(1.0f + __builtin_amdgcn_exp2f(-1.4426950408889634f * v)); }
        __syncthreads();
        for (int it = C.bx; it < 2 * 96; it += C.G) {
            const int l = it / 96, cb = it % 96, col = cb * 64 + lane;
            const float* W = INP(4) + (size_t)l * 1024 * 6144 + col;
            float a0 = 0.f, a1 = 0.f, a2 = 0.f, a3 = 0.f, a4 = 0.f;
            const int kbeg = C.wave * 128;
#pragma unroll 1
            for (int k8 = kbeg; k8 < kbeg + 128; k8 += 16) {
                float wv[16];
#pragma unroll
                for (int j = 0; j < 16; ++j) wv[j] = W[(size_t)(k8 + j) * 6144];
#pragma unroll
                for (int j = 0; j < 16; ++j) { const int k = k8 + j; a0 += sl[k] * wv[j]; a1 += sl[1024 + k] * wv[j]; a2 += sl[2048 + k] * wv[j]; a3 += sl[3072 + k] * wv[j]; a4 += sl[4096 + k] * wv[j]; }
            }
            red[(C.wave * 5 + 0) * 64 + lane] = a0; red[(C.wave * 5 + 1) * 64 + lane] = a1; red[(C.wave * 5 + 2) * 64 + lane] = a2; red[(C.wave * 5 + 3) * 64 + lane] = a3; red[(C.wave * 5 + 4) * 64 + lane] = a4;
            __syncthreads();
            if (C_tid < 320) { const int v = C_tid >> 6, cc = C_tid & 63; float s = 0.f;
#pragma unroll
                for (int w = 0; w < 8; ++w) s += red[(w * 5 + v) * 64 + cc];
                const int oc = cb * 64 + cc; s += INP(5)[l * 6144 + oc];
                if (v < 4) WSP(float, WS_MOD)[(size_t)(l * 4 + v) * 6144 + oc] = s;
                else if (l == 0 && oc < 2048) WSP(float, WS_CMOD)[oc] = s; }
            __syncthreads();
        }
    }
}

__device__ __forceinline__ void phase_norm_mod(Ctx& C, const float* src, int rows, int rows_per_batch, const float* g, const float* shift, const float* scale, int bstride, bf16* dst) {
    const int C_lane = lane_fresh(), C_tid = C.wave * 64 + C_lane;
    const int gw = C.bx * NWAVES + C.wave, NGW = C.G * NWAVES, lane = C_lane;
    for (int r = gw; r < rows; r += NGW) {
        const f32x4* xr = (const f32x4*)(src + (size_t)r * DM) + lane;
        const int b = r / rows_per_batch;
        f32x4 v[4]; float s = 0.f;
#pragma unroll
        for (int j = 0; j < 4; ++j) { v[j] = xr[64 * j]; s += (v[j][0] * v[j][0] + v[j][1] * v[j][1]) + (v[j][2] * v[j][2] + v[j][3] * v[j][3]); }
        const float rstd = 1.0f / sqrtf(wave_sum(s) * (1.0f / DM) + EPS);
        v2u* o = (v2u*)(dst + (size_t)r * DM) + lane;
#pragma unroll
        for (int j = 0; j < 4; ++j) {
            const int col = 4 * (lane + 64 * j);
            const f32x4 gg = *(const f32x4*)(g + col), sh = *(const f32x4*)(shift + (size_t)b * bstride + col), sc = *(const f32x4*)(scale + (size_t)b * bstride + col);
            const f32x4 y = (v[j] * rstd) * gg * (sc + 1.0f) + sh;
            o[64 * j] = (v2u){pk2(y[0], y[1]), pk2(y[2], y[3])};
        }
    }
}
__device__ __forceinline__ void phase_shw(Ctx& C) {
    const int C_lane = lane_fresh(), C_tid = C.wave * 64 + C_lane;
    const int gw = C.bx * NWAVES + C.wave, NGW = C.G * NWAVES, lane = C_lane;
    const float* MOD = WSP(float, WS_MOD);
    for (int r = gw; r < NUP + 2048 + NUP; r += NGW) {
        int inst, n; const bf16* WT; const float* sh;
        if (r < NUP) { inst = 0; n = r; WT = WSP(bf16, WS_WUP0); sh = MOD + 3072; }
        else if (r < NUP + 2048) { inst = 1; n = r - NUP; WT = WSP(bf16, WS_WSIN); sh = MOD + 4 * 6144; }
        else { inst = 2; n = r - NUP - 2048; WT = WSP(bf16, WS_WUP1); sh = MOD + 4 * 6144 + 3072; }
        float a[4] = {0.f, 0.f, 0.f, 0.f};
#pragma unroll
        for (int h = 0; h < 2; ++h) {
            const v4u wv = *(const v4u*)(WT + (size_t)n * 1024 + 512 * h + 8 * lane);
            const float wf[8] = {bflo(wv.x), bfhi(wv.x), bflo(wv.y), bfhi(wv.y), bflo(wv.z), bfhi(wv.z), bflo(wv.w), bfhi(wv.w)};
#pragma unroll
            for (int b = 0; b < 4; ++b) {
                const f32x4 s0 = *(const f32x4*)(sh + b * 6144 + 512 * h + 8 * lane), s1 = *(const f32x4*)(sh + b * 6144 + 512 * h + 8 * lane + 4);
                a[b] += (s0[0] * wf[0] + s0[1] * wf[1]) + (s0[2] * wf[2] + s0[3] * wf[3]) + (s1[0] * wf[4] + s1[1] * wf[5]) + (s1[2] * wf[6] + s1[3] * wf[7]);
            }
        }
#pragma unroll
        for (int b = 0; b < 4; ++b) { const float s = wave_sum(a[b]); if (lane == 0) WSP(float, WS_SHW)[(size_t)(inst * 4 + b) * NUP + n] = s; }
    }
}
__device__ __forceinline__ void phase_final_norm(Ctx& C, float* x, const float* g) {
    const int C_lane = lane_fresh(), C_tid = C.wave * 64 + C_lane;
    const int gw = C.bx * NWAVES + C.wave, NGW = C.G * NWAVES, lane = C_lane;
    for (int r = gw; r < NTOK; r += NGW) {
        f32x4* xr = (f32x4*)(x + (size_t)r * DM) + lane;
        f32x4 v[4]; float s = 0.f;
#pragma unroll
        for (int j = 0; j < 4; ++j) { v[j] = xr[64 * j]; s += (v[j][0] * v[j][0] + v[j][1] * v[j][1]) + (v[j][2] * v[j][2] + v[j][3] * v[j][3]); }
        const float rstd = 1.0f / sqrtf(wave_sum(s) * (1.0f / DM) + EPS);
#pragma unroll
        for (int j = 0; j < 4; ++j) { const f32x4 gg = *(const f32x4*)(g + 4 * (lane + 64 * j)); xr[64 * j] = (v[j] * rstd) * gg; }
    }
}

constexpr int HY_BSTR = 19264, HY_UL_BYTES = 4 * HY_BSTR, HY_RL_OFF = HY_UL_BYTES, HY_RL_BYTES = 2 * SEQ * 2;
static_assert(HY_RL_OFF + 2 * HY_RL_BYTES <= MISC_OFF && HY_UL_BYTES % 16 == 0, "hyena LDS");
__device__ __forceinline__ unsigned alignbit16(unsigned hi, unsigned lo) { return __builtin_amdgcn_alignbit(hi, lo, 16); }
__device__ __forceinline__ void hyena_make_filters(Ctx& C, int c) {
    const int C_lane = lane_fresh(), C_tid = C.wave * 64 + C_lane;
    LAS unsigned short* RL0 = (LAS unsigned short*)(C.lds + HY_RL_OFF);
    const bf16* H2T = WSP(bf16, WS_H2); const float* w3 = INP(20) + c;
    const int tid = C_tid;
    f32x4 acc[4][4];
#pragma unroll
    for (int i = 0; i < 4; ++i)
#pragma unroll
        for (int j = 0; j < 4; ++j) acc[i][j] = (f32x4){0.f, 0.f, 0.f, 0.f};
#pragma unroll 4
    for (int k = 0; k < 64; ++k) {
        const float w0 = w3[k * 2048], w1 = w3[k * 2048 + 512], w2 = w3[k * 2048 + 1024], w3v = w3[k * 2048 + 1536];
#pragma unroll
        for (int jj = 0; jj < 2; ++jj) {
            const v4u hv = *(const v4u*)(H2T + (size_t)k * SEQ + 8 * (tid + NTHR * jj));
            const f32x4 ha = (f32x4){bflo(hv.x), bfhi(hv.x), bflo(hv.y), bfhi(hv.y)}, hb = (f32x4){bflo(hv.z), bfhi(hv.z), bflo(hv.w), bfhi(hv.w)};
            acc[0][2 * jj] += ha * w0; acc[0][2 * jj + 1] += hb * w0; acc[1][2 * jj] += ha * w1; acc[1][2 * jj + 1] += hb * w1;
            acc[2][2 * jj] += ha * w2; acc[2][2 * jj + 1] += hb * w2; acc[3][2 * jj] += ha * w3v; acc[3][2 * jj + 1] += hb * w3v;
        }
    }
    const float dsc = (3.0701134573253945f + (float)c * ((15.350567286626973f - 3.0701134573253945f) / 511.0f)) * (1.4426950408889634f / 8191.0f);
#pragma unroll
    for (int j = 0; j < 4; ++j)
#pragma unroll
        for (int e = 0; e < 4; ++e) {
            const int t = 8 * (tid + NTHR * (j >> 1)) + 4 * (j & 1) + e; const float win = __builtin_amdgcn_exp2f(-(float)t * dsc) + 0.05f;
            RL0[SEQ - t] = (unsigned short)f2bf(acc[0][j][e] * win); RL0[2 * SEQ + SEQ - t] = (unsigned short)f2bf(acc[2][j][e] * win);
            if (t > 0) { RL0[SEQ + t] = (unsigned short)f2bf(acc[1][j][e] * win); RL0[2 * SEQ + SEQ + t] = (unsigned short)f2bf(acc[3][j][e] * win); }
        }
    if (tid == 0) { RL0[0] = 0; RL0[2 * SEQ] = 0; }
}
__device__ __forceinline__ void hyena_conv(Ctx& C, int o, f32x4 (&acc)[2][8]) {
    const int C_lane = lane_fresh(), C_tid = C.wave * 64 + C_lane;
    const int lane = C_lane, w = C.wave, m = lane & 15, q = lane >> 4;
    const LAS unsigned char* UL = C.lds; const LAS unsigned char* RL = C.lds + HY_RL_OFF + o * HY_RL_BYTES;
#pragma unroll
    for (int g = 0; g < 2; ++g)
#pragma unroll
        for (int a = 0; a < 8; ++a) acc[g][a] = (f32x4){0.f, 0.f, 0.f, 0.f};
    const int cl = m >> 2, bt = m & 3;
    const int dlo = 8 * w - 63;
    const int roff0 = 2 * (SEQ - 128 * dlo - 8 * m + 8 * q), uoff0 = bt * HY_BSTR + (8 * w + cl + 3) * 272 + 16 * q - 272 * dlo;
#define HY_ROFF(i) (roff0 + 64 * ((i) & 3) - 256 * ((i) >> 2))
#define HY_UOFF(i) (uoff0 + 64 * ((i) & 3) - 272 * ((i) >> 2))
#define HY_BUILD(af, lo, hi) do { const unsigned wd[8] = {lo.x, lo.y, lo.z, lo.w, hi.x, hi.y, hi.z, hi.w}; \
        _Pragma("unroll") for (int p = 0; p < 4; ++p) { \
            const v4u ev = (v4u){wd[4 - p], wd[5 - p], wd[6 - p], wd[7 - p]}; \
            const v4u od = (v4u){alignbit16(wd[4 - p], wd[3 - p]), alignbit16(wd[5 - p], wd[4 - p]), alignbit16(wd[6 - p], wd[5 - p]), alignbit16(wd[7 - p], wd[6 - p])}; \
            af[2 * p] = __builtin_bit_cast(bf16x8, ev); af[2 * p + 1] = __builtin_bit_cast(bf16x8, od); } } while (0)
    v4u lo = *(const LAS v4u*)(RL + HY_ROFF(0) - 16), hi = *(const LAS v4u*)(RL + HY_ROFF(0));
    v4u b0 = *(const LAS v4u*)(UL + HY_UOFF(0)), b1 = *(const LAS v4u*)(UL + HY_UOFF(0) + 4 * 272);
    bf16x8 afc[8];
    HY_BUILD(afc, lo, hi);
    lo = *(const LAS v4u*)(RL + HY_ROFF(1) - 16); hi = *(const LAS v4u*)(RL + HY_ROFF(1));
#pragma unroll 1
    for (int it = 0; it < 284; ++it) {
        const int d = dlo + (it >> 2);
        const bool v0 = d <= 8 * w + 3, v1 = d >= 8 * w + 4 - 63;
        const int i1 = it + 1 < 284 ? it + 1 : 283, i2 = it + 2 < 284 ? it + 2 : 283;
        const v4u lo2 = *(const LAS v4u*)(RL + HY_ROFF(i2) - 16), hi2 = *(const LAS v4u*)(RL + HY_ROFF(i2));
        const v4u b0n = *(const LAS v4u*)(UL + HY_UOFF(i1)), b1n = *(const LAS v4u*)(UL + HY_UOFF(i1) + 4 * 272);
        bf16x8 afn[8];
        HY_BUILD(afn, lo, hi);
        if (v0) {
            const bf16x8 bfr = __builtin_bit_cast(bf16x8, b0);
#pragma unroll
            for (int a = 0; a < 8; ++a) acc[0][a] = __builtin_amdgcn_mfma_f32_16x16x32_bf16(afc[a], bfr, acc[0][a], 0, 0, 0);
        }
        if (v1) {
            const bf16x8 bfr = __builtin_bit_cast(bf16x8, b1);
#pragma unroll
            for (int a = 0; a < 8; ++a) acc[1][a] = __builtin_amdgcn_mfma_f32_16x16x32_bf16(afc[a], bfr, acc[1][a], 0, 0, 0);
        }
#pragma unroll
        for (int a = 0; a < 8; ++a) afc[a] = afn[a];
        lo = lo2; hi = hi2; b0 = b0n; b1 = b1n;
    }
#undef HY_ROFF
#undef HY_UOFF
#undef HY_BUILD
}
__device__ __forceinline__ void hyena_item(Ctx& C, int c) {
    const int C_lane = lane_fresh(), C_tid = C.wave * 64 + C_lane;
    const int lane = C_lane, w = C.wave, tid = C_tid;
    LAS unsigned char* UL = C.lds;
    const bf16* HY = WSP(bf16, WS_HY);
    for (int i = tid; i < 4 * 6 * 17; i += NTHR) { const int bt = i / 102, r = i % 102, sl = r / 17, pc = r % 17; const int slot = sl < 3 ? sl : 64 + sl;
        *(LAS v4u*)(UL + bt * HY_BSTR + slot * 272 + pc * 16) = (v4u){0u, 0u, 0u, 0u}; }
#pragma unroll
    for (int i = 0; i < 8; ++i) { const int p = i * NTHR + tid, bt = p >> 10, r = p & 1023, ch = r >> 4, pc = r & 15;
        *(LAS v4u*)(UL + bt * HY_BSTR + (ch + 3) * 272 + pc * 16) = *(const v4u*)(HY + ((size_t)(bt * 1536 + c) * SEQ) + r * 8); }
    hyena_make_filters(C, c);
    __syncthreads();
    f32x4 acc[2][8];
    const int mcol = lane & 15, q = lane >> 4, cl = mcol >> 2, bt = mcol & 3;
#pragma unroll 1
    for (int o = 0; o < 2; ++o) {
        hyena_conv(C, o, acc);
        __syncthreads();
        const float dsk = INP(21)[o * 512 + c];
#pragma unroll
        for (int g = 0; g < 2; ++g) {
            const int chunk = 8 * w + 4 * g + cl, p0 = 128 * chunk + 32 * q;
            LAS unsigned char* zl = UL + bt * HY_BSTR + (chunk + 3) * 272 + 64 * q;
            const bf16* gate = HY + ((size_t)(bt * 1536 + (o + 1) * 512 + c) * SEQ) + p0;
            unsigned short outv[32];
#pragma unroll
            for (int k = 0; k < 4; ++k) {
                const v4u zz = *(LAS v4u*)(zl + 16 * k), gg = *(const v4u*)(gate + 8 * k);
                const unsigned zw[4] = {zz.x, zz.y, zz.z, zz.w}, gw[4] = {gg.x, gg.y, gg.z, gg.w};
#pragma unroll
                for (int e = 0; e < 8; ++e) {
                    const float zv = (e & 1) ? bfhi(zw[e >> 1]) : bflo(zw[e >> 1]), gv = (e & 1) ? bfhi(gw[e >> 1]) : bflo(gw[e >> 1]);
                    outv[8 * k + e] = (unsigned short)f2bf(gv * (acc[g][e][k] + dsk * zv));
                }
            }
#pragma unroll
            for (int k = 0; k < 4; ++k) {
                const v4u ov = (v4u){(unsigned)outv[8 * k] | ((unsigned)outv[8 * k + 1] << 16), (unsigned)outv[8 * k + 2] | ((unsigned)outv[8 * k + 3] << 16),
                                     (unsigned)outv[8 * k + 4] | ((unsigned)outv[8 * k + 5] << 16), (unsigned)outv[8 * k + 6] | ((unsigned)outv[8 * k + 7] << 16)};
                if (o == 0) *(LAS v4u*)(zl + 16 * k) = ov;
                else *(v4u*)(WSP(bf16, WS_YAT) + ((size_t)(bt * 512 + c) * SEQ) + p0 + 8 * k) = ov;
            }
        }
        __syncthreads();
    }
}

__device__ __forceinline__ void phase_hyena(Ctx& C) {
    const int C_lane = lane_fresh(), C_tid = C.wave * 64 + C_lane;
#pragma unroll 1
    for (int c = C.bx; c < DHY; c += C.G) hyena_item(C, c);
}
__device__ __forceinline__ void phase_attn(Ctx& C) {
    const int C_lane = lane_fresh(), C_tid = C.wave * 64 + C_lane;
    const int v = (C.G % 8 == 0) ? (C.bx % 8) * (C.G / 8) + C.bx / 8 : C.bx;
#pragma unroll 1
    for (int u = v; u < 1024; u += C.G) {
        const int combo = u >> 5, qb = u & 31;
        const int b = combo >> 3, hm = combo & 7, h = hm >> 1, mm = hm & 1;
        const attn_body::bf16* Qp = (const attn_body::bf16*)(WSP(bf16, WS_Q) + ((size_t)(b * SEQ + qb * 256) * 512 + hm * 64));
        const attn_body::bf16* Kp = (const attn_body::bf16*)(WSP(bf16, WS_K) + ((size_t)b * NKV * 512 + hm * 64));
        const attn_body::bf16* Vp = (const attn_body::bf16*)(WSP(bf16, WS_V) + ((size_t)b * NKV * 512 + h * 128));
        attn_body::bf16* Op = (attn_body::bf16*)(WSP(bf16, WS_O) + ((size_t)(b * SEQ + qb * 256) * 1024 + mm * 512 + h * 128));
        attn_body::attn_unit<8>(Qp, Kp, Vp, Op, (char*)C.ldsg, C.wave);
    }
    __syncthreads();
}

__device__ __forceinline__ void phase_combine(Ctx& C, bf16* MIX) {
    const int C_lane = lane_fresh(), C_tid = C.wave * 64 + C_lane;
    const int gw = C.bx * NWAVES + C.wave, NGW = C.G * NWAVES, lane = C_lane;
    const float lam_init = 0.2f;
    const float* dl = INP(22);
    const float lam = __expf(wave_sum(dl[lane] * dl[64 + lane])) - __expf(wave_sum(dl[128 + lane] * dl[192 + lane])) + lam_init;
    const bf16* O = WSP(bf16, WS_O);
    const float* sg = INP(23) + (lane & 15) * 8;
    const f32x4 g0 = *(const f32x4*)sg, g1 = *(const f32x4*)(sg + 4);
    for (int r = gw; r < NTOK; r += NGW) {
        const v4u a = *(const v4u*)(O + (size_t)r * 1024 + 8 * lane), b = *(const v4u*)(O + (size_t)r * 1024 + 512 + 8 * lane);
        const unsigned aw[4] = {a.x, a.y, a.z, a.w}, bw[4] = {b.x, b.y, b.z, b.w};
        float o[8]; float ss = 0.f;
#pragma unroll
        for (int e = 0; e < 4; ++e) { o[2 * e] = bflo(aw[e]) - lam * bflo(bw[e]); o[2 * e + 1] = bfhi(aw[e]) - lam * bfhi(bw[e]); ss += o[2 * e] * o[2 * e] + o[2 * e + 1] * o[2 * e + 1]; }
        ss += __shfl_xor(ss, 1); ss += __shfl_xor(ss, 2); ss += __shfl_xor(ss, 4); ss += __shfl_xor(ss, 8);
        const float rs = (1.0f / sqrtf(ss * (1.0f / 128.0f) + EPS)) * (1.0f - lam_init);
        *(v4u*)(MIX + (size_t)r * DM + 512 + 8 * lane) = (v4u){pk2(o[0] * rs * g0[0], o[1] * rs * g0[1]), pk2(o[2] * rs * g0[2], o[3] * rs * g0[3]), pk2(o[4] * rs * g1[0], o[5] * rs * g1[1]), pk2(o[6] * rs * g1[2], o[7] * rs * g1[3])};
    }
    LAS unsigned* tl = (LAS unsigned*)(C.lds + C.wave * 16384);
    const bf16* YAT = WSP(bf16, WS_YAT);
    for (int it = gw; it < 4 * 128 * 8; it += NGW) {
        const int b = it >> 10, tt = (it >> 3) & 127, ct = it & 7;
#pragma unroll
        for (int r = 0; r < 8; ++r) { const int c = r * 8 + (lane >> 3), tc = lane & 7;
            const v4u v = *(const v4u*)(YAT + ((size_t)(b * 512 + ct * 64 + c) * SEQ) + tt * 64 + tc * 8);
            tl[c * 33 + tc * 4 + 0] = v.x; tl[c * 33 + tc * 4 + 1] = v.y; tl[c * 33 + tc * 4 + 2] = v.z; tl[c * 33 + tc * 4 + 3] = v.w; }
        LDS_WAIT(); asm volatile("" ::: "memory");
#pragma unroll
        for (int r = 0; r < 8; ++r) { const int t = r * 8 + (lane >> 3), cc = lane & 7;
            unsigned short e[8];
#pragma unroll
            for (int k = 0; k < 8; ++k) { const unsigned wv = tl[(cc * 8 + k) * 33 + (t >> 1)]; e[k] = (unsigned short)((t & 1) ? (wv >> 16) : (wv & 0xffffu)); }
            *(v4u*)(MIX + (size_t)(b * SEQ + tt * 64 + t) * DM + ct * 64 + cc * 8) = (v4u){(unsigned)e[0] | ((unsigned)e[1] << 16), (unsigned)e[2] | ((unsigned)e[3] << 16), (unsigned)e[4] | ((unsigned)e[5] << 16), (unsigned)e[6] | ((unsigned)e[7] << 16)}; }
        LDS_WAIT(); asm volatile("" ::: "memory");
    }
}

__device__ __forceinline__ void phase_sgu_spatial(Ctx& C, bf16* GATED) {
    const int C_lane = lane_fresh(), C_tid = C.wave * 64 + C_lane;
    const int lane = C_lane, w = C.wave, tid = C_tid;
    LAS unsigned short* vt = (LAS unsigned short*)C.lds;
    const bf16* SU = WSP(bf16, WS_SU); const bf16* SV = WSP(bf16, WS_SV); const float* stat = WSP(float, WS_STAT); const bf16* WSb = WSP(bf16, WS_WS);
    const float* lng = INP(27); const float* lnb = INP(28); const float* bs = INP(30);
    for (int it = C.bx; it < 4 * 64 * 8; it += C.G) {
        const int g = it & 7, n = (it >> 3) & 63, b = it >> 9, tok0 = b * SEQ + n * 128;
        __syncthreads();
#pragma unroll
        for (int i = 0; i < 4; ++i) {
            const int p = i * NTHR + tid, s = p & 127, cp = p >> 7;
            const v4u v = *(const v4u*)(SV + (size_t)(tok0 + s) * DM + g * 128 + cp * 8);
            const float sm = stat[2 * (tok0 + s)], sq = stat[2 * (tok0 + s) + 1];
            const float mean = sm * (1.0f / 1024.0f), var = sq * (1.0f / 1024.0f) - mean * mean, rstd = 1.0f / sqrtf(var + EPS);
            const unsigned vw[4] = {v.x, v.y, v.z, v.w};
            const f32x4 ga = *(const f32x4*)(lng + g * 128 + cp * 8), gb = *(const f32x4*)(lng + g * 128 + cp * 8 + 4), ba = *(const f32x4*)(lnb + g * 128 + cp * 8), bb = *(const f32x4*)(lnb + g * 128 + cp * 8 + 4);
            const float gg[8] = {ga[0], ga[1], ga[2], ga[3], gb[0], gb[1], gb[2], gb[3]}, bq[8] = {ba[0], ba[1], ba[2], ba[3], bb[0], bb[1], bb[2], bb[3]};
#pragma unroll
            for (int e = 0; e < 8; ++e) { const float x = (e & 1) ? bfhi(vw[e >> 1]) : bflo(vw[e >> 1]); vt[(cp * 8 + e) * 136 + s] = (unsigned short)f2bf((x - mean) * rstd * gg[e] + bq[e]); }
        }
        __syncthreads();
        f32x4 acc[8];
#pragma unroll
        for (int cb = 0; cb < 8; ++cb) acc[cb] = (f32x4){0.f, 0.f, 0.f, 0.f};
        const int fr = lane & 15, fq = lane >> 4;
#pragma unroll
        for (int kb = 0; kb < 4; ++kb) {
            const bf16x8 a = *(const bf16x8*)(WSb + ((size_t)(g * 128 + 16 * w + fr) * 128) + 32 * kb + 8 * fq);
#pragma unroll
            for (int cb = 0; cb < 8; ++cb) { const bf16x8 bfr = *(const LAS bf16x8*)(vt + (16 * cb + fr) * 136 + 32 * kb + 8 * fq); acc[cb] = __builtin_amdgcn_mfma_f32_16x16x32_bf16(a, bfr, acc[cb], 0, 0, 0); }
        }
#pragma unroll
        for (int reg = 0; reg < 4; ++reg) {
            const int t = 16 * w + 4 * fq + reg; const float bias = bs[g * 128 + t];
#pragma unroll
            for (int cb = 0; cb < 8; ++cb) { const size_t off = (size_t)(tok0 + t) * DM + g * 128 + 16 * cb + fr; GATED[off] = (bf16)f2bf(bf2f(SU[off]) * (acc[cb][reg] + bias)); }
        }
    }
    __syncthreads();
}

#ifndef DUP_HY
#define DUP_HY 1
#endif
#ifndef DUP_IN
#define DUP_IN 1
#endif
#ifndef DUP_AT
#define DUP_AT 1
#endif
#ifndef DUP_UP
#define DUP_UP 1
#endif
struct Args { const float* in[33]; float* out; unsigned char* ws; int ph_lo, ph_hi; };
constexpr int N_PHASES = 17;
__global__ void __launch_bounds__(NTHR, 2) fwd_megakernel(Args args) {
    extern __shared__ __attribute__((aligned(16))) unsigned char lds_raw[];
    cg::grid_group grid = cg::this_grid();
    Ctx C;
    C.lds = (LAS unsigned char*)lds_raw; C.ldsg = lds_raw; C.wave = __builtin_amdgcn_readfirstlane(threadIdx.x >> 6); C.G = gridDim.x; C.bx = blockIdx.x;
    C.kin = (ktab)__builtin_amdgcn_kernarg_segment_ptr();
    C.out = args.out; C.ws = args.ws;
    const int lo = args.ph_lo, hi = args.ph_hi;
    { const int C_lane = lane_fresh(), C_tid = C.wave * 64 + C_lane;
    { volatile LAS unsigned* mz = (volatile LAS unsigned*)(C.lds + MISC_OFF); if (C_tid < 64) mz[C_tid] = 0u; }
    __syncthreads();
    if (C.bx == 0) for (int i = C_tid; i < XCD_BAR_WORDS; i += NTHR) ((unsigned*)(C.ws + WS_CTL) + 4096)[i] = 0u;
    }
    XcdBarrier bar; bar.bar = (unsigned*)(C.ws + WS_CTL) + 4096; bar.x = 0; bar.wave = C.wave; bar.st = (volatile LAS unsigned*)(C.lds + MISC_OFF) + 8;
#ifndef PHMASK
#define PHMASK 0x1ffff
#endif
#define IN(k) ((((PHMASK) >> (k)) & 1) && lo <= (k) && (k) < hi)
#define SEAM(k) do { if (IN(k) && (k) + 1 < hi) xcd_barrier(bar); } while (0)
    bf16* ACT = WSP(bf16, WS_ACT);
    const float* MOD = WSP(float, WS_MOD);

    if (IN(0)) phase_p0(C);
    grid.sync();
    bar = xcd_barrier_post((unsigned*)(C.ws + WS_CTL) + 4096, (volatile LAS unsigned*)(C.lds + MISC_OFF) + 8, C.wave);
    bf16* ACT2 = WSP(bf16, WS_ACT2);
    float* RS = WSP(float, WS_RS);
    const float* SHW = WSP(float, WS_SHW);
    const float* MOD1 = MOD + (size_t)4 * 6144;
    if (IN(1)) {
        phase_norm_mod(C, INP(0), NTOK, SEQ, INP(6), MOD, MOD + 1024, 6144, ACT + DM);
        phase_norm_mod(C, INP(2), NCTX, NCTX, INP(6), WSP(float, WS_CMOD), WSP(float, WS_CMOD) + 1024, 0, WSP(bf16, WS_HC));
        phase_shw(C);
    }
    SEAM(1);
    if (IN(2)) {
        { pg8::Gemm g{ACT, WSP(bf16, WS_WIN), SLAB_TILES * 256, NIN, 1024, 1}; pg8::StaticOrder S; S.init(SLAB_TILES * 256, NIN, C.G, C.bx);
          epi::EpiInProj E{WSP(bf16, WS_HY), WSP(bf16, WS_Q), WSP(bf16, WS_K), WSP(bf16, WS_V), INP(13), INP(14), WSP(float, WS_ROPE)};
          _Pragma("unroll 1") for (int r_ = 0; r_ < DUP_IN; ++r_) pg8::gemm_phase<epi::EpiInProj, pg8::StaticOrder, true, true>(C.lds, g, S, E, C.wave); }
        { pg8::Gemm g{WSP(bf16, WS_HC), WSP(bf16, WS_WIN) + (size_t)2048 * 1024, NCTX, 1024, 1024, 0}; pg8::StaticOrder S; S.init(NCTX, 1024, C.G, (C.bx + C.G - 64) % C.G);
          epi::EpiCtxKV E{WSP(bf16, WS_K), WSP(bf16, WS_V)};
          pg8::gemm_phase<epi::EpiCtxKV, pg8::StaticOrder, true, true>(C.lds, g, S, E, C.wave); }
    }
    SEAM(2);
    if (IN(3)) {
#pragma unroll 1
        for (int r_ = 0; r_ < DUP_HY; ++r_) phase_hyena(C);
#pragma unroll 1
        for (int r_ = 0; r_ < DUP_AT; ++r_) phase_attn(C);
    }
    SEAM(3);
    if (IN(4)) phase_combine(C, ACT + DM);
    SEAM(4);
    if (IN(5)) {
        pg8::Gemm g{ACT + DM, WSP(bf16, WS_WOUT), NTOK, 1024, 1024, 0}; pg8::StaticOrder S; S.init(NTOK, 1024, C.G, C.bx);
        epi::EpiResid E{INP(0), C.out, MOD + 2048, nullptr, nullptr, nullptr, nullptr};
        pg8::gemm_phase<epi::EpiResid, pg8::StaticOrder, true, true>(C.lds, g, S, E, C.wave);
    }
    SEAM(5);
    if (IN(6)) phase_norm_mod(C, C.out, NTOK, SEQ, INP(7), MOD + 3072, MOD + 4096, 6144, ACT + DM);
    SEAM(6);
    if (IN(7)) {
        pg8::Gemm g{ACT, WSP(bf16, WS_WUP0), SLAB_TILES * 256, NUP, 1024, 1}; pg8::StaticOrder S; S.init(SLAB_TILES * 256, NUP, C.G, C.bx);
        epi::EpiFfnUp E{WSP(bf16, WS_HID), INP(9), INP(10)};
        pg8::gemm_phase<epi::EpiFfnUp, pg8::StaticOrder, true, true>(C.lds, g, S, E, C.wave);
    }
    SEAM(7);
    if (IN(8)) {
        pg8::Gemm g{WSP(bf16, WS_HID), WSP(bf16, WS_WDN0), NTOK, 1024, DFF, 0}; pg8::StaticOrder S; S.init(NTOK, 1024, C.G, C.bx);
        epi::EpiResid E{C.out, C.out, MOD + 5120, ACT + DM, INP(6) + 1024, MOD1 + 1024, RS + NTOK};
        pg8::gemm_phase<epi::EpiResid, pg8::StaticOrder, true, true>(C.lds, g, S, E, C.wave);
    }
    SEAM(8);
    if (IN(10)) {
        pg8::Gemm g{ACT + DM, WSP(bf16, WS_WSIN), NTOK, 2048, 1024, 0}; pg8::StaticOrder S; S.init(NTOK, 2048, C.G, C.bx);
        epi::EpiSguIn E{WSP(bf16, WS_SU), WSP(bf16, WS_SV), INP(26), WSP(float, WS_STAT), RS + NTOK, SHW + (size_t)4 * NUP};
        pg8::gemm_phase<epi::EpiSguIn, pg8::StaticOrder, true, true>(C.lds, g, S, E, C.wave);
    }
    SEAM(10);
    if (IN(11)) phase_sgu_spatial(C, ACT2 + DM);
    SEAM(11);
    if (IN(12)) {
        pg8::Gemm g{ACT2 + DM, WSP(bf16, WS_WSOUT), NTOK, 1024, 1024, 0}; pg8::StaticOrder S; S.init(NTOK, 1024, C.G, C.bx);
        epi::EpiResid E{C.out, C.out, MOD1 + 2048, nullptr, nullptr, nullptr, nullptr};
        pg8::gemm_phase<epi::EpiResid, pg8::StaticOrder, true, true>(C.lds, g, S, E, C.wave);
    }
    SEAM(12);
    if (IN(13)) phase_norm_mod(C, C.out, NTOK, SEQ, INP(7) + 1024, MOD1 + 3072, MOD1 + 4096, 6144, ACT + DM);
    SEAM(13);
    if (IN(14)) {
        pg8::Gemm g{ACT, WSP(bf16, WS_WUP1), SLAB_TILES * 256, NUP, 1024, 1}; pg8::StaticOrder S; S.init(SLAB_TILES * 256, NUP, C.G, C.bx);
        epi::EpiFfnUp E{WSP(bf16, WS_HID), INP(9) + (size_t)3 * NUP, INP(10) + NUP};
        pg8::gemm_phase<epi::EpiFfnUp, pg8::StaticOrder, true, true>(C.lds, g, S, E, C.wave);
    }
    SEAM(14);
    if (IN(15)) {
        pg8::Gemm g{WSP(bf16, WS_HID), WSP(bf16, WS_WDN1), NTOK, 1024, DFF, 0}; pg8::StaticOrder S; S.init(NTOK, 1024, C.G, C.bx);
        epi::EpiResid E{C.out, C.out, MOD1 + 5120, nullptr, nullptr, nullptr, nullptr};
        pg8::gemm_phase<epi::EpiResid, pg8::StaticOrder, true, true>(C.lds, g, S, E, C.wave);
    }
    SEAM(15);
    if (IN(16)) phase_final_norm(C, C.out, INP(32));
#undef IN
#undef SEAM
}

extern "C" void kernel_launch(void* const* d_in, const int* in_sizes, int n_in, void* d_out, int out_size, void* d_ws, size_t ws_size, hipStream_t stream) {
    static int grid = 0;
    if (grid == 0) {
        if (n_in != 33 || out_size != NTOK * DM || ws_size < WS_END) { fprintf(stderr, "kernel_launch: unexpected shapes (n_in %d out %d ws %zu)\n", n_in, out_size, ws_size); grid = -1; return; }
        int dev = 0, cus = 0, per_cu = 0;
        hipGetDevice(&dev); hipDeviceGetAttribute(&cus, hipDeviceAttributeMultiprocessorCount, dev);
        hipFuncSetAttribute((const void*)fwd_megakernel, hipFuncAttributeMaxDynamicSharedMemorySize, LDS_BYTES);
        if (hipOccupancyMaxActiveBlocksPerMultiprocessor(&per_cu, (const void*)fwd_megakernel, NTHR, LDS_BYTES) != hipSuccess || per_cu < 1) per_cu = 1;
        (void)hipGetLastError();
        grid = cus * per_cu;
    }
    if (grid < 0) return;
    Args a{};
    for (int i = 0; i < 33; ++i) a.in[i] = (const float*)d_in[i];
    a.out = (float*)d_out; a.ws = (unsigned char*)d_ws;
#ifndef N_LAUNCH_SPLIT
    a.ph_lo = 0; a.ph_hi = N_PHASES;
    void* params[] = {&a};
    hipError_t e = hipLaunchCooperativeKernel((const void*)fwd_megakernel, dim3(grid), dim3(NTHR), params, LDS_BYTES, stream);
    if (e != hipSuccess) fprintf(stderr, "cooperative launch failed: %s (grid %d)\n", hipGetErrorString(e), grid);
#else
    for (int p = 0; p < N_PHASES; ++p) { a.ph_lo = p; a.ph_hi = p + 1; hipLaunchKernelGGL(fwd_megakernel, dim3(grid), dim3(NTHR), LDS_BYTES, stream, a); }
#endif
}
```
